# Optimizing an MI355X kernel written in HIP

```python
import jax, jax.numpy as jnp
from jax import lax
import numpy as np

D_MODEL = 2048
BATCH = 4
SEQ = 4096
DEPTH = 2

HEAD_DIM = 128
EPS = 1e-6
A_HEADS = 8
A_KV_HEADS = 2
A_GROUP = A_HEADS // A_KV_HEADS
A_WINDOW = 128
A_BLOCK = 128
B_HEADS = 4
GRID_W = 64
NB_ROWS_MAX = 8
NB_COLS = 16
C_HEADS = 4
C_Q_RANK = 512
C_KV_RANK = 256
C_NOPE = 128
C_ROPE = 64
C_V = 128
C_BLOCK = 128
ROPE_THETA = 10000.0
A_Q = A_HEADS * HEAD_DIM
A_KV = A_KV_HEADS * HEAD_DIM
B_W = B_HEADS * HEAD_DIM
C_OUT = C_HEADS * C_V
D_MIX = A_Q + B_W + C_OUT
IN_SPLITS = (A_Q, A_KV, A_KV, B_W, B_W, B_W, C_Q_RANK, C_KV_RANK, C_ROPE)
D_IN = A_Q + 2 * A_KV + 3 * B_W + C_Q_RANK + C_KV_RANK + C_ROPE
PEER_HEADS = 8
PEER_KEYS = 128
PEER_EXPERTS = PEER_KEYS * PEER_KEYS
PEER_KEY_DIM = 128
PEER_TOPK = 16
PEER_CHUNK = 128

kernel_name = 'hybrid_parallel_heads_peer_encoder'


def rms_norm(x, g):
    xf = x.astype(jnp.float32)
    y = xf * lax.rsqrt(jnp.mean(xf * xf, axis=-1, keepdims=True) + EPS)
    return (y * g.astype(jnp.float32)).astype(x.dtype)


def alibi_slopes(n):
    return jnp.asarray([2.0 ** (-8.0 * (h + 1) / n) for h in range(n)], dtype=jnp.float32)


def apply_rope(x):
    s_len, d = x.shape[1], x.shape[-1]
    half = d // 2
    inv = ROPE_THETA ** (-jnp.arange(half, dtype=jnp.float32) / half)
    ang = jnp.arange(s_len, dtype=jnp.float32)[:, None] * inv[None, :]
    cos = jnp.cos(ang)[None, :, None, :]
    sin = jnp.sin(ang)[None, :, None, :]
    x1 = x[..., :half].astype(jnp.float32)
    x2 = x[..., half:].astype(jnp.float32)
    return jnp.concatenate([x1 * cos - x2 * sin, x1 * sin + x2 * cos], axis=-1).astype(x.dtype)


def window_gqa_attention(q, k, v, sink):
    bsz, s_len = q.shape[0], q.shape[1]
    nb = s_len // A_BLOCK
    qb = q.reshape(bsz, nb, A_BLOCK, A_KV_HEADS, A_GROUP, HEAD_DIM)

    def band(t):
        tb = t.reshape(bsz, nb, A_BLOCK, A_KV_HEADS, HEAD_DIM)
        tp = jnp.pad(tb, ((0, 0), (1, 1), (0, 0), (0, 0), (0, 0)))
        return jnp.concatenate([tp[:, :-2], tp[:, 1:-1], tp[:, 2:]], axis=2)

    kb, vb = band(k), band(v)
    s = jnp.einsum('bnqkgd,bnskd->bnkgqs', qb, kb).astype(jnp.float32) * (HEAD_DIM ** -0.5)
    blk = jnp.arange(nb)[:, None, None] * A_BLOCK
    q_pos = blk + jnp.arange(A_BLOCK)[None, :, None]
    k_pos = blk + jnp.arange(3 * A_BLOCK)[None, None, :] - A_BLOCK
    dist = jnp.abs(q_pos - k_pos)
    valid = (dist <= A_WINDOW) & (k_pos >= 0) & (k_pos < s_len)
    slopes = alibi_slopes(A_HEADS).reshape(A_KV_HEADS, A_GROUP)
    s = s - slopes[None, None, :, :, None, None] * dist[None, :, None, None].astype(jnp.float32)
    s = jnp.where(valid[None, :, None, None], s, -jnp.inf)
    sk = sink.astype(jnp.float32).reshape(A_KV_HEADS, A_GROUP)[None, None, :, :, None, None]
    m = jnp.maximum(jnp.max(s, axis=-1, keepdims=True), sk)
    p = jnp.exp(s - m)
    p = p / (jnp.sum(p, axis=-1, keepdims=True) + jnp.exp(sk - m))
    o = jnp.einsum('bnkgqs,bnskd->bnqkgd', p.astype(v.dtype), vb)
    return o.reshape(bsz, s_len, A_Q)


def neighbourhood_attention(q, k, v, rel_bias):
    bsz, s_len = q.shape[0], q.shape[1]
    rows = s_len // GRID_W
    kr = min(NB_ROWS_MAX, rows)
    qg = jnp.moveaxis(q.reshape(bsz, rows, GRID_W, B_HEADS, HEAD_DIM), 1, 0)
    kg = k.reshape(bsz, rows, GRID_W, B_HEADS, HEAD_DIM)
    vg = v.reshape(bsz, rows, GRID_W, B_HEADS, HEAD_DIM)
    col = jnp.arange(GRID_W)
    c_start = jnp.clip(col - NB_COLS // 2, 0, GRID_W - NB_COLS)
    col_ok = (col[None, :] >= c_start[:, None]) & (col[None, :] < c_start[:, None] + NB_COLS)
    dc_idx = jnp.clip(col[None, :] - col[:, None] + NB_COLS - 1, 0, 2 * NB_COLS - 2)
    scale = HEAD_DIM ** -0.5

    def one_row(args):
        r, q_r = args
        r_start = jnp.clip(r - kr // 2, 0, rows - kr)
        k_r = lax.dynamic_slice_in_dim(kg, r_start, kr, axis=1)
        v_r = lax.dynamic_slice_in_dim(vg, r_start, kr, axis=1)
        dr_idx = r_start + jnp.arange(kr) - r + NB_ROWS_MAX - 1
        bias = rel_bias[:, dr_idx[None, :, None], dc_idx[:, None, :]].astype(jnp.float32)
        bias = jnp.where(col_ok[None, :, None, :], bias, -jnp.inf)
        s = jnp.einsum('bqhd,brkhd->bhqrk', q_r, k_r).astype(jnp.float32) * scale + bias[None]
        p = jax.nn.softmax(s.reshape(bsz, B_HEADS, GRID_W, kr * GRID_W), axis=-1)
        p = p.reshape(bsz, B_HEADS, GRID_W, kr, GRID_W).astype(v_r.dtype)
        return jnp.einsum('bhqrk,brkhd->bqhd', p, v_r)

    o = lax.map(one_row, (jnp.arange(rows), qg))
    return jnp.moveaxis(o, 0, 1).reshape(bsz, s_len, B_W)


def mla_attention(c_q, c_kv, k_rope, g_cq, g_ckv, w_uq, w_ukv):
    bsz, s_len = c_q.shape[0], c_q.shape[1]
    q = (rms_norm(c_q, g_cq) @ w_uq).reshape(bsz, s_len, C_HEADS, C_NOPE + C_ROPE)
    q_nope = q[..., :C_NOPE]
    q_pe = apply_rope(q[..., C_NOPE:])
    kv = (rms_norm(c_kv, g_ckv) @ w_ukv).reshape(bsz, s_len, C_HEADS, C_NOPE + C_V)
    k_nope = kv[..., :C_NOPE]
    v = kv[..., C_NOPE:]
    k_pe = apply_rope(k_rope[:, :, None, :])[:, :, 0]
    nb = s_len // C_BLOCK
    scale = (C_NOPE + C_ROPE) ** -0.5

    def to_blocks(t):
        return jnp.moveaxis(t.reshape(bsz, nb, C_BLOCK, *t.shape[2:]), 1, 0)

    def one_block(args):
        qn, qp = args
        s = (jnp.einsum('bqhd,bkhd->bhqk', qn, k_nope)
             + jnp.einsum('bqhd,bkd->bhqk', qp, k_pe)).astype(jnp.float32) * scale
        p = jax.nn.softmax(s, axis=-1).astype(v.dtype)
        return jnp.einsum('bhqk,bkhd->bqhd', p, v)

    o = lax.map(one_block, (to_blocks(q_nope), to_blocks(q_pe)))
    return jnp.moveaxis(o, 0, 1).reshape(bsz, s_len, C_OUT)


def hybrid_mixer(xn, w_in, a_sink, b_rel_bias, c_q_norm, c_kv_norm, c_w_uq, c_w_ukv, out_norm, w_o):
    bsz, s_len, _ = xn.shape
    h = xn @ w_in
    cuts = [int(c) for c in np.cumsum(IN_SPLITS)[:-1]]
    qa, ka, va, qb, kb, vb, cq, ckv, kr = jnp.split(h, cuts, axis=-1)
    o_a = window_gqa_attention(qa.reshape(bsz, s_len, A_HEADS, HEAD_DIM),
                               ka.reshape(bsz, s_len, A_KV_HEADS, HEAD_DIM),
                               va.reshape(bsz, s_len, A_KV_HEADS, HEAD_DIM), a_sink)
    o_b = neighbourhood_attention(qb.reshape(bsz, s_len, B_HEADS, HEAD_DIM),
                                  kb.reshape(bsz, s_len, B_HEADS, HEAD_DIM),
                                  vb.reshape(bsz, s_len, B_HEADS, HEAD_DIM), b_rel_bias)
    o_c = mla_attention(cq, ckv, kr, c_q_norm, c_kv_norm, c_w_uq, c_w_ukv)
    o = jnp.concatenate([rms_norm(o_a, out_norm[:A_Q]),
                         rms_norm(o_b, out_norm[A_Q:A_Q + B_W]),
                         rms_norm(o_c, out_norm[A_Q + B_W:])], axis=-1)
    return o @ w_o


def peer_ffn(x, w_q, sub_keys, u, vv):
    bsz, s_len, d = x.shape
    q = (x @ w_q).reshape(bsz, s_len, PEER_HEADS, 2, PEER_KEY_DIM // 2).astype(jnp.float32)
    s = jnp.einsum('bshcd,cnd->bshcn', q, sub_keys.astype(jnp.float32))
    top_s, top_i = lax.top_k(s, PEER_TOPK)
    cand_s = (top_s[..., 0, :, None] + top_s[..., 1, None, :]).reshape(bsz, s_len, PEER_HEADS, PEER_TOPK * PEER_TOPK)
    cand_i = (top_i[..., 0, :, None] * PEER_KEYS + top_i[..., 1, None, :]).reshape(bsz, s_len, PEER_HEADS, PEER_TOPK * PEER_TOPK)
    best_s, best_j = lax.top_k(cand_s, PEER_TOPK)
    idx = jnp.take_along_axis(cand_i, best_j, axis=-1)
    g = jax.nn.softmax(best_s, axis=-1).astype(x.dtype)
    n_tok = bsz * s_len
    n_sel = PEER_HEADS * PEER_TOPK
    xc = x.reshape(n_tok // PEER_CHUNK, PEER_CHUNK, d)
    ic = idx.reshape(n_tok // PEER_CHUNK, PEER_CHUNK, n_sel)
    gc = g.reshape(n_tok // PEER_CHUNK, PEER_CHUNK, n_sel)

    def chunk(args):
        xt, it, gt = args
        a = jnp.einsum('td,tkd->tk', xt, u[it])
        hsel = jax.nn.gelu(a) * gt
        return jnp.einsum('tk,tkd->td', hsel, vv[it])

    y = lax.map(chunk, (xc, ic, gc))
    return y.reshape(bsz, s_len, d)


def setup_inputs(seed: int = 0) -> dict:
    key = jax.random.key(seed)
    ks = jax.random.split(key, 17)
    f32 = jnp.float32

    def nrm(k, shape, scale):
        return jax.random.normal(k, shape, f32) * scale

    def gain(k, shape):
        return 1.0 + 0.05 * jax.random.normal(k, shape, f32)

    return {
        'x': nrm(ks[0], (BATCH, SEQ, D_MODEL), 1.0),
        'ln1': gain(ks[1], (DEPTH, D_MODEL)),
        'w_in': nrm(ks[2], (DEPTH, D_MODEL, D_IN), D_MODEL ** -0.5),
        'a_sink': nrm(ks[3], (DEPTH, A_HEADS), 1.0),
        'b_rel_bias': nrm(ks[4], (DEPTH, B_HEADS, 2 * NB_ROWS_MAX - 1, 2 * NB_COLS - 1), 0.5),
        'c_q_norm': gain(ks[5], (DEPTH, C_Q_RANK)),
        'c_kv_norm': gain(ks[6], (DEPTH, C_KV_RANK)),
        'c_w_uq': nrm(ks[7], (DEPTH, C_Q_RANK, C_HEADS * (C_NOPE + C_ROPE)), C_Q_RANK ** -0.5),
        'c_w_ukv': nrm(ks[8], (DEPTH, C_KV_RANK, C_HEADS * (C_NOPE + C_V)), C_KV_RANK ** -0.5),
        'out_norm': gain(ks[9], (DEPTH, D_MIX)),
        'w_o': nrm(ks[10], (DEPTH, D_MIX, D_MODEL), D_MIX ** -0.5),
        'ln2': gain(ks[11], (DEPTH, D_MODEL)),
        'peer_w_q': nrm(ks[12], (DEPTH, D_MODEL, PEER_HEADS * PEER_KEY_DIM), D_MODEL ** -0.5),
        'peer_sub_keys': nrm(ks[13], (DEPTH, 2, PEER_KEYS, PEER_KEY_DIM // 2), (PEER_KEY_DIM // 2) ** -0.5),
        'peer_u': nrm(ks[14], (DEPTH, PEER_EXPERTS, D_MODEL), D_MODEL ** -0.5),
        'peer_v': nrm(ks[15], (DEPTH, PEER_EXPERTS, D_MODEL), PEER_TOPK ** -0.5),
        'final_norm': gain(ks[16], (D_MODEL,)),
    }


def reference(x, ln1, w_in, a_sink, b_rel_bias, c_q_norm, c_kv_norm, c_w_uq, c_w_ukv, out_norm, w_o,
              ln2, peer_w_q, peer_sub_keys, peer_u, peer_v, final_norm):
    for l in range(DEPTH):
        x = x + hybrid_mixer(rms_norm(x, ln1[l]), w_in[l], a_sink[l], b_rel_bias[l], c_q_norm[l],
                             c_kv_norm[l], c_w_uq[l], c_w_ukv[l], out_norm[l], w_o[l])
        x = x + peer_ffn(rms_norm(x, ln2[l]), peer_w_q[l], peer_sub_keys[l], peer_u[l], peer_v[l])
    return rms_norm(x, final_norm)
```

```cpp
#include <hip/hip_runtime.h>
#include <hip/hip_cooperative_groups.h>
#include <cstdio>
namespace cg = cooperative_groups;

#ifndef MEGA
#define MEGA 1
#endif

#define DI __device__ __forceinline__
typedef unsigned short u16;
typedef unsigned int u32;
using bf16x8 = __attribute__((ext_vector_type(8))) short;
using f32x16 = __attribute__((ext_vector_type(16))) float;
typedef __bf16 bf16x2_t __attribute__((ext_vector_type(2)));
typedef float float2_t __attribute__((ext_vector_type(2)));
typedef unsigned int u32x4 __attribute__((ext_vector_type(4)));
typedef unsigned int u32x2 __attribute__((ext_vector_type(2)));

constexpr int T = 16384, SEQ = 4096, DM = 2048, HLD = 4096;
constexpr int NTHR = 512, NWAVE = 8;
constexpr int NEXP = 16384;
constexpr float EPS = 1e-6f;
constexpr float LOG2E = 1.4426950408889634f;
constexpr float QSCALE_AB = 0.08838834764831845f * LOG2E;
constexpr float QSCALE_C = 0.07216878364870323f * LOG2E;
constexpr float U_SCALE = 90.5f, V_SCALE = 8.f;
constexpr int LDT = 72;
constexpr int GEMM_STAGE = 512 * LDT;
constexpr int GEMM_SROW_OFF = 2 * GEMM_STAGE * 2;
constexpr int SMEM_BYTES = 256 * 132 * 4 + 256 * 16 * 4;

#define MFMA32(a, b, c) __builtin_amdgcn_mfma_f32_32x32x16_bf16((a), (b), (c), 0, 0, 0)

constexpr size_t al256(size_t x) { return (x + 255) & ~(size_t)255; }
constexpr size_t OFF_wt_in = 0;
constexpr size_t OFF_wt_o = OFF_wt_in + al256((size_t)2 * HLD * 2048 * 2);
constexpr size_t OFF_wt_pq = OFF_wt_o + al256((size_t)2 * 2048 * 2048 * 2);
constexpr size_t OFF_wt_uq = OFF_wt_pq + al256((size_t)2 * 1024 * 2048 * 2);
constexpr size_t OFF_wt_ukv = OFF_wt_uq + al256((size_t)2 * 768 * 512 * 2);
constexpr size_t OFF_keys_b = OFF_wt_ukv + al256((size_t)2 * 1024 * 256 * 2);
constexpr size_t OFF_ub = OFF_keys_b + al256((size_t)2 * 256 * 128 * 2);
constexpr size_t OFF_vb = OFF_ub + al256((size_t)2 * NEXP * 1024);
constexpr size_t OFF_ropeC = OFF_vb + al256((size_t)2 * NEXP * 1024);
constexpr size_t OFF_ropeS = OFF_ropeC + al256((size_t)SEQ * 32 * 4);
constexpr size_t OFF_xres = OFF_ropeS + al256((size_t)SEQ * 32 * 4);
constexpr size_t OFF_xb = OFF_xres + al256((size_t)T * 2048 * 4);
constexpr size_t OFF_h = OFF_xb + al256((size_t)T * 2048 * 2);
constexpr size_t OFF_vtA = OFF_h + al256((size_t)T * HLD * 2);
constexpr size_t OFF_vtB = OFF_vtA + al256((size_t)T * 256 * 2);
constexpr size_t OFF_kmla = OFF_vtB + al256((size_t)T * 512 * 2);
constexpr size_t OFF_vtC = OFF_kmla + al256((size_t)T * 4 * 192 * 2);
constexpr size_t OFF_qmla = OFF_vtC + al256((size_t)T * 512 * 2);
constexpr size_t OFF_o = OFF_qmla + al256((size_t)T * 4 * 192 * 2);
constexpr size_t OFF_on = OFF_o + al256((size_t)T * 2048 * 2);
constexpr size_t OFF_ssqh = OFF_on + al256((size_t)T * 2048 * 2);
constexpr size_t OFF_END1 = OFF_ssqh + al256((size_t)T * 16 * 4);
constexpr size_t OFF_pq = OFF_h;
constexpr size_t OFF_scores = OFF_pq + al256((size_t)T * 1024 * 2);
constexpr size_t OFF_idx = OFF_scores + al256((size_t)T * 8 * 256 * 4);
constexpr size_t OFF_g = OFF_idx + al256((size_t)T * 128 * 4);
constexpr size_t OFF_END2 = OFF_g + al256((size_t)T * 128 * 4);
constexpr size_t WS_NEED = OFF_END1 > OFF_END2 ? OFF_END1 : OFF_END2;

struct Params {
  const float *x, *ln1, *w_in, *a_sink, *b_rel, *cqn, *ckvn, *wuq, *wukv, *onorm, *wo, *ln2, *pwq, *pkeys, *pu, *pv, *fnorm;
  float* out;
  char* ws;
  DI u16* wt_in() const { return (u16*)(ws + OFF_wt_in); }
  DI u16* wt_o() const { return (u16*)(ws + OFF_wt_o); }
  DI u16* wt_pq() const { return (u16*)(ws + OFF_wt_pq); }
  DI u16* wt_uq() const { return (u16*)(ws + OFF_wt_uq); }
  DI u16* wt_ukv() const { return (u16*)(ws + OFF_wt_ukv); }
  DI u16* keys_b() const { return (u16*)(ws + OFF_keys_b); }
  DI unsigned char* ub() const { return (unsigned char*)(ws + OFF_ub); }
  DI unsigned char* vb() const { return (unsigned char*)(ws + OFF_vb); }
  DI float* ropeC() const { return (float*)(ws + OFF_ropeC); }
  DI float* ropeS() const { return (float*)(ws + OFF_ropeS); }
  DI float* xres() const { return (float*)(ws + OFF_xres); }
  DI u16* xb() const { return (u16*)(ws + OFF_xb); }
  DI u16* h() const { return (u16*)(ws + OFF_h); }
  DI u16* vtA() const { return (u16*)(ws + OFF_vtA); }
  DI u16* vtB() const { return (u16*)(ws + OFF_vtB); }
  DI u16* kmla() const { return (u16*)(ws + OFF_kmla); }
  DI u16* vtC() const { return (u16*)(ws + OFF_vtC); }
  DI u16* qmla() const { return (u16*)(ws + OFF_qmla); }
  DI u16* o() const { return (u16*)(ws + OFF_o); }
  DI u16* on() const { return (u16*)(ws + OFF_on); }
  DI float* ssqh() const { return (float*)(ws + OFF_ssqh); }
  DI u16* pq() const { return (u16*)(ws + OFF_pq); }
  DI float* scores() const { return (float*)(ws + OFF_scores); }
  DI int* idx() const { return (int*)(ws + OFF_idx); }
  DI float* g() const { return (float*)(ws + OFF_g); }
};

DI int otid() { int t = threadIdx.x; asm volatile("" : "+v"(t)); return t; }
DI int obid() { int b = blockIdx.x; asm volatile("" : "+s"(b)); return b; }
DI u16 f2bf(float x) {
  u32 u = __float_as_uint(x);
  u += 0x7fffu + ((u >> 16) & 1u);
  return (u16)(u >> 16);
}
DI u32 pack2bf(float a, float b) {
  float2_t f = {a, b};
  bf16x2_t r = __builtin_convertvector(f, bf16x2_t);
  return __builtin_bit_cast(u32, r);
}
DI float bf_lo(u32 w) { return __uint_as_float(w << 16); }
DI float bf_hi(u32 w) { return __uint_as_float(w & 0xffff0000u); }
DI int crow(int r, int h) { return (r & 3) + 8 * (r >> 2) + 4 * h; }
DI float wave_sum(float v) {
#pragma unroll
  for (int o = 32; o >= 1; o >>= 1) v += __shfl_xor(v, o);
  return v;
}
DI float ssq8(u32x4 w) {
  float s = 0.f, a;
  a = bf_lo(w.x); s += a * a; a = bf_hi(w.x); s += a * a;
  a = bf_lo(w.y); s += a * a; a = bf_hi(w.y); s += a * a;
  a = bf_lo(w.z); s += a * a; a = bf_hi(w.z); s += a * a;
  a = bf_lo(w.w); s += a * a; a = bf_hi(w.w); s += a * a;
  return s;
}
DI bool gemm_tile_map(int it, int MT, int NT, int& mt, int& nt) {
  const int b = obid(), x = b & 7, nb = gridDim.x >> 3;
  const int li = it * nb + (b >> 3);
  const int nrn = (NT + 7) >> 3, nrect = (MT >> 3) * nrn;
  const int q = x + 8 * (li >> 6);
  if (q >= nrect) { mt = -1; nt = 0; return false; }
  const int in = li & 63;
  mt = (q / nrn) * 8 + (in >> 3);
  nt = (q % nrn) * 8 + (in & 7);
  return nt < NT;
}

constexpr int GM = 256, GN = 256;
DI u32x4 scale8(u32x4 w, float sc) {
  w.x = pack2bf(bf_lo(w.x) * sc, bf_hi(w.x) * sc);
  w.y = pack2bf(bf_lo(w.y) * sc, bf_hi(w.y) * sc);
  w.z = pack2bf(bf_lo(w.z) * sc, bf_hi(w.z) * sc);
  w.w = pack2bf(bf_lo(w.w) * sc, bf_hi(w.w) * sc);
  return w;
}
template <bool ROWNORM, bool CONV = false, bool ASCALE = false>
DI void gemm_mainloop(const u16* __restrict__ Ag, int lda, const u16* __restrict__ Bg, int ldb, int K, char* smem,
                      f32x16 (&acc)[4][2], const float4* __restrict__ csrc = nullptr, u16* __restrict__ cdst = nullptr,
                      float cscale = 1.f) {
  u16* sbase = (u16*)smem;
  float* sRow = (float*)(smem + GEMM_SROW_OFF);
  const int tid = otid(), lane = tid & 63, wid = tid >> 6;
  const int wm = wid >> 2, wn = wid & 3, hh = lane >> 5, l31 = lane & 31;
  const int lr = tid >> 3, lc = (tid & 7) * 8;
#pragma unroll
  for (int i = 0; i < 4; ++i)
#pragma unroll
    for (int j = 0; j < 2; ++j)
#pragma unroll
      for (int r = 0; r < 16; ++r) acc[i][j][r] = 0.f;
  u32x4 ra[4], rb[4];
  float ssq[4] = {0.f, 0.f, 0.f, 0.f};
  const u16* ap = Ag + (size_t)lr * lda + lc;
  const u16* bp = Bg + (size_t)lr * ldb + lc;
#pragma unroll
  for (int i = 0; i < 4; ++i) {
    ra[i] = *(const u32x4*)(ap + (size_t)(64 * i) * lda);
    rb[i] = *(const u32x4*)(bp + (size_t)(64 * i) * ldb);
  }
  __syncthreads();
#pragma unroll
  for (int i = 0; i < 4; ++i) {
    if (ASCALE) ra[i] = scale8(ra[i], sRow[(lr + 64 * i) * 4 + 0]);
    *(u32x4*)(sbase + (lr + 64 * i) * LDT + lc) = ra[i];
    *(u32x4*)(sbase + (256 + lr + 64 * i) * LDT + lc) = rb[i];
    if (ROWNORM) ssq[i] += ssq8(ra[i]);
  }
  __syncthreads();
  const int nk = K >> 6;
#pragma unroll 1
  for (int kt = 0; kt < nk; ++kt) {
    const int cur = kt & 1;
    const bool more = (kt + 1 < nk);
    const int kn = more ? kt + 1 : kt;
    float4 cv;
    if (CONV) cv = csrc[(size_t)kt * NTHR + tid];
#pragma unroll
    for (int i = 0; i < 4; ++i) {
      ra[i] = *(const u32x4*)(ap + (size_t)(64 * i) * lda + kn * 64);
      rb[i] = *(const u32x4*)(bp + (size_t)(64 * i) * ldb + kn * 64);
    }
    const u16* a_s = sbase + cur * GEMM_STAGE + (wm * 128 + l31) * LDT + hh * 8;
    const u16* b_s = sbase + cur * GEMM_STAGE + (256 + wn * 64 + l31) * LDT + hh * 8;
#pragma unroll
    for (int ks = 0; ks < 4; ++ks) {
      const bf16x8 b0 = *(const bf16x8*)(b_s + ks * 16);
      const bf16x8 b1 = *(const bf16x8*)(b_s + 32 * LDT + ks * 16);
      bf16x8 a0[4];
#pragma unroll
      for (int i = 0; i < 4; ++i) a0[i] = *(const bf16x8*)(a_s + i * 32 * LDT + ks * 16);
      __builtin_amdgcn_s_setprio(1);
#pragma unroll
      for (int i = 0; i < 4; ++i) {
        acc[i][0] = MFMA32(a0[i], b0, acc[i][0]);
        acc[i][1] = MFMA32(a0[i], b1, acc[i][1]);
      }
      __builtin_amdgcn_s_setprio(0);
    }
    {
      u16* w = sbase + (cur ^ 1) * GEMM_STAGE;
      const int g = (kn < 16) ? 0 : (kn < 24 ? 1 : 2);
#pragma unroll
      for (int i = 0; i < 4; ++i) {
        if (ASCALE) ra[i] = scale8(ra[i], sRow[(lr + 64 * i) * 4 + g]);
        *(u32x4*)(w + (lr + 64 * i) * LDT + lc) = ra[i];
        *(u32x4*)(w + (256 + lr + 64 * i) * LDT + lc) = rb[i];
        if (ROWNORM) ssq[i] += more ? ssq8(ra[i]) : 0.f;
      }
    }
    if (CONV) {
      u32 w4 = 0;
      w4 = __builtin_amdgcn_cvt_scalef32_pk_fp4_f32(w4, cv.x * cscale, cv.y * cscale, 1.0f, 0);
      w4 = __builtin_amdgcn_cvt_scalef32_pk_fp4_f32(w4, cv.z * cscale, cv.w * cscale, 1.0f, 1);
      cdst[(size_t)kt * NTHR + tid] = (u16)w4;
    }
    __syncthreads();
  }
  if (ROWNORM) {
#pragma unroll
    for (int i = 0; i < 4; ++i) {
      float s = ssq[i];
      s += __shfl_xor(s, 1);
      s += __shfl_xor(s, 2);
      s += __shfl_xor(s, 4);
      if ((tid & 7) == 0) sRow[lr + 64 * i] = rsqrtf(s / (float)K + EPS);
    }
    __syncthreads();
  }
}

DI void conv_transpose_all(const Params& p, char* smem) {
  const int lane = otid() & 63, wid = otid() >> 6;
  float* s = (float*)smem + wid * (64 * 65);
  constexpr int T0 = 32 * 61, T1 = T0 + 32 * 32, T2 = T1 + 32 * 16, T3 = T2 + 8 * 12, T4 = T3 + 4 * 16;
  for (int f = obid() * NWAVE + wid; f < 2 * T4; f += gridDim.x * NWAVE) {
    const int L = f / T4, r = f % T4;
    const float* W; const float* g; u16* Wt; int K, N, tile;
    if (r < T0)      { W = p.w_in + (size_t)L * 2048 * 3904; g = p.ln1 + L * 2048;   Wt = p.wt_in() + (size_t)L * HLD * 2048;   K = 2048; N = 3904; tile = r; }
    else if (r < T1) { W = p.wo + (size_t)L * 2048 * 2048;   g = p.onorm + L * 2048; Wt = p.wt_o() + (size_t)L * 2048 * 2048;   K = 2048; N = 2048; tile = r - T0; }
    else if (r < T2) { W = p.pwq + (size_t)L * 2048 * 1024;  g = p.ln2 + L * 2048;   Wt = p.wt_pq() + (size_t)L * 1024 * 2048;  K = 2048; N = 1024; tile = r - T1; }
    else if (r < T3) { W = p.wuq + (size_t)L * 512 * 768;    g = p.cqn + L * 512;    Wt = p.wt_uq() + (size_t)L * 768 * 512;    K = 512;  N = 768;  tile = r - T2; }
    else             { W = p.wukv + (size_t)L * 256 * 1024;  g = p.ckvn + L * 256;   Wt = p.wt_ukv() + (size_t)L * 1024 * 256;  K = 256;  N = 1024; tile = r - T3; }
    const int ntn = N / 64;
    const int k0 = (tile / ntn) * 64, n0 = (tile % ntn) * 64;
#pragma unroll
    for (int kb = 0; kb < 64; kb += 32) {
      float tv[32];
#pragma unroll
      for (int kk = 0; kk < 32; ++kk) tv[kk] = W[(size_t)(k0 + kb + kk) * N + n0 + lane];
#pragma unroll
      for (int kk = 0; kk < 32; ++kk) s[(kb + kk) * 65 + lane] = tv[kk] * g[k0 + kb + kk];
    }
    __builtin_amdgcn_fence(__ATOMIC_RELEASE, "wavefront");
    __builtin_amdgcn_wave_barrier();
    __builtin_amdgcn_fence(__ATOMIC_ACQUIRE, "wavefront");
#pragma unroll 8
    for (int nn = 0; nn < 64; ++nn) Wt[(size_t)(n0 + nn) * K + k0 + lane] = f2bf(s[lane * 65 + nn]);
    __builtin_amdgcn_fence(__ATOMIC_RELEASE, "wavefront");
    __builtin_amdgcn_wave_barrier();
    __builtin_amdgcn_fence(__ATOMIC_ACQUIRE, "wavefront");
  }
}
DI void conv_flat(const float* __restrict__ src, u16* __restrict__ dst, size_t n4) {
  for (size_t i0 = (size_t)obid() * (NTHR * 8) + otid(); i0 < n4; i0 += (size_t)gridDim.x * (NTHR * 8)) {
    float4 v[8];
#pragma unroll
    for (int j = 0; j < 8; ++j) {
      const size_t i = i0 + (size_t)j * NTHR;
      v[j] = (i < n4) ? ((const float4*)src)[i] : float4{0.f, 0.f, 0.f, 0.f};
    }
#pragma unroll
    for (int j = 0; j < 8; ++j) {
      const size_t i = i0 + (size_t)j * NTHR;
      if (i < n4) {
        u32x2 w = {pack2bf(v[j].x, v[j].y), pack2bf(v[j].z, v[j].w)};
        ((u32x2*)dst)[i] = w;
      }
    }
  }
}
DI void conv_fp4(const float* __restrict__ src, unsigned char* __restrict__ dst, size_t n8, float sc) {
  for (size_t i = (size_t)obid() * NTHR + otid(); i < n8; i += (size_t)gridDim.x * NTHR) {
    const float4 a = ((const float4*)src)[i * 2 + 0], b = ((const float4*)src)[i * 2 + 1];
    u32 w = 0;
    w = __builtin_amdgcn_cvt_scalef32_pk_fp4_f32(w, a.x * sc, a.y * sc, 1.0f, 0);
    w = __builtin_amdgcn_cvt_scalef32_pk_fp4_f32(w, a.z * sc, a.w * sc, 1.0f, 1);
    w = __builtin_amdgcn_cvt_scalef32_pk_fp4_f32(w, b.x * sc, b.y * sc, 1.0f, 2);
    w = __builtin_amdgcn_cvt_scalef32_pk_fp4_f32(w, b.z * sc, b.w * sc, 1.0f, 3);
    ((u32*)dst)[i] = w;
  }
}
DI void phase_prologue(const Params& p, char* smem) {
  __syncthreads();
  conv_transpose_all(p, smem);
  for (int L = 0; L < 2; ++L) {
    u16* pad = p.wt_in() + (size_t)L * HLD * 2048 + (size_t)3904 * 2048;
    for (int i = obid() * NTHR + otid(); i < 192 * 2048 / 8; i += gridDim.x * NTHR) ((u32x4*)pad)[i] = u32x4{0, 0, 0, 0};
  }
  for (int i = obid() * NTHR + otid(); i < 2 * 256 * 128; i += gridDim.x * NTHR) {
    const int L = i >> 15, n = (i >> 7) & 255, k = i & 127;
    const int c = n >> 7, kin = k - 64 * c;
    const float v = (kin >= 0 && kin < 64) ? p.pkeys[((size_t)(L * 2 + c) * 128 + (n & 127)) * 64 + kin] : 0.f;
    p.keys_b()[i] = f2bf(v);
  }
  conv_flat(p.x, p.xb(), (size_t)T * 2048 / 4);
  for (int i = obid() * NTHR + otid(); i < SEQ * 32; i += gridDim.x * NTHR) {
    const int pos = i >> 5, f = i & 31;
    const float inv = powf(10000.0f, -(float)f / 32.0f);
    const float ang = (float)pos * inv;
    p.ropeC()[i] = cosf(ang);
    p.ropeS()[i] = sinf(ang);
  }
}

#define EPI_IDS                                                                                     \
  const int etid = otid();                                                                          \
  const int lane = etid & 63, wid = etid >> 6, wm = wid >> 2, wn = wid & 3, hh = lane >> 5, l31 = lane & 31;

DI void phase_gemm1(const Params& p, int L, char* smem) {
  const u16* Wt = p.wt_in() + (size_t)L * HLD * 2048;
  const float* sRow = (const float*)(smem + GEMM_SROW_OFF);
  for (int it = 0;; ++it) {
    int mt, nt;
    if (!gemm_tile_map(it, 64, 16, mt, nt)) { if (mt < 0) break; continue; }
    f32x16 acc[4][2];
    const int tile_id = mt * 16 + nt;
    const bool isv = tile_id >= 512;
    const float4* csrc = (const float4*)((isv ? p.pv : p.pu) + (size_t)L * NEXP * 2048) + (size_t)(tile_id & 511) * 32 * NTHR;
    u16* cdst = (u16*)((isv ? p.vb() : p.ub()) + (size_t)L * NEXP * 1024) + (size_t)(tile_id & 511) * 32 * NTHR;
    gemm_mainloop<true, true>(p.xb() + (size_t)mt * GM * 2048, 2048, Wt + (size_t)nt * GN * 2048, 2048, 2048, smem, acc, csrc, cdst,
                              isv ? V_SCALE : U_SCALE);
    EPI_IDS
    const int nt128 = nt * 2 + (wn >> 1), wn1 = wn & 1;
    const int m0 = mt * GM, b = m0 >> 12, s0 = m0 & 4095;
    if (nt128 >= 30) {
      if (nt128 == 30 && wn1 == 0) {
#pragma unroll
        for (int i = 0; i < 4; ++i)
#pragma unroll
          for (int r = 0; r < 16; ++r) {
            const int rl = wm * 128 + i * 32 + crow(r, hh);
            const float rs = sRow[rl];
            const float x1 = acc[i][0][r] * rs, x2 = acc[i][1][r] * rs;
            const int pos = s0 + rl;
            const float c = p.ropeC()[pos * 32 + l31], sn = p.ropeS()[pos * 32 + l31];
            const u16 o1 = f2bf(x1 * c - x2 * sn), o2 = f2bf(x1 * sn + x2 * c);
#pragma unroll
            for (int hd = 0; hd < 4; ++hd) {
              u16* kr = p.kmla() + ((size_t)(b * 4 + hd) * 4096 + pos) * 192 + 128;
              kr[l31] = o1;
              kr[32 + l31] = o2;
            }
            if ((r & 3) == 3) __builtin_amdgcn_sched_barrier(0);
          }
      }
    } else if (nt128 == 10 || nt128 == 11 || (nt128 >= 20 && nt128 < 24)) {
      u16* vt;
      int nh, hd;
      if (nt128 < 12) { vt = p.vtA(); nh = 2; hd = nt128 - 10; } else { vt = p.vtB(); nh = 4; hd = nt128 - 20; }
#pragma unroll
      for (int i = 0; i < 4; ++i)
#pragma unroll
        for (int j = 0; j < 2; ++j)
#pragma unroll
          for (int g4 = 0; g4 < 4; ++g4) {
            const int rl0 = wm * 128 + i * 32 + 8 * g4 + 4 * hh;
            const int d = wn1 * 64 + j * 32 + l31;
            const float v0 = acc[i][j][4 * g4 + 0] * sRow[rl0 + 0], v1 = acc[i][j][4 * g4 + 1] * sRow[rl0 + 1];
            const float v2 = acc[i][j][4 * g4 + 2] * sRow[rl0 + 2], v3 = acc[i][j][4 * g4 + 3] * sRow[rl0 + 3];
            u32x2 w = {pack2bf(v0, v1), pack2bf(v2, v3)};
            *(u32x2*)(vt + ((size_t)(b * nh + hd) * 128 + d) * 4096 + s0 + rl0) = w;
          }
    } else {
      const float sc = (nt128 < 8 || (nt128 >= 12 && nt128 < 16)) ? QSCALE_AB : 1.f;
#pragma unroll
      for (int i = 0; i < 4; ++i)
#pragma unroll
        for (int j = 0; j < 2; ++j)
#pragma unroll
          for (int r = 0; r < 16; ++r) {
            const int rl = wm * 128 + i * 32 + crow(r, hh);
            p.h()[(size_t)(m0 + rl) * HLD + nt128 * 128 + wn1 * 64 + j * 32 + l31] = f2bf(acc[i][j][r] * sRow[rl] * sc);
          }
    }
  }
}

DI void tile_upq(const Params& p, int L, int tile, char* smem) {
  const float* sRow = (const float*)(smem + GEMM_SROW_OFF);
  const int mt = tile / 3, nt = tile % 3;
  f32x16 acc[4][2];
  gemm_mainloop<true>(p.h() + (size_t)mt * GM * HLD + 3072, HLD, p.wt_uq() + (size_t)L * 768 * 512 + (size_t)nt * GN * 512, 512, 512,
                      smem, acc);
  EPI_IDS
  const int m0 = mt * GM, b = m0 >> 12, s0 = m0 & 4095;
  const int nb64 = nt * 4 + wn;
  const int head = nb64 / 3, part = nb64 % 3;
#pragma unroll
  for (int i = 0; i < 4; ++i)
#pragma unroll
    for (int j = 0; j < 2; ++j)
#pragma unroll
      for (int r = 0; r < 16; ++r) {
        const int rl = wm * 128 + i * 32 + crow(r, hh);
        const int pos = s0 + rl;
        p.qmla()[((size_t)(b * 4 + head) * 4096 + pos) * 192 + part * 64 + j * 32 + l31] = f2bf(acc[i][j][r] * sRow[rl] * QSCALE_C);
      }
}

DI void tile_upkv(const Params& p, int L, int tile, char* smem) {
  const float* sRow = (const float*)(smem + GEMM_SROW_OFF);
  const int mt = tile >> 2, nt = tile & 3;
  f32x16 acc[4][2];
  gemm_mainloop<true>(p.h() + (size_t)mt * GM * HLD + 3584, HLD, p.wt_ukv() + (size_t)L * 1024 * 256 + (size_t)nt * GN * 256, 256, 256,
                      smem, acc);
  EPI_IDS
  const int nt128 = nt * 2 + (wn >> 1), wn1 = wn & 1;
  const int m0 = mt * GM, b = m0 >> 12, s0 = m0 & 4095;
  const int head = nt128 >> 1;
  if (nt128 & 1) {
#pragma unroll
    for (int i = 0; i < 4; ++i)
#pragma unroll
      for (int j = 0; j < 2; ++j)
#pragma unroll
        for (int g4 = 0; g4 < 4; ++g4) {
          const int rl0 = wm * 128 + i * 32 + 8 * g4 + 4 * hh;
          const int d = wn1 * 64 + j * 32 + l31;
          const float v0 = acc[i][j][4 * g4 + 0] * sRow[rl0 + 0], v1 = acc[i][j][4 * g4 + 1] * sRow[rl0 + 1];
          const float v2 = acc[i][j][4 * g4 + 2] * sRow[rl0 + 2], v3 = acc[i][j][4 * g4 + 3] * sRow[rl0 + 3];
          u32x2 w = {pack2bf(v0, v1), pack2bf(v2, v3)};
          *(u32x2*)(p.vtC() + ((size_t)(b * 4 + head) * 128 + d) * 4096 + s0 + rl0) = w;
        }
  } else {
#pragma unroll
    for (int i = 0; i < 4; ++i)
#pragma unroll
      for (int j = 0; j < 2; ++j)
#pragma unroll
        for (int r = 0; r < 16; ++r) {
          const int rl = wm * 128 + i * 32 + crow(r, hh);
          const int pos = s0 + rl;
          p.kmla()[((size_t)(b * 4 + head) * 4096 + pos) * 192 + wn1 * 64 + j * 32 + l31] = f2bf(acc[i][j][r] * sRow[rl]);
        }
  }
}

DI void phase_gemm_o(const Params& p, int L, char* smem) {
  const u16* Wt = p.wt_o() + (size_t)L * 2048 * 2048;
  const float* xin = (L == 0) ? p.x : p.xres();
  for (int it = 0;; ++it) {
    int mt, nt;
    if (!gemm_tile_map(it, 64, 8, mt, nt)) { if (mt < 0) break; continue; }
    f32x16 acc[4][2];
    {
      float* sRow = (float*)(smem + GEMM_SROW_OFF);
      const int t = otid();
      __syncthreads();
      if (t < 256) {
        const float4* sp = (const float4*)(p.ssqh() + (size_t)(mt * GM + t) * 16);
        const float4 a0 = sp[0], a1 = sp[1], b0 = sp[2], c0 = sp[3];
        sRow[t * 4 + 0] = rsqrtf((a0.x + a0.y + a0.z + a0.w + a1.x + a1.y + a1.z + a1.w) * (1.f / 1024.f) + EPS);
        sRow[t * 4 + 1] = rsqrtf((b0.x + b0.y + b0.z + b0.w) * (1.f / 512.f) + EPS);
        sRow[t * 4 + 2] = rsqrtf((c0.x + c0.y + c0.z + c0.w) * (1.f / 512.f) + EPS);
      }
    }
    gemm_mainloop<false, false, true>(p.o() + (size_t)mt * GM * 2048, 2048, Wt + (size_t)nt * GN * 2048, 2048, 2048, smem, acc);
    EPI_IDS
#pragma unroll
    for (int i = 0; i < 4; ++i)
#pragma unroll
      for (int j = 0; j < 2; ++j)
#pragma unroll
        for (int r = 0; r < 16; ++r) {
          const size_t off = (size_t)(mt * GM + wm * 128 + i * 32 + crow(r, hh)) * 2048 + nt * GN + wn * 64 + j * 32 + l31;
          const float v = xin[off] + acc[i][j][r];
          p.xres()[off] = v;
          p.xb()[off] = f2bf(v);
        }
  }
}

DI void phase_gemm_pq(const Params& p, int L, char* smem) {
  const u16* Wt = p.wt_pq() + (size_t)L * 1024 * 2048;
  const float* sRow = (const float*)(smem + GEMM_SROW_OFF);
  for (int tile = obid(); tile < 64 * 4; tile += gridDim.x) {
    const int mt = tile >> 2, nt = tile & 3;
    f32x16 acc[4][2];
    gemm_mainloop<true>(p.xb() + (size_t)mt * GM * 2048, 2048, Wt + (size_t)nt * GN * 2048, 2048, 2048, smem, acc);
    EPI_IDS
#pragma unroll
    for (int i = 0; i < 4; ++i)
#pragma unroll
      for (int j = 0; j < 2; ++j)
#pragma unroll
        for (int r = 0; r < 16; ++r) {
          const int rl = wm * 128 + i * 32 + crow(r, hh);
          p.pq()[(size_t)(mt * GM + rl) * 1024 + nt * GN + wn * 64 + j * 32 + l31] = f2bf(acc[i][j][r] * sRow[rl]);
        }
  }
}

DI void phase_gemm_scores(const Params& p, int L, char* smem) {
  for (int mt = obid(); mt < 512; mt += gridDim.x) {
    f32x16 acc[4][2];
    gemm_mainloop<false>(p.pq() + (size_t)mt * GM * 128, 128, p.keys_b() + (size_t)L * 256 * 128, 128, 128, smem, acc);
    EPI_IDS
#pragma unroll
    for (int i = 0; i < 4; ++i)
#pragma unroll
      for (int j = 0; j < 2; ++j)
#pragma unroll
        for (int r = 0; r < 16; ++r) {
          const int rl = wm * 128 + i * 32 + crow(r, hh);
          p.scores()[(size_t)(mt * GM + rl) * 256 + wn * 64 + j * 32 + l31] = acc[i][j][r];
        }
  }
}

template <int DQK, int MODE>
DI void attn_block(char* smem, const u16* __restrict__ Q, int ldq, const u16* __restrict__ Kb, int ldk,
                   const u16* __restrict__ Vt, int t0, int t1, int qpos0, float slope2, float sink2,
                   const float* __restrict__ biasTbl, u16* __restrict__ Oout, float* __restrict__ ssq_out,
                   const float* __restrict__ ropeCS = nullptr) {
  constexpr int LDK = DQK + 8;
  constexpr int NCH = DQK / 8;
  constexpr int KCH = NCH / 8;
  constexpr int NKS = DQK / 16;
  constexpr int STG = 64 * LDK + 128 * 68;
  u16* sbase = (u16*)smem;
  float* sBias = (float*)(sbase + 2 * STG);
  const int tid = otid(), lane = tid & 63, wid = tid >> 6, hh = lane >> 5, l31 = lane & 31;

  __syncthreads();
  if (MODE == 1) {
    for (int i = tid; i < 465; i += NTHR) sBias[i] = biasTbl[i] * LOG2E;
  }
  bf16x8 qf[NKS];
  {
    const u16* qrow = Q + (size_t)(wid * 32 + l31) * ldq + hh * 8;
#pragma unroll
    for (int ks = 0; ks < NKS; ++ks) qf[ks] = *(const bf16x8*)(qrow + ks * 16);
  }
  if (MODE == 2) {
    const int pos = qpos0 + wid * 32 + l31;
#pragma unroll
    for (int k2 = 0; k2 < 2; ++k2) {
      const float* cp = ropeCS + (size_t)pos * 32 + k2 * 16 + 8 * hh;
      const float* sp = ropeCS + (size_t)SEQ * 32 + (size_t)pos * 32 + k2 * 16 + 8 * hh;
#pragma unroll
      for (int j = 0; j < 8; ++j) {
        const float c = cp[j], sn = sp[j];
        const float x1 = __uint_as_float(((u32)(u16)qf[NKS - 4 + k2][j]) << 16);
        const float x2 = __uint_as_float(((u32)(u16)qf[NKS - 2 + k2][j]) << 16);
        qf[NKS - 4 + k2][j] = (short)f2bf(x1 * c - x2 * sn);
        qf[NKS - 2 + k2][j] = (short)f2bf(x1 * sn + x2 * c);
      }
    }
  }
  float m_run = (MODE == 0) ? sink2 : -1e30f;
  float l_run = (MODE == 0 && hh == 0) ? 1.f : 0.f;
  f32x16 oacc[4];
#pragma unroll
  for (int d = 0; d < 4; ++d)
#pragma unroll
    for (int r = 0; r < 16; ++r) oacc[d][r] = 0.f;

  const int widu = __builtin_amdgcn_readfirstlane(wid);
  const int qw0 = qpos0 + widu * 32;
  const int qpos = qw0 + l31;
  const int rq = (qpos0 >> 6) + (widu >> 1);
  const int rsq = min(max(rq - 4, 0), 56);
  const int cq = (wid & 1) * 32 + l31;
  const int cs = min(max(cq - 8, 0), 48);

  u32x4 rk[KCH], rv[2];
#define ATTN_LOAD_TILE(TT)                                                              \
  {                                                                                     \
    _Pragma("unroll") for (int i = 0; i < KCH; ++i) {                                   \
      const int c = tid + NTHR * i;                                                     \
      const int rr = c / NCH, cc = c % NCH;                                             \
      rk[i] = *(const u32x4*)(Kb + (size_t)((TT) * 64 + rr) * ldk + cc * 8);            \
    }                                                                                   \
    _Pragma("unroll") for (int i = 0; i < 2; ++i) {                                     \
      const int c = tid + NTHR * i;                                                     \
      const int d = c >> 3, part = c & 7;                                               \
      rv[i] = *(const u32x4*)(Vt + (size_t)d * 4096 + (TT) * 64 + part * 8);            \
    }                                                                                   \
  }
#define ATTN_STORE_TILE(STAGE)                                                          \
  {                                                                                     \
    u16* sKw = sbase + (STAGE) * STG;                                                   \
    u16* sVw = sKw + 64 * LDK;                                                          \
    _Pragma("unroll") for (int i = 0; i < KCH; ++i) {                                   \
      const int c = tid + NTHR * i;                                                     \
      const int rr = c / NCH, cc = c % NCH;                                             \
      *(u32x4*)(sKw + rr * LDK + cc * 8) = rk[i];                                       \
    }                                                                                   \
    _Pragma("unroll") for (int i = 0; i < 2; ++i) {                                     \
      const int c = tid + NTHR * i;                                                     \
      const int d = c >> 3, part = c & 7;                                               \
      *(u32x2*)(sVw + d * 68 + part * 8) = u32x2{rv[i].x, rv[i].y};                     \
      *(u32x2*)(sVw + d * 68 + part * 8 + 4) = u32x2{rv[i].z, rv[i].w};                 \
    }                                                                                   \
  }
  ATTN_LOAD_TILE(t0)
  ATTN_STORE_TILE(0)
  __syncthreads();
#pragma unroll 1
  for (int t = t0; t < t1; ++t) {
    const int cur = (t - t0) & 1;
    {
      const int tn = (t + 1 < t1) ? t + 1 : t;
      ATTN_LOAD_TILE(tn)
    }
    const u16* sK = sbase + cur * STG;
    const u16* sV = sK + 64 * LDK;
    bool relevant = true;
    if (MODE == 0) relevant = (t * 64 <= qw0 + 31 + 128) && (t * 64 + 63 >= qw0 - 128);
    if (MODE == 1) relevant = (t >= rsq) && (t < rsq + 8);
    if (relevant) {
      f32x16 sacc[2];
#pragma unroll
      for (int tt = 0; tt < 2; ++tt) {
#pragma unroll
        for (int r = 0; r < 16; ++r) sacc[tt][r] = 0.f;
        const u16* kp = sK + (tt * 32 + l31) * LDK + hh * 8;
#pragma unroll
        for (int ks = 0; ks < NKS; ++ks) {
          bf16x8 kf = *(const bf16x8*)(kp + ks * 16);
          sacc[tt] = MFMA32(kf, qf[ks], sacc[tt]);
        }
      }
      float mx = -INFINITY;
      const int drow = min(max(t - rq + 7, 0), 14) * 31;
#pragma unroll
      for (int tt = 0; tt < 2; ++tt)
#pragma unroll
        for (int r = 0; r < 16; ++r) {
          float sv = sacc[tt][r];
          const int kl = tt * 32 + crow(r, hh);
          if (MODE == 0) {
            const int kpos = t * 64 + kl;
            int dist = qpos - kpos;
            dist = dist < 0 ? -dist : dist;
            sv = (dist <= 128) ? (sv - slope2 * (float)dist) : -INFINITY;
          } else if (MODE == 1) {
            const bool ok = ((unsigned)(kl - cs) < 16u);
            const int dc = min(max(kl - cq + 15, 0), 30);
            sv = ok ? (sv + sBias[drow + dc]) : -INFINITY;
          }
          sacc[tt][r] = sv;
          mx = fmaxf(mx, sv);
        }
      mx = fmaxf(mx, __shfl_xor(mx, 32));
      const float mn = fmaxf(m_run, mx);
      const float alpha = __builtin_amdgcn_exp2f(m_run - mn);
      m_run = mn;
      if (__builtin_amdgcn_ballot_w64(alpha != 1.f) != 0ull) {
#pragma unroll
        for (int d = 0; d < 4; ++d)
#pragma unroll
          for (int r = 0; r < 16; ++r) oacc[d][r] *= alpha;
      }
      float ps = 0.f;
#pragma unroll
      for (int tt = 0; tt < 2; ++tt) {
#pragma unroll
        for (int r = 0; r < 16; ++r) {
          const float pv = __builtin_amdgcn_exp2f(sacc[tt][r] - mn);
          sacc[tt][r] = pv;
          ps += pv;
        }
#pragma unroll
        for (int s2 = 0; s2 < 2; ++s2) {
          u32x4 w;
          w.x = pack2bf(sacc[tt][8 * s2 + 0], sacc[tt][8 * s2 + 1]);
          w.y = pack2bf(sacc[tt][8 * s2 + 2], sacc[tt][8 * s2 + 3]);
          w.z = pack2bf(sacc[tt][8 * s2 + 4], sacc[tt][8 * s2 + 5]);
          w.w = pack2bf(sacc[tt][8 * s2 + 6], sacc[tt][8 * s2 + 7]);
          const bf16x8 pf = __builtin_bit_cast(bf16x8, w);
#pragma unroll
          for (int dt = 0; dt < 4; ++dt) {
            const u16* vp = sV + (dt * 32 + l31) * 68 + 4 * hh;
            const u32x2 lo = *(const u32x2*)(vp + tt * 32 + s2 * 16);
            const u32x2 hi = *(const u32x2*)(vp + tt * 32 + s2 * 16 + 8);
            u32x4 wv = {lo.x, lo.y, hi.x, hi.y};
            oacc[dt] = MFMA32(__builtin_bit_cast(bf16x8, wv), pf, oacc[dt]);
          }
        }
      }
      l_run = l_run * alpha + ps;
    }
    ATTN_STORE_TILE(cur ^ 1)
    __syncthreads();
  }
  const float lt = l_run + __shfl_xor(l_run, 32);
  const float inv = 1.f / lt;
  float sq = 0.f;
  u16* orow = Oout + (size_t)(wid * 32 + l31) * 2048;
#pragma unroll
  for (int dt = 0; dt < 4; ++dt)
#pragma unroll
    for (int g4 = 0; g4 < 4; ++g4) {
      const float v0 = oacc[dt][4 * g4 + 0] * inv, v1 = oacc[dt][4 * g4 + 1] * inv;
      const float v2 = oacc[dt][4 * g4 + 2] * inv, v3 = oacc[dt][4 * g4 + 3] * inv;
      sq += v0 * v0 + v1 * v1 + v2 * v2 + v3 * v3;
      u32x2 w = {pack2bf(v0, v1), pack2bf(v2, v3)};
      *(u32x2*)(orow + dt * 32 + 8 * g4 + 4 * hh) = w;
    }
  sq += __shfl_xor(sq, 32);
  if (hh == 0) ssq_out[(size_t)(wid * 32 + l31) * 16] = sq;
}

DI void phase_mix(const Params& p, int L, char* smem) {
  for (int w = obid(); w < 256; w += gridDim.x) {
    const int b = w >> 6, rem = w & 63, rg = rem >> 2, hb = rem & 3;
    const int r0 = rg * 4;
    const int t0 = min(max(r0 - 4, 0), 56), t1 = min(max(r0 - 1, 0), 56) + 8;
    const size_t tok0 = (size_t)b * 4096 + r0 * 64;
    attn_block<128, 1>(smem, p.h() + tok0 * HLD + 1536 + hb * 128, HLD, p.h() + (size_t)b * 4096 * HLD + 2048 + hb * 128, HLD,
                       p.vtB() + (size_t)(b * 4 + hb) * 128 * 4096, t0, t1, r0 * 64, 0.f, 0.f,
                       p.b_rel + (size_t)L * 4 * 465 + hb * 465, p.o() + tok0 * 2048 + 1024 + hb * 128, p.ssqh() + tok0 * 16 + 8 + hb);
  }
  for (int ww = obid(); ww < 512; ww += gridDim.x) {
    const int b = ww >> 7, rem = ww & 127, sb = rem >> 3, hq = rem & 7;
    const int t0 = max(0, 4 * sb - 2), t1 = min(64, 4 * sb + 6);
    const size_t tok0 = (size_t)b * 4096 + sb * 256;
    const float slope2 = exp2f(-(float)(hq + 1)) * LOG2E;
    const float sink2 = p.a_sink[L * 8 + hq] * LOG2E;
    attn_block<128, 0>(smem, p.h() + tok0 * HLD + hq * 128, HLD, p.h() + (size_t)b * 4096 * HLD + 1024 + (hq >> 2) * 128, HLD,
                       p.vtA() + (size_t)(b * 2 + (hq >> 2)) * 128 * 4096, t0, t1, sb * 256, slope2, sink2, nullptr,
                       p.o() + tok0 * 2048 + hq * 128, p.ssqh() + tok0 * 16 + hq);
  }
  for (int w = (obid() + 64) % gridDim.x; w < 192; w += gridDim.x) tile_upq(p, L, w, smem);
  for (int w = obid(); w < 256; w += gridDim.x) tile_upkv(p, L, w, smem);
}

DI void phase_mla(const Params& p, char* smem) {
  const int nbx = gridDim.x >> 3;
  for (int li = obid() >> 3; li < 32; li += nbx) {
    const int pair = (obid() & 7) * 2 + (li >> 4), nq = li & 15;
    const int b = pair >> 2, hc = pair & 3;
    const size_t tok0 = (size_t)b * 4096 + nq * 256;
    attn_block<192, 2>(smem, p.qmla() + ((size_t)(b * 4 + hc) * 4096 + nq * 256) * 192, 192, p.kmla() + (size_t)(b * 4 + hc) * 4096 * 192, 192,
                       p.vtC() + (size_t)(b * 4 + hc) * 128 * 4096, 0, 64, nq * 256, 0.f, 0.f, nullptr,
                       p.o() + tok0 * 2048 + 1536 + hc * 128, p.ssqh() + tok0 * 16 + 12 + hc, p.ropeC());
  }
}

DI void phase_onorm(const Params& p) {
  const int lane = otid() & 63, wid = otid() >> 6;
  for (int row = obid() * NWAVE + wid; row < T; row += gridDim.x * NWAVE) {
    const float4* sp = (const float4*)(p.ssqh() + (size_t)row * 16);
    const float4 a0 = sp[0], a1 = sp[1], b0 = sp[2], c0 = sp[3];
    const float rA = rsqrtf((a0.x + a0.y + a0.z + a0.w + a1.x + a1.y + a1.z + a1.w) * (1.f / 1024.f) + EPS);
    const float rB = rsqrtf((b0.x + b0.y + b0.z + b0.w) * (1.f / 512.f) + EPS);
    const float rC = rsqrtf((c0.x + c0.y + c0.z + c0.w) * (1.f / 512.f) + EPS);
#pragma unroll
    for (int j = 0; j < 4; ++j) {
      const float sc = (j < 2) ? rA : (j == 2 ? rB : rC);
      const size_t off = (size_t)row * 2048 + j * 512 + lane * 8;
      u32x4 w = *(const u32x4*)(p.o() + off);
      w.x = pack2bf(bf_lo(w.x) * sc, bf_hi(w.x) * sc);
      w.y = pack2bf(bf_lo(w.y) * sc, bf_hi(w.y) * sc);
      w.z = pack2bf(bf_lo(w.z) * sc, bf_hi(w.z) * sc);
      w.w = pack2bf(bf_lo(w.w) * sc, bf_hi(w.w) * sc);
      *(u32x4*)(p.on() + off) = w;
    }
  }
}

DI u32 ordkey(float s) {
  const u32 u = __float_as_uint(s);
  return u ^ ((u >> 31) ? 0xFFFFFFFFu : 0x80000000u);
}
DI float unord(u32 k) {
  const u32 u = (k & 0x80000000u) ? (k ^ 0x80000000u) : ~k;
  return __uint_as_float(u);
}
DI void insert16(u32 (&Ls)[16], u32 key) {
#pragma unroll
  for (int q = 0; q < 16; ++q) {
    const u32 hi = max(Ls[q], key);
    key = min(Ls[q], key);
    Ls[q] = hi;
  }
}

DI void phase_select(const Params& p, int L, char* smem) {
  float* sS = (float*)smem;
  u32* sTop = (u32*)(smem + 256 * 132 * 4);
  const int tid = otid(), lane = tid & 63, wid = tid >> 6, hh = lane >> 5, l31 = lane & 31;
  const int rt = wid >> 1, c = wid & 1;
  const u16* kb = p.keys_b() + (size_t)L * 256 * 128;
  for (int it = obid(); it < 1024; it += gridDim.x) {
    f32x16 sc[4];
    {
      const u16* qrow = p.pq() + ((size_t)it * 128 + rt * 32 + l31) * 128 + c * 64 + hh * 8;
      bf16x8 qa[4];
#pragma unroll
      for (int ks = 0; ks < 4; ++ks) qa[ks] = *(const bf16x8*)(qrow + ks * 16);
#pragma unroll
      for (int ct = 0; ct < 4; ++ct) {
#pragma unroll
        for (int r = 0; r < 16; ++r) sc[ct][r] = 0.f;
        const u16* krow = kb + (size_t)(c * 128 + ct * 32 + l31) * 128 + c * 64 + hh * 8;
#pragma unroll
        for (int ks = 0; ks < 4; ++ks) {
          const bf16x8 kf = *(const bf16x8*)(krow + ks * 16);
          sc[ct] = MFMA32(qa[ks], kf, sc[ct]);
        }
      }
    }
    __syncthreads();
#pragma unroll
    for (int ct = 0; ct < 4; ++ct)
#pragma unroll
      for (int r = 0; r < 16; ++r) sS[((rt * 32 + crow(r, hh)) * 2 + c) * 132 + ct * 32 + l31] = sc[ct][r];
    __syncthreads();
    {
      const int combo = tid >> 1, half = tid & 1;
      u32 Ls[16];
#pragma unroll
      for (int q = 0; q < 16; ++q) Ls[q] = 0u;
      const float* sp = sS + combo * 132 + half * 64;
      for (int n4 = 0; n4 < 16; ++n4) {
        const int n4r = (n4 + half * 8) & 15;
        const float4 v = *(const float4*)(sp + n4r * 4);
        const int nb = half * 64 + n4r * 4;
        insert16(Ls, (ordkey(v.x) & ~0x7Fu) | (u32)(127 - (nb + 0)));
        insert16(Ls, (ordkey(v.y) & ~0x7Fu) | (u32)(127 - (nb + 1)));
        insert16(Ls, (ordkey(v.z) & ~0x7Fu) | (u32)(127 - (nb + 2)));
        insert16(Ls, (ordkey(v.w) & ~0x7Fu) | (u32)(127 - (nb + 3)));
      }
      u32 Ms[16];
#pragma unroll
      for (int q = 0; q < 16; ++q) {
        const u32 other = (u32)__shfl_xor((int)Ls[15 - q], 1);
        Ms[q] = max(Ls[q], other);
      }
#pragma unroll
      for (int span = 8; span >= 1; span >>= 1)
#pragma unroll
        for (int q = 0; q < 16; ++q)
          if ((q & span) == 0) {
            const u32 hi = max(Ms[q], Ms[q + span]), lo = min(Ms[q], Ms[q + span]);
            Ms[q] = hi;
            Ms[q + span] = lo;
          }
      if (half == 0) {
#pragma unroll
        for (int q = 0; q < 16; ++q) sTop[combo * 16 + q] = Ms[q];
      }
    }
    __syncthreads();
    if (tid < 128) {
      const u32* t0 = sTop + (tid * 2) * 16;
      const u32* t1 = sTop + (tid * 2 + 1) * 16;
      float s0[16], s1[16];
#pragma unroll
      for (int q = 0; q < 16; ++q) {
        s0[q] = unord(t0[q] & ~0x7Fu);
        s1[q] = unord(t1[q] & ~0x7Fu);
      }
      u32 M[16];
#pragma unroll
      for (int q = 0; q < 16; ++q) M[q] = 0u;
#pragma unroll
      for (int i = 0; i < 16; ++i)
#pragma unroll
        for (int j = 0; j < 16; ++j)
          if ((i + 1) * (j + 1) <= 16) {
            const float sm = s0[i] + s1[j];
            insert16(M, (ordkey(sm) & ~0xFFu) | (u32)(255 - (i * 16 + j)));
          }
      const float mxv = unord(M[0] & ~0xFFu);
      float e[16], sum = 0.f;
#pragma unroll
      for (int q = 0; q < 16; ++q) {
        e[q] = __expf(unord(M[q] & ~0xFFu) - mxv);
        sum += e[q];
      }
      const float inv = 1.f / sum;
      const size_t row = (size_t)it * 128 + tid;
#pragma unroll
      for (int q = 0; q < 16; ++q) {
        const int ij = 255 - (int)(M[q] & 0xFFu);
        const int n0 = 127 - (int)(t0[ij >> 4] & 0x7Fu);
        const int n1 = 127 - (int)(t1[ij & 15] & 0x7Fu);
        p.idx()[row * 16 + q] = n0 * 128 + n1;
        p.g()[row * 16 + q] = e[q] * inv;
      }
    }
  }
}

DI float dot32(u32x4 w, const float2_t* xn2) {
  float2_t s = {0.f, 0.f};
#pragma unroll
  for (int c = 0; c < 4; ++c) {
    s = __builtin_elementwise_fma(__builtin_amdgcn_cvt_scalef32_pk_f32_fp4(w[c], 1.0f, 0), xn2[4 * c + 0], s);
    s = __builtin_elementwise_fma(__builtin_amdgcn_cvt_scalef32_pk_f32_fp4(w[c], 1.0f, 1), xn2[4 * c + 1], s);
    s = __builtin_elementwise_fma(__builtin_amdgcn_cvt_scalef32_pk_f32_fp4(w[c], 1.0f, 2), xn2[4 * c + 2], s);
    s = __builtin_elementwise_fma(__builtin_amdgcn_cvt_scalef32_pk_f32_fp4(w[c], 1.0f, 3), xn2[4 * c + 3], s);
  }
  return s.x + s.y;
}
DI void axpy32(u32x4 w, float a, float2_t* y2) {
  const float2_t a2 = {a, a};
#pragma unroll
  for (int c = 0; c < 4; ++c) {
    y2[4 * c + 0] = __builtin_elementwise_fma(__builtin_amdgcn_cvt_scalef32_pk_f32_fp4(w[c], 1.0f, 0), a2, y2[4 * c + 0]);
    y2[4 * c + 1] = __builtin_elementwise_fma(__builtin_amdgcn_cvt_scalef32_pk_f32_fp4(w[c], 1.0f, 1), a2, y2[4 * c + 1]);
    y2[4 * c + 2] = __builtin_elementwise_fma(__builtin_amdgcn_cvt_scalef32_pk_f32_fp4(w[c], 1.0f, 2), a2, y2[4 * c + 2]);
    y2[4 * c + 3] = __builtin_elementwise_fma(__builtin_amdgcn_cvt_scalef32_pk_f32_fp4(w[c], 1.0f, 3), a2, y2[4 * c + 3]);
  }
}
DI float gelu_tanh(float a) {
  const float u = 0.7978845608028654f * (a + 0.044715f * a * a * a);
  return 0.5f * a * (1.f + tanhf(u));
}

DI void phase_gather(const Params& p, int L, bool last) {
  const int wid = otid() >> 6;
  const unsigned char* U = p.ub() + (size_t)L * NEXP * 1024;
  const unsigned char* V = p.vb() + (size_t)L * NEXP * 1024;
  const float* ln2 = p.ln2 + L * 2048;
  int ni0 = 0, ni1 = 0;
  float ng0 = 0.f, ng1 = 0.f;
  {
    const int t0 = obid() * NWAVE + wid, l0 = otid() & 63;
    if (t0 < T) {
      ni0 = p.idx()[(size_t)t0 * 128 + l0]; ni1 = p.idx()[(size_t)t0 * 128 + 64 + l0];
      ng0 = p.g()[(size_t)t0 * 128 + l0];   ng1 = p.g()[(size_t)t0 * 128 + 64 + l0];
    }
  }
  for (int t = obid() * NWAVE + wid; t < T; t += gridDim.x * NWAVE) {
    const int lane = otid() & 63;
    float* xr = p.xres() + (size_t)t * 2048;
    float2_t xn2[16];
    float ss = 0.f;
#pragma unroll
    for (int c4 = 0; c4 < 8; ++c4) {
      const float4 a = *(const float4*)(xr + lane * 32 + c4 * 4);
      xn2[c4 * 2 + 0] = float2_t{a.x, a.y};
      xn2[c4 * 2 + 1] = float2_t{a.z, a.w};
    }
#pragma unroll
    for (int e = 0; e < 16; ++e) ss += xn2[e].x * xn2[e].x + xn2[e].y * xn2[e].y;
    ss = wave_sum(ss);
    const float rstd = rsqrtf(ss * (1.f / 2048.f) + EPS) * (1.f / U_SCALE);
#pragma unroll
    for (int c4 = 0; c4 < 8; ++c4) {
      const float4 a = *(const float4*)(ln2 + lane * 32 + c4 * 4);
      xn2[c4 * 2 + 0] *= float2_t{rstd * a.x, rstd * a.y};
      xn2[c4 * 2 + 1] *= float2_t{rstd * a.z, rstd * a.w};
    }
    const int i0 = ni0, i1 = ni1;
    const float g0 = ng0, g1 = ng1;
    float a0 = 0.f, a1 = 0.f;
#pragma unroll
    for (int half = 0; half < 2; ++half) {
      const int iv = half ? i1 : i0;
      float av = 0.f;
#pragma unroll 1
      for (int k0 = 0; k0 < 64; k0 += 16) {
        u32x4 w[16];
#pragma unroll
        for (int q = 0; q < 16; ++q) {
          const int row = __builtin_amdgcn_readlane(iv, k0 + q);
          w[q] = *(const u32x4*)(U + (size_t)row * 1024 + lane * 16);
        }
        float d[16];
#pragma unroll
        for (int q = 0; q < 16; ++q) {
          __builtin_amdgcn_sched_barrier(0);
          if (q > 0) asm volatile("" : "+v"(w[q]), "+v"(d[q - 1]));
          d[q] = dot32(w[q], xn2);
        }
        __builtin_amdgcn_sched_barrier(0);
        {
          const bool b5 = (lane & 32) != 0, b4 = (lane & 16) != 0, b3 = (lane & 8) != 0, b2 = (lane & 4) != 0;
          float e8[8], e4[4], e2[2], e1;
#pragma unroll
          for (int j = 0; j < 8; ++j) {
            const float snd = b5 ? d[j] : d[j + 8];
            const float kep = b5 ? d[j + 8] : d[j];
            e8[j] = kep + __shfl_xor(snd, 32);
          }
#pragma unroll
          for (int j = 0; j < 4; ++j) {
            const float snd = b4 ? e8[j] : e8[j + 4];
            const float kep = b4 ? e8[j + 4] : e8[j];
            e4[j] = kep + __shfl_xor(snd, 16);
          }
#pragma unroll
          for (int j = 0; j < 2; ++j) {
            const float snd = b3 ? e4[j] : e4[j + 2];
            const float kep = b3 ? e4[j + 2] : e4[j];
            e2[j] = kep + __shfl_xor(snd, 8);
          }
          {
            const float snd = b2 ? e2[0] : e2[1];
            const float kep = b2 ? e2[1] : e2[0];
            e1 = kep + __shfl_xor(snd, 4);
          }
          e1 += __shfl_xor(e1, 2);
          e1 += __shfl_xor(e1, 1);
          const float got = __shfl(e1, ((lane - k0) & 15) * 4);
          if (lane >= k0 && lane < k0 + 16) av = got;
        }
      }
      if (half) a1 = av; else a0 = av;
    }
    const float hs0 = gelu_tanh(a0) * g0 * (1.f / V_SCALE), hs1 = gelu_tanh(a1) * g1 * (1.f / V_SCALE);
    {
      const int tn = t + gridDim.x * NWAVE;
      if (tn < T) {
        ni0 = p.idx()[(size_t)tn * 128 + lane]; ni1 = p.idx()[(size_t)tn * 128 + 64 + lane];
        ng0 = p.g()[(size_t)tn * 128 + lane];   ng1 = p.g()[(size_t)tn * 128 + 64 + lane];
      }
    }
    float2_t y2[16];
#pragma unroll
    for (int e = 0; e < 16; ++e) y2[e] = float2_t{0.f, 0.f};
#pragma unroll
    for (int half = 0; half < 2; ++half) {
      const int iv = half ? i1 : i0;
      const int hv = __float_as_int(half ? hs1 : hs0);
#pragma unroll 1
      for (int k0 = 0; k0 < 64; k0 += 8) {
        u32x4 w[8];
        float wq[8];
#pragma unroll
        for (int q = 0; q < 8; ++q) {
          const int row = __builtin_amdgcn_readlane(iv, k0 + q);
          wq[q] = __int_as_float(__builtin_amdgcn_readlane(hv, k0 + q));
          w[q] = *(const u32x4*)(V + (size_t)row * 1024 + lane * 16);
        }
#pragma unroll
        for (int q = 0; q < 8; ++q) {
          __builtin_amdgcn_sched_barrier(0);
          asm volatile("" : "+v"(w[q]), "+v"(y2[0]), "+v"(y2[8]));
          axpy32(w[q], wq[q], y2);
        }
        __builtin_amdgcn_sched_barrier(0);
      }
    }
    int t2 = t;
    asm volatile("" : "+v"(t2));
    const int lane2 = otid() & 63;
    float* xr2 = p.xres() + (size_t)t2 * 2048;
#pragma unroll
    for (int c4 = 0; c4 < 8; ++c4) {
      const float4 a = *(const float4*)(xr2 + lane2 * 32 + c4 * 4);
      y2[c4 * 2 + 0] += float2_t{a.x, a.y};
      y2[c4 * 2 + 1] += float2_t{a.z, a.w};
    }
    if (!last) {
#pragma unroll
      for (int c4 = 0; c4 < 8; ++c4)
        *(float4*)(xr2 + lane2 * 32 + c4 * 4) = float4{y2[c4 * 2].x, y2[c4 * 2].y, y2[c4 * 2 + 1].x, y2[c4 * 2 + 1].y};
#pragma unroll
      for (int c8 = 0; c8 < 4; ++c8) {
        const float2_t* yy = y2 + c8 * 4;
        u32x4 w = {pack2bf(yy[0].x, yy[0].y), pack2bf(yy[1].x, yy[1].y), pack2bf(yy[2].x, yy[2].y), pack2bf(yy[3].x, yy[3].y)};
        *(u32x4*)(p.xb() + (size_t)t2 * 2048 + lane2 * 32 + c8 * 8) = w;
      }
    } else {
      float ss2 = 0.f;
#pragma unroll
      for (int e = 0; e < 16; ++e) ss2 += y2[e].x * y2[e].x + y2[e].y * y2[e].y;
      ss2 = wave_sum(ss2);
      const float r2 = rsqrtf(ss2 * (1.f / 2048.f) + EPS);
      float* orow = p.out + (size_t)t2 * 2048;
#pragma unroll
      for (int c4 = 0; c4 < 8; ++c4) {
        const float4 a = *(const float4*)(p.fnorm + lane2 * 32 + c4 * 4);
        *(float4*)(orow + lane2 * 32 + c4 * 4) =
            float4{y2[c4 * 2].x * r2 * a.x, y2[c4 * 2].y * r2 * a.y, y2[c4 * 2 + 1].x * r2 * a.z, y2[c4 * 2 + 1].y * r2 * a.w};
      }
    }
  }
}


#define XB_TMO      128
#define XB_XCNT(j)  (256  + 64 * (j))
#define XB_XSUB(j)  (1280 + 64 * (j))
#define XB_XGEN(j)  (2304 + 64 * (j))
#define XB_TOP      3328
#define XB_TOPGEN   3392
#define XCD_BAR_WORDS 3456
#define XB_SPIN_CAP (1u << 18)
#define LAS __attribute__((address_space(3)))
DI unsigned xb_ld(unsigned* p) { return __hip_atomic_load(p, __ATOMIC_RELAXED, __HIP_MEMORY_SCOPE_AGENT); }
DI unsigned xb_add(unsigned* p, unsigned v) { return __hip_atomic_fetch_add(p, v, __ATOMIC_RELAXED, __HIP_MEMORY_SCOPE_AGENT); }
DI unsigned xb_xcc_id() { return (unsigned)__builtin_amdgcn_s_getreg((3 << 11) | 20) & 0xFu; }
#define XB_SPIN(cond, bar) do { unsigned _sp = 0; while (cond) { __builtin_amdgcn_s_sleep(1); \
    if ((++_sp & 255u) == 0u) { if (xb_ld(&(bar)[XB_TMO])) break; if (_sp > XB_SPIN_CAP) { atomicAdd(&(bar)[XB_TMO], 1u); break; } } } } while (0)
struct XcdBarrier { unsigned* bar; unsigned x; volatile LAS unsigned* st; };
DI XcdBarrier xcd_barrier_post(unsigned* bar, volatile LAS unsigned* st) {
  XcdBarrier b; b.bar = bar; b.x = xb_xcc_id(); b.st = st;
  if (threadIdx.x == 0) (void)xb_add(&bar[XB_XCNT(b.x)], 1u);
  return b;
}
DI void xcd_barrier_complete(unsigned* bar, unsigned x, unsigned& nloc, unsigned& nx) {
  const unsigned G = gridDim.x * gridDim.y * gridDim.z;
  unsigned sum, cnt, mine, sp = 0u;
  for (;;) {
    sum = 0u; cnt = 0u; mine = 0u;
#pragma unroll
    for (unsigned j = 0; j < 16; ++j) { const unsigned c = xb_ld(&bar[XB_XCNT(j)]); sum += c; cnt += (c > 0u) ? 1u : 0u; mine = (j == x) ? c : mine; }
    if (sum == G) break;
    __builtin_amdgcn_s_sleep(1);
    if ((++sp & 255u) == 0u) { if (xb_ld(&bar[XB_TMO])) break; if (sp > XB_SPIN_CAP) { atomicAdd(&bar[XB_TMO], 1u); break; } }
  }
  nloc = mine > 0u ? mine : 1u; nx = cnt > 0u ? cnt : 1u;
}
DI void xcd_barrier(const XcdBarrier& b) {
  asm volatile("s_waitcnt vmcnt(0)" ::: "memory");
  __syncthreads();
  if (threadIdx.x == 0) {
    unsigned* bar = b.bar;
    __builtin_amdgcn_s_waitcnt(0);
    unsigned nloc = b.st[0], nx = b.st[1];
    if (nloc == 0u) { xcd_barrier_complete(bar, b.x, nloc, nx); b.st[0] = nloc; b.st[1] = nx; }
    const unsigned old = xb_add(&bar[XB_XSUB(b.x)], 1u);
    const unsigned gen = old / nloc;
    if (old + 1u == (gen + 1u) * nloc) {
      __builtin_amdgcn_fence(__ATOMIC_RELEASE, "agent");
      asm volatile("s_waitcnt vmcnt(0)" ::: "memory");
      const unsigned og = xb_add(&bar[XB_TOP], 1u);
      const unsigned tg = og / nx;
      if (og + 1u == (tg + 1u) * nx) xb_add(&bar[XB_TOPGEN], 1u);
      else XB_SPIN(xb_ld(&bar[XB_TOPGEN]) == tg, bar);
      __builtin_amdgcn_fence(__ATOMIC_ACQUIRE, "agent");
      xb_add(&bar[XB_XGEN(b.x)], 1u);
      asm volatile("s_waitcnt vmcnt(0)" ::: "memory");
    } else {
      XB_SPIN(xb_ld(&bar[XB_XGEN(b.x)]) == gen, bar);
      __builtin_amdgcn_fence(__ATOMIC_ACQUIRE, "agent");
      asm volatile("s_waitcnt vmcnt(0)" ::: "memory");
    }
  }
  __syncthreads();
}

#define KDEF(name, body)                                                       \
  __global__ void __launch_bounds__(512) name(Params p, int L) {            \
    __shared__ __attribute__((aligned(16))) char smem[SMEM_BYTES];             \
    body;                                                                      \
  }
#if !MEGA
KDEF(k_prologue, phase_prologue(p, smem))
KDEF(k_gemm1, phase_gemm1(p, L, smem))
KDEF(k_mix, phase_mix(p, L, smem))
KDEF(k_mla, phase_mla(p, smem))
KDEF(k_onorm, phase_onorm(p))
KDEF(k_gemm_o, phase_gemm_o(p, L, smem))
KDEF(k_gemm_pq, phase_gemm_pq(p, L, smem))
KDEF(k_scores, phase_gemm_scores(p, L, smem))
KDEF(k_select, phase_select(p, L, smem))
KDEF(k_gather, phase_gather(p, L, L == 1))
#else
#ifndef PROBE_MASK
#define PROBE_MASK 0
#endif
#define RUN(bit, call)                         \
  call;                                        \
  if (PROBE_MASK & (bit)) {                    \
    grid.sync();                               \
    call;                                      \
  }
__global__ void __launch_bounds__(512) mega_coop(Params p) {
  __shared__ __attribute__((aligned(16))) char smem[SMEM_BYTES];
  __shared__ uint4 xb_words;
  cg::grid_group grid = cg::this_grid();
  if (threadIdx.x == 0) xb_words = make_uint4(0u, 0u, 0u, 0u);
  __syncthreads();
  const XcdBarrier xb = xcd_barrier_post((unsigned*)(p.ws + WS_NEED), (volatile LAS unsigned*)&xb_words);
#define GSYNC xcd_barrier(xb)
  RUN(256, phase_prologue(p, smem))
  if (p.ws == nullptr) grid.sync();
  GSYNC;
#pragma unroll 1
  for (int L = 0; L < 2; ++L) {
    phase_gemm1(p, L, smem);
    GSYNC;
    phase_mix(p, L, smem);
    GSYNC;
    phase_mla(p, smem);
    GSYNC;
    phase_gemm_o(p, L, smem);
    GSYNC;
    phase_gemm_pq(p, L, smem);
    GSYNC;
    phase_select(p, L, smem);
    GSYNC;
    phase_gather(p, L, L == 1);
    if (L == 0) GSYNC;
  }
}
#endif

extern "C" void kernel_launch(void* const* d_in, const int* in_sizes, int n_in, void* d_out, int out_size, void* d_ws,
                              size_t ws_size, hipStream_t stream) {
  Params p{};
  p.x = (const float*)d_in[0]; p.ln1 = (const float*)d_in[1]; p.w_in = (const float*)d_in[2]; p.a_sink = (const float*)d_in[3];
  p.b_rel = (const float*)d_in[4]; p.cqn = (const float*)d_in[5]; p.ckvn = (const float*)d_in[6]; p.wuq = (const float*)d_in[7];
  p.wukv = (const float*)d_in[8]; p.onorm = (const float*)d_in[9]; p.wo = (const float*)d_in[10]; p.ln2 = (const float*)d_in[11];
  p.pwq = (const float*)d_in[12]; p.pkeys = (const float*)d_in[13]; p.pu = (const float*)d_in[14]; p.pv = (const float*)d_in[15];
  p.fnorm = (const float*)d_in[16];
  p.out = (float*)d_out;
  p.ws = (char*)d_ws;
  if (WS_NEED + XCD_BAR_WORDS * sizeof(unsigned) > ws_size) { fprintf(stderr, "kernel_launch: workspace too small (%zu > %zu)\n", (size_t)WS_NEED, ws_size); return; }

#if MEGA
  static int grid_blocks = 0;
  if (!grid_blocks) {
    int dev = 0, cus = 0, per_cu = 0;
    hipGetDevice(&dev);
    hipDeviceGetAttribute(&cus, hipDeviceAttributeMultiprocessorCount, dev);
    hipOccupancyMaxActiveBlocksPerMultiprocessor(&per_cu, mega_coop, NTHR, 0);
    if (per_cu > 1) per_cu = 1;
    if (per_cu < 1) per_cu = 1;
    grid_blocks = (cus * per_cu) & ~7;
  }
  (void)hipMemsetAsync(p.ws + WS_NEED, 0, XCD_BAR_WORDS * sizeof(unsigned), stream);
  void* args[] = {&p};
  hipError_t e = hipLaunchCooperativeKernel((void*)mega_coop, dim3(grid_blocks), dim3(NTHR), args, 0, stream);
  if (e != hipSuccess) fprintf(stderr, "cooperative launch failed: %s (grid %d)\n", hipGetErrorString(e), grid_blocks);
#else
  const dim3 g(256), b(NTHR);
  k_prologue<<<g, b, 0, stream>>>(p, 0);
  for (int L = 0; L < 2; ++L) {
    k_gemm1<<<g, b, 0, stream>>>(p, L);
    k_mix<<<g, b, 0, stream>>>(p, L);
    k_mla<<<g, b, 0, stream>>>(p, L);
    k_gemm_o<<<g, b, 0, stream>>>(p, L);
    k_gemm_pq<<<g, b, 0, stream>>>(p, L);
    k_select<<<g, b, 0, stream>>>(p, L);
    k_gather<<<g, b, 0, stream>>>(p, L);
  }
#endif
}
```

```cpp
#include <hip/hip_runtime.h>
#include <hip/hip_cooperative_groups.h>
#include <cstdio>
namespace cg = cooperative_groups;

#ifndef MEGA
#define MEGA 1
#endif

#define DI __device__ __forceinline__
typedef unsigned short u16;
typedef unsigned int u32;
using bf16x8 = __attribute__((ext_vector_type(8))) short;
using f32x16 = __attribute__((ext_vector_type(16))) float;
typedef __bf16 bf16x2_t __attribute__((ext_vector_type(2)));
typedef float float2_t __attribute__((ext_vector_type(2)));
typedef unsigned int u32x4 __attribute__((ext_vector_type(4)));
typedef unsigned int u32x2 __attribute__((ext_vector_type(2)));

constexpr int T = 16384, SEQ = 4096, DM = 2048, HLD = 4096;
constexpr int NTHR = 512, NWAVE = 8;
constexpr int NEXP = 16384;
constexpr float EPS = 1e-6f;
constexpr float LOG2E = 1.4426950408889634f;
constexpr float QSCALE_AB = 0.08838834764831845f * LOG2E;
constexpr float QSCALE_C = 0.07216878364870323f * LOG2E;
constexpr float U_SCALE = 90.5f, V_SCALE = 8.f;
constexpr int LDT = 72;
constexpr int GEMM_STAGE = 512 * LDT;
constexpr int GEMM_SROW_OFF = 2 * GEMM_STAGE * 2;
constexpr int SMEM_BYTES = 256 * 132 * 4 + 256 * 16 * 4;

#define MFMA32(a, b, c) __builtin_amdgcn_mfma_f32_32x32x16_bf16((a), (b), (c), 0, 0, 0)

constexpr size_t al256(size_t x) { return (x + 255) & ~(size_t)255; }
constexpr size_t OFF_wt_in = 0;
constexpr size_t OFF_wt_o = OFF_wt_in + al256((size_t)2 * HLD * 2048 * 2);
constexpr size_t OFF_wt_pq = OFF_wt_o + al256((size_t)2 * 2048 * 2048 * 2);
constexpr size_t OFF_wt_uq = OFF_wt_pq + al256((size_t)2 * 1024 * 2048 * 2);
constexpr size_t OFF_wt_ukv = OFF_wt_uq + al256((size_t)2 * 768 * 512 * 2);
constexpr size_t OFF_keys_b = OFF_wt_ukv + al256((size_t)2 * 1024 * 256 * 2);
constexpr size_t OFF_ub = OFF_keys_b + al256((size_t)2 * 256 * 128 * 2);
constexpr size_t OFF_vb = OFF_ub + al256((size_t)2 * NEXP * 1024);
constexpr size_t OFF_ropeC = OFF_vb + al256((size_t)2 * NEXP * 1024);
constexpr size_t OFF_ropeS = OFF_ropeC + al256((size_t)SEQ * 32 * 4);
constexpr size_t OFF_xres = OFF_ropeS + al256((size_t)SEQ * 32 * 4);
constexpr size_t OFF_xb = OFF_xres + al256((size_t)T * 2048 * 4);
constexpr size_t OFF_h = OFF_xb + al256((size_t)T * 2048 * 2);
constexpr size_t OFF_vtA = OFF_h + al256((size_t)T * HLD * 2);
constexpr size_t OFF_vtB = OFF_vtA + al256((size_t)T * 256 * 2);
constexpr size_t OFF_kmla = OFF_vtB + al256((size_t)T * 512 * 2);
constexpr size_t OFF_vtC = OFF_kmla + al256((size_t)T * 4 * 192 * 2);
constexpr size_t OFF_qmla = OFF_vtC + al256((size_t)T * 512 * 2);
constexpr size_t OFF_o = OFF_qmla + al256((size_t)T * 4 * 192 * 2);
constexpr size_t OFF_on = OFF_o + al256((size_t)T * 2048 * 2);
constexpr size_t OFF_ssqh = OFF_on + al256((size_t)T * 2048 * 2);
constexpr size_t OFF_END1 = OFF_ssqh + al256((size_t)T * 16 * 4);
constexpr size_t OFF_pq = OFF_h;
constexpr size_t OFF_scores = OFF_pq + al256((size_t)T * 1024 * 2);
constexpr size_t OFF_idx = OFF_scores + al256((size_t)T * 8 * 256 * 4);
constexpr size_t OFF_g = OFF_idx + al256((size_t)T * 128 * 4);
constexpr size_t OFF_END2 = OFF_g + al256((size_t)T * 128 * 4);
constexpr size_t WS_NEED = OFF_END1 > OFF_END2 ? OFF_END1 : OFF_END2;

struct Params {
  const float *x, *ln1, *w_in, *a_sink, *b_rel, *cqn, *ckvn, *wuq, *wukv, *onorm, *wo, *ln2, *pwq, *pkeys, *pu, *pv, *fnorm;
  float* out;
  char* ws;
  DI u16* wt_in() const { return (u16*)(ws + OFF_wt_in); }
  DI u16* wt_o() const { return (u16*)(ws + OFF_wt_o); }
  DI u16* wt_pq() const { return (u16*)(ws + OFF_wt_pq); }
  DI u16* wt_uq() const { return (u16*)(ws + OFF_wt_uq); }
  DI u16* wt_ukv() const { return (u16*)(ws + OFF_wt_ukv); }
  DI u16* keys_b() const { return (u16*)(ws + OFF_keys_b); }
  DI unsigned char* ub() const { return (unsigned char*)(ws + OFF_ub); }
  DI unsigned char* vb() const { return (unsigned char*)(ws + OFF_vb); }
  DI float* ropeC() const { return (float*)(ws + OFF_ropeC); }
  DI float* ropeS() const { return (float*)(ws + OFF_ropeS); }
  DI float* xres() const { return (float*)(ws + OFF_xres); }
  DI u16* xb() const { return (u16*)(ws + OFF_xb); }
  DI u16* h() const { return (u16*)(ws + OFF_h); }
  DI u16* vtA() const { return (u16*)(ws + OFF_vtA); }
  DI u16* vtB() const { return (u16*)(ws + OFF_vtB); }
  DI u16* kmla() const { return (u16*)(ws + OFF_kmla); }
  DI u16* vtC() const { return (u16*)(ws + OFF_vtC); }
  DI u16* qmla() const { return (u16*)(ws + OFF_qmla); }
  DI u16* o() const { return (u16*)(ws + OFF_o); }
  DI u16* on() const { return (u16*)(ws + OFF_on); }
  DI float* ssqh() const { return (float*)(ws + OFF_ssqh); }
  DI u16* pq() const { return (u16*)(ws + OFF_pq); }
  DI float* scores() const { return (float*)(ws + OFF_scores); }
  DI int* idx() const { return (int*)(ws + OFF_idx); }
  DI float* g() const { return (float*)(ws + OFF_g); }
};

DI int otid() { int t = threadIdx.x; asm volatile("" : "+v"(t)); return t; }
DI int obid() { int b = blockIdx.x; asm volatile("" : "+s"(b)); return b; }
DI u16 f2bf(float x) {
  u32 u = __float_as_uint(x);
  u += 0x7fffu + ((u >> 16) & 1u);
  return (u16)(u >> 16);
}
DI u32 pack2bf(float a, float b) {
  float2_t f = {a, b};
  bf16x2_t r = __builtin_convertvector(f, bf16x2_t);
  return __builtin_bit_cast(u32, r);
}
DI float bf_lo(u32 w) { return __uint_as_float(w << 16); }
DI float bf_hi(u32 w) { return __uint_as_float(w & 0xffff0000u); }
DI int crow(int r, int h) { return (r & 3) + 8 * (r >> 2) + 4 * h; }
DI float wave_sum(float v) {
#pragma unroll
  for (int o = 32; o >= 1; o >>= 1) v += __shfl_xor(v, o);
  return v;
}
DI float ssq8(u32x4 w) {
  float s = 0.f, a;
  a = bf_lo(w.x); s += a * a; a = bf_hi(w.x); s += a * a;
  a = bf_lo(w.y); s += a * a; a = bf_hi(w.y); s += a * a;
  a = bf_lo(w.z); s += a * a; a = bf_hi(w.z); s += a * a;
  a = bf_lo(w.w); s += a * a; a = bf_hi(w.w); s += a * a;
  return s;
}
DI bool gemm_tile_map(int it, int MT, int NT, int& mt, int& nt) {
  const int b = obid(), x = b & 7, nb = gridDim.x >> 3;
  const int li = it * nb + (b >> 3);
  const int nrn = (NT + 7) >> 3, nrect = (MT >> 3) * nrn;
  const int q = x + 8 * (li >> 6);
  if (q >= nrect) { mt = -1; nt = 0; return false; }
  const int in = li & 63;
  mt = (q / nrn) * 8 + (in >> 3);
  nt = (q % nrn) * 8 + (in & 7);
  return nt < NT;
}

constexpr int GM = 256, GN = 256;
DI u32x4 scale8(u32x4 w, float sc) {
  w.x = pack2bf(bf_lo(w.x) * sc, bf_hi(w.x) * sc);
  w.y = pack2bf(bf_lo(w.y) * sc, bf_hi(w.y) * sc);
  w.z = pack2bf(bf_lo(w.z) * sc, bf_hi(w.z) * sc);
  w.w = pack2bf(bf_lo(w.w) * sc, bf_hi(w.w) * sc);
  return w;
}
template <bool ROWNORM, bool CONV = false, bool ASCALE = false>
DI void gemm_mainloop(const u16* __restrict__ Ag, int lda, const u16* __restrict__ Bg, int ldb, int K, char* smem,
                      f32x16 (&acc)[4][2], const float4* __restrict__ csrc = nullptr, u16* __restrict__ cdst = nullptr,
                      float cscale = 1.f) {
  u16* sbase = (u16*)smem;
  float* sRow = (float*)(smem + GEMM_SROW_OFF);
  const int tid = otid(), lane = tid & 63, wid = tid >> 6;
  const int wm = wid >> 2, wn = wid & 3, hh = lane >> 5, l31 = lane & 31;
  const int lr = tid >> 3, lc = (tid & 7) * 8;
#pragma unroll
  for (int i = 0; i < 4; ++i)
#pragma unroll
    for (int j = 0; j < 2; ++j)
#pragma unroll
      for (int r = 0; r < 16; ++r) acc[i][j][r] = 0.f;
  u32x4 ra[4], rb[4];
  float ssq[4] = {0.f, 0.f, 0.f, 0.f};
  const u16* ap = Ag + (size_t)lr * lda + lc;
  const u16* bp = Bg + (size_t)lr * ldb + lc;
#pragma unroll
  for (int i = 0; i < 4; ++i) {
    ra[i] = *(const u32x4*)(ap + (size_t)(64 * i) * lda);
    rb[i] = *(const u32x4*)(bp + (size_t)(64 * i) * ldb);
  }
  __syncthreads();
#pragma unroll
  for (int i = 0; i < 4; ++i) {
    if (ASCALE) ra[i] = scale8(ra[i], sRow[(lr + 64 * i) * 4 + 0]);
    *(u32x4*)(sbase + (lr + 64 * i) * LDT + lc) = ra[i];
    *(u32x4*)(sbase + (256 + lr + 64 * i) * LDT + lc) = rb[i];
    if (ROWNORM) ssq[i] += ssq8(ra[i]);
  }
  __syncthreads();
  const int nk = K >> 6;
#pragma unroll 1
  for (int kt = 0; kt < nk; ++kt) {
    const int cur = kt & 1;
    const bool more = (kt + 1 < nk);
    const int kn = more ? kt + 1 : kt;
    float4 cv;
    if (CONV) cv = csrc[(size_t)kt * NTHR + tid];
#pragma unroll
    for (int i = 0; i < 4; ++i) {
      ra[i] = *(const u32x4*)(ap + (size_t)(64 * i) * lda + kn * 64);
      rb[i] = *(const u32x4*)(bp + (size_t)(64 * i) * ldb + kn * 64);
    }
    const u16* a_s = sbase + cur * GEMM_STAGE + (wm * 128 + l31) * LDT + hh * 8;
    const u16* b_s = sbase + cur * GEMM_STAGE + (256 + wn * 64 + l31) * LDT + hh * 8;
#pragma unroll
    for (int ks = 0; ks < 4; ++ks) {
      const bf16x8 b0 = *(const bf16x8*)(b_s + ks * 16);
      const bf16x8 b1 = *(const bf16x8*)(b_s + 32 * LDT + ks * 16);
      bf16x8 a0[4];
#pragma unroll
      for (int i = 0; i < 4; ++i) a0[i] = *(const bf16x8*)(a_s + i * 32 * LDT + ks * 16);
      __builtin_amdgcn_s_setprio(1);
#pragma unroll
      for (int i = 0; i < 4; ++i) {
        acc[i][0] = MFMA32(a0[i], b0, acc[i][0]);
        acc[i][1] = MFMA32(a0[i], b1, acc[i][1]);
      }
      __builtin_amdgcn_s_setprio(0);
    }
    {
      u16* w = sbase + (cur ^ 1) * GEMM_STAGE;
      const int g = (kn < 16) ? 0 : (kn < 24 ? 1 : 2);
#pragma unroll
      for (int i = 0; i < 4; ++i) {
        if (ASCALE) ra[i] = scale8(ra[i], sRow[(lr + 64 * i) * 4 + g]);
        *(u32x4*)(w + (lr + 64 * i) * LDT + lc) = ra[i];
        *(u32x4*)(w + (256 + lr + 64 * i) * LDT + lc) = rb[i];
        if (ROWNORM) ssq[i] += more ? ssq8(ra[i]) : 0.f;
      }
    }
    if (CONV) {
      u32 w4 = 0;
      w4 = __builtin_amdgcn_cvt_scalef32_pk_fp4_f32(w4, cv.x * cscale, cv.y * cscale, 1.0f, 0);
      w4 = __builtin_amdgcn_cvt_scalef32_pk_fp4_f32(w4, cv.z * cscale, cv.w * cscale, 1.0f, 1);
      cdst[(size_t)kt * NTHR + tid] = (u16)w4;
    }
    __syncthreads();
  }
  if (ROWNORM) {
#pragma unroll
    for (int i = 0; i < 4; ++i) {
      float s = ssq[i];
      s += __shfl_xor(s, 1);
      s += __shfl_xor(s, 2);
      s += __shfl_xor(s, 4);
      if ((tid & 7) == 0) sRow[lr + 64 * i] = rsqrtf(s / (float)K + EPS);
    }
    __syncthreads();
  }
}

DI void conv_transpose_all(const Params& p, char* smem) {
  const int lane = otid() & 63, wid = otid() >> 6;
  float* s = (float*)smem + wid * (64 * 65);
  constexpr int T0 = 32 * 61, T1 = T0 + 32 * 32, T2 = T1 + 32 * 16, T3 = T2 + 8 * 12, T4 = T3 + 4 * 16;
  for (int f = obid() * NWAVE + wid; f < 2 * T4; f += gridDim.x * NWAVE) {
    const int L = f / T4, r = f % T4;
    const float* W; const float* g; u16* Wt; int K, N, tile;
    if (r < T0)      { W = p.w_in + (size_t)L * 2048 * 3904; g = p.ln1 + L * 2048;   Wt = p.wt_in() + (size_t)L * HLD * 2048;   K = 2048; N = 3904; tile = r; }
    else if (r < T1) { W = p.wo + (size_t)L * 2048 * 2048;   g = p.onorm + L * 2048; Wt = p.wt_o() + (size_t)L * 2048 * 2048;   K = 2048; N = 2048; tile = r - T0; }
    else if (r < T2) { W = p.pwq + (size_t)L * 2048 * 1024;  g = p.ln2 + L * 2048;   Wt = p.wt_pq() + (size_t)L * 1024 * 2048;  K = 2048; N = 1024; tile = r - T1; }
    else if (r < T3) { W = p.wuq + (size_t)L * 512 * 768;    g = p.cqn + L * 512;    Wt = p.wt_uq() + (size_t)L * 768 * 512;    K = 512;  N = 768;  tile = r - T2; }
    else             { W = p.wukv + (size_t)L * 256 * 1024;  g = p.ckvn + L * 256;   Wt = p.wt_ukv() + (size_t)L * 1024 * 256;  K = 256;  N = 1024; tile = r - T3; }
    const int ntn = N / 64;
    const int k0 = (tile / ntn) * 64, n0 = (tile % ntn) * 64;
#pragma unroll 8
    for (int kk = 0; kk < 64; ++kk) s[kk * 65 + lane] = W[(size_t)(k0 + kk) * N + n0 + lane] * g[k0 + kk];
    __builtin_amdgcn_fence(__ATOMIC_RELEASE, "wavefront");
    __builtin_amdgcn_wave_barrier();
    __builtin_amdgcn_fence(__ATOMIC_ACQUIRE, "wavefront");
#pragma unroll 8
    for (int nn = 0; nn < 64; ++nn) Wt[(size_t)(n0 + nn) * K + k0 + lane] = f2bf(s[lane * 65 + nn]);
    __builtin_amdgcn_fence(__ATOMIC_RELEASE, "wavefront");
    __builtin_amdgcn_wave_barrier();
    __builtin_amdgcn_fence(__ATOMIC_ACQUIRE, "wavefront");
  }
}
DI void conv_flat(const float* __restrict__ src, u16* __restrict__ dst, size_t n4) {
  for (size_t i = (size_t)obid() * NTHR + otid(); i < n4; i += (size_t)gridDim.x * NTHR) {
    float4 v = ((const float4*)src)[i];
    u32x2 w = {pack2bf(v.x, v.y), pack2bf(v.z, v.w)};
    ((u32x2*)dst)[i] = w;
  }
}
DI void conv_fp4(const float* __restrict__ src, unsigned char* __restrict__ dst, size_t n8, float sc) {
  for (size_t i = (size_t)obid() * NTHR + otid(); i < n8; i += (size_t)gridDim.x * NTHR) {
    const float4 a = ((const float4*)src)[i * 2 + 0], b = ((const float4*)src)[i * 2 + 1];
    u32 w = 0;
    w = __builtin_amdgcn_cvt_scalef32_pk_fp4_f32(w, a.x * sc, a.y * sc, 1.0f, 0);
    w = __builtin_amdgcn_cvt_scalef32_pk_fp4_f32(w, a.z * sc, a.w * sc, 1.0f, 1);
    w = __builtin_amdgcn_cvt_scalef32_pk_fp4_f32(w, b.x * sc, b.y * sc, 1.0f, 2);
    w = __builtin_amdgcn_cvt_scalef32_pk_fp4_f32(w, b.z * sc, b.w * sc, 1.0f, 3);
    ((u32*)dst)[i] = w;
  }
}
DI void phase_prologue(const Params& p, char* smem) {
  __syncthreads();
  conv_transpose_all(p, smem);
  for (int L = 0; L < 2; ++L) {
    u16* pad = p.wt_in() + (size_t)L * HLD * 2048 + (size_t)3904 * 2048;
    for (int i = obid() * NTHR + otid(); i < 192 * 2048 / 8; i += gridDim.x * NTHR) ((u32x4*)pad)[i] = u32x4{0, 0, 0, 0};
  }
  for (int i = obid() * NTHR + otid(); i < 2 * 256 * 128; i += gridDim.x * NTHR) {
    const int L = i >> 15, n = (i >> 7) & 255, k = i & 127;
    const int c = n >> 7, kin = k - 64 * c;
    const float v = (kin >= 0 && kin < 64) ? p.pkeys[((size_t)(L * 2 + c) * 128 + (n & 127)) * 64 + kin] : 0.f;
    p.keys_b()[i] = f2bf(v);
  }
  conv_flat(p.x, p.xb(), (size_t)T * 2048 / 4);
  for (int i = obid() * NTHR + otid(); i < SEQ * 32; i += gridDim.x * NTHR) {
    const int pos = i >> 5, f = i & 31;
    const float inv = powf(10000.0f, -(float)f / 32.0f);
    const float ang = (float)pos * inv;
    p.ropeC()[i] = cosf(ang);
    p.ropeS()[i] = sinf(ang);
  }
}

#define EPI_IDS                                                                                     \
  const int etid = otid();                                                                          \
  const int lane = etid & 63, wid = etid >> 6, wm = wid >> 2, wn = wid & 3, hh = lane >> 5, l31 = lane & 31;

DI void phase_gemm1(const Params& p, int L, char* smem) {
  const u16* Wt = p.wt_in() + (size_t)L * HLD * 2048;
  const float* sRow = (const float*)(smem + GEMM_SROW_OFF);
  for (int it = 0;; ++it) {
    int mt, nt;
    if (!gemm_tile_map(it, 64, 16, mt, nt)) { if (mt < 0) break; continue; }
    f32x16 acc[4][2];
    const int tile_id = mt * 16 + nt;
    const bool isv = tile_id >= 512;
    const float4* csrc = (const float4*)((isv ? p.pv : p.pu) + (size_t)L * NEXP * 2048) + (size_t)(tile_id & 511) * 32 * NTHR;
    u16* cdst = (u16*)((isv ? p.vb() : p.ub()) + (size_t)L * NEXP * 1024) + (size_t)(tile_id & 511) * 32 * NTHR;
    gemm_mainloop<true, true>(p.xb() + (size_t)mt * GM * 2048, 2048, Wt + (size_t)nt * GN * 2048, 2048, 2048, smem, acc, csrc, cdst,
                              isv ? V_SCALE : U_SCALE);
    EPI_IDS
    const int nt128 = nt * 2 + (wn >> 1), wn1 = wn & 1;
    const int m0 = mt * GM, b = m0 >> 12, s0 = m0 & 4095;
    if (nt128 >= 30) {
      if (nt128 == 30 && wn1 == 0) {
#pragma unroll
        for (int i = 0; i < 4; ++i)
#pragma unroll
          for (int r = 0; r < 16; ++r) {
            const int rl = wm * 128 + i * 32 + crow(r, hh);
            const float rs = sRow[rl];
            const float x1 = acc[i][0][r] * rs, x2 = acc[i][1][r] * rs;
            const int pos = s0 + rl;
            const float c = p.ropeC()[pos * 32 + l31], sn = p.ropeS()[pos * 32 + l31];
            const u16 o1 = f2bf(x1 * c - x2 * sn), o2 = f2bf(x1 * sn + x2 * c);
#pragma unroll
            for (int hd = 0; hd < 4; ++hd) {
              u16* kr = p.kmla() + ((size_t)(b * 4 + hd) * 4096 + pos) * 192 + 128;
              kr[l31] = o1;
              kr[32 + l31] = o2;
            }
            if ((r & 3) == 3) __builtin_amdgcn_sched_barrier(0);
          }
      }
    } else if (nt128 == 10 || nt128 == 11 || (nt128 >= 20 && nt128 < 24)) {
      u16* vt;
      int nh, hd;
      if (nt128 < 12) { vt = p.vtA(); nh = 2; hd = nt128 - 10; } else { vt = p.vtB(); nh = 4; hd = nt128 - 20; }
#pragma unroll
      for (int i = 0; i < 4; ++i)
#pragma unroll
        for (int j = 0; j < 2; ++j)
#pragma unroll
          for (int g4 = 0; g4 < 4; ++g4) {
            const int rl0 = wm * 128 + i * 32 + 8 * g4 + 4 * hh;
            const int d = wn1 * 64 + j * 32 + l31;
            const float v0 = acc[i][j][4 * g4 + 0] * sRow[rl0 + 0], v1 = acc[i][j][4 * g4 + 1] * sRow[rl0 + 1];
            const float v2 = acc[i][j][4 * g4 + 2] * sRow[rl0 + 2], v3 = acc[i][j][4 * g4 + 3] * sRow[rl0 + 3];
            u32x2 w = {pack2bf(v0, v1), pack2bf(v2, v3)};
            *(u32x2*)(vt + ((size_t)(b * nh + hd) * 128 + d) * 4096 + s0 + rl0) = w;
          }
    } else {
      const float sc = (nt128 < 8 || (nt128 >= 12 && nt128 < 16)) ? QSCALE_AB : 1.f;
#pragma unroll
      for (int i = 0; i < 4; ++i)
#pragma unroll
        for (int j = 0; j < 2; ++j)
#pragma unroll
          for (int r = 0; r < 16; ++r) {
            const int rl = wm * 128 + i * 32 + crow(r, hh);
            p.h()[(size_t)(m0 + rl) * HLD + nt128 * 128 + wn1 * 64 + j * 32 + l31] = f2bf(acc[i][j][r] * sRow[rl] * sc);
          }
    }
  }
}

DI void tile_upq(const Params& p, int L, int tile, char* smem) {
  const float* sRow = (const float*)(smem + GEMM_SROW_OFF);
  const int mt = tile / 3, nt = tile % 3;
  f32x16 acc[4][2];
  gemm_mainloop<true>(p.h() + (size_t)mt * GM * HLD + 3072, HLD, p.wt_uq() + (size_t)L * 768 * 512 + (size_t)nt * GN * 512, 512, 512,
                      smem, acc);
  EPI_IDS
  const int m0 = mt * GM, b = m0 >> 12, s0 = m0 & 4095;
  const int nb64 = nt * 4 + wn;
  const int head = nb64 / 3, part = nb64 % 3;
#pragma unroll
  for (int i = 0; i < 4; ++i)
#pragma unroll
    for (int j = 0; j < 2; ++j)
#pragma unroll
      for (int r = 0; r < 16; ++r) {
        const int rl = wm * 128 + i * 32 + crow(r, hh);
        const int pos = s0 + rl;
        p.qmla()[((size_t)(b * 4 + head) * 4096 + pos) * 192 + part * 64 + j * 32 + l31] = f2bf(acc[i][j][r] * sRow[rl] * QSCALE_C);
      }
}

DI void tile_upkv(const Params& p, int L, int tile, char* smem) {
  const float* sRow = (const float*)(smem + GEMM_SROW_OFF);
  const int mt = tile >> 2, nt = tile & 3;
  f32x16 acc[4][2];
  gemm_mainloop<true>(p.h() + (size_t)mt * GM * HLD + 3584, HLD, p.wt_ukv() + (size_t)L * 1024 * 256 + (size_t)nt * GN * 256, 256, 256,
                      smem, acc);
  EPI_IDS
  const int nt128 = nt * 2 + (wn >> 1), wn1 = wn & 1;
  const int m0 = mt * GM, b = m0 >> 12, s0 = m0 & 4095;
  const int head = nt128 >> 1;
  if (nt128 & 1) {
#pragma unroll
    for (int i = 0; i < 4; ++i)
#pragma unroll
      for (int j = 0; j < 2; ++j)
#pragma unroll
        for (int g4 = 0; g4 < 4; ++g4) {
          const int rl0 = wm * 128 + i * 32 + 8 * g4 + 4 * hh;
          const int d = wn1 * 64 + j * 32 + l31;
          const float v0 = acc[i][j][4 * g4 + 0] * sRow[rl0 + 0], v1 = acc[i][j][4 * g4 + 1] * sRow[rl0 + 1];
          const float v2 = acc[i][j][4 * g4 + 2] * sRow[rl0 + 2], v3 = acc[i][j][4 * g4 + 3] * sRow[rl0 + 3];
          u32x2 w = {pack2bf(v0, v1), pack2bf(v2, v3)};
          *(u32x2*)(p.vtC() + ((size_t)(b * 4 + head) * 128 + d) * 4096 + s0 + rl0) = w;
        }
  } else {
#pragma unroll
    for (int i = 0; i < 4; ++i)
#pragma unroll
      for (int j = 0; j < 2; ++j)
#pragma unroll
        for (int r = 0; r < 16; ++r) {
          const int rl = wm * 128 + i * 32 + crow(r, hh);
          const int pos = s0 + rl;
          p.kmla()[((size_t)(b * 4 + head) * 4096 + pos) * 192 + wn1 * 64 + j * 32 + l31] = f2bf(acc[i][j][r] * sRow[rl]);
        }
  }
}

DI void phase_gemm_o(const Params& p, int L, char* smem) {
  const u16* Wt = p.wt_o() + (size_t)L * 2048 * 2048;
  const float* xin = (L == 0) ? p.x : p.xres();
  for (int it = 0;; ++it) {
    int mt, nt;
    if (!gemm_tile_map(it, 64, 8, mt, nt)) { if (mt < 0) break; continue; }
    f32x16 acc[4][2];
    {
      float* sRow = (float*)(smem + GEMM_SROW_OFF);
      const int t = otid();
      __syncthreads();
      if (t < 256) {
        const float4* sp = (const float4*)(p.ssqh() + (size_t)(mt * GM + t) * 16);
        const float4 a0 = sp[0], a1 = sp[1], b0 = sp[2], c0 = sp[3];
        sRow[t * 4 + 0] = rsqrtf((a0.x + a0.y + a0.z + a0.w + a1.x + a1.y + a1.z + a1.w) * (1.f / 1024.f) + EPS);
        sRow[t * 4 + 1] = rsqrtf((b0.x + b0.y + b0.z + b0.w) * (1.f / 512.f) + EPS);
        sRow[t * 4 + 2] = rsqrtf((c0.x + c0.y + c0.z + c0.w) * (1.f / 512.f) + EPS);
      }
    }
    gemm_mainloop<false, false, true>(p.o() + (size_t)mt * GM * 2048, 2048, Wt + (size_t)nt * GN * 2048, 2048, 2048, smem, acc);
    EPI_IDS
#pragma unroll
    for (int i = 0; i < 4; ++i)
#pragma unroll
      for (int j = 0; j < 2; ++j)
#pragma unroll
        for (int r = 0; r < 16; ++r) {
          const size_t off = (size_t)(mt * GM + wm * 128 + i * 32 + crow(r, hh)) * 2048 + nt * GN + wn * 64 + j * 32 + l31;
          const float v = xin[off] + acc[i][j][r];
          p.xres()[off] = v;
          p.xb()[off] = f2bf(v);
        }
  }
}

DI void phase_gemm_pq(const Params& p, int L, char* smem) {
  const u16* Wt = p.wt_pq() + (size_t)L * 1024 * 2048;
  const float* sRow = (const float*)(smem + GEMM_SROW_OFF);
  for (int tile = obid(); tile < 64 * 4; tile += gridDim.x) {
    const int mt = tile >> 2, nt = tile & 3;
    f32x16 acc[4][2];
    gemm_mainloop<true>(p.xb() + (size_t)mt * GM * 2048, 2048, Wt + (size_t)nt * GN * 2048, 2048, 2048, smem, acc);
    EPI_IDS
#pragma unroll
    for (int i = 0; i < 4; ++i)
#pragma unroll
      for (int j = 0; j < 2; ++j)
#pragma unroll
        for (int r = 0; r < 16; ++r) {
          const int rl = wm * 128 + i * 32 + crow(r, hh);
          p.pq()[(size_t)(mt * GM + rl) * 1024 + nt * GN + wn * 64 + j * 32 + l31] = f2bf(acc[i][j][r] * sRow[rl]);
        }
  }
}

DI void phase_gemm_scores(const Params& p, int L, char* smem) {
  for (int mt = obid(); mt < 512; mt += gridDim.x) {
    f32x16 acc[4][2];
    gemm_mainloop<false>(p.pq() + (size_t)mt * GM * 128, 128, p.keys_b() + (size_t)L * 256 * 128, 128, 128, smem, acc);
    EPI_IDS
#pragma unroll
    for (int i = 0; i < 4; ++i)
#pragma unroll
      for (int j = 0; j < 2; ++j)
#pragma unroll
        for (int r = 0; r < 16; ++r) {
          const int rl = wm * 128 + i * 32 + crow(r, hh);
          p.scores()[(size_t)(mt * GM + rl) * 256 + wn * 64 + j * 32 + l31] = acc[i][j][r];
        }
  }
}

template <int DQK, int MODE>
DI void attn_block(char* smem, const u16* __restrict__ Q, int ldq, const u16* __restrict__ Kb, int ldk,
                   const u16* __restrict__ Vt, int t0, int t1, int qpos0, float slope2, float sink2,
                   const float* __restrict__ biasTbl, u16* __restrict__ Oout, float* __restrict__ ssq_out,
                   const float* __restrict__ ropeCS = nullptr) {
  constexpr int LDK = DQK + 8;
  constexpr int NCH = DQK / 8;
  constexpr int KCH = NCH / 8;
  constexpr int NKS = DQK / 16;
  constexpr int STG = 64 * LDK + 128 * 68;
  u16* sbase = (u16*)smem;
  float* sBias = (float*)(sbase + 2 * STG);
  const int tid = otid(), lane = tid & 63, wid = tid >> 6, hh = lane >> 5, l31 = lane & 31;

  __syncthreads();
  if (MODE == 1) {
    for (int i = tid; i < 465; i += NTHR) sBias[i] = biasTbl[i] * LOG2E;
  }
  bf16x8 qf[NKS];
  {
    const u16* qrow = Q + (size_t)(wid * 32 + l31) * ldq + hh * 8;
#pragma unroll
    for (int ks = 0; ks < NKS; ++ks) qf[ks] = *(const bf16x8*)(qrow + ks * 16);
  }
  if (MODE == 2) {
    const int pos = qpos0 + wid * 32 + l31;
#pragma unroll
    for (int k2 = 0; k2 < 2; ++k2) {
      const float* cp = ropeCS + (size_t)pos * 32 + k2 * 16 + 8 * hh;
      const float* sp = ropeCS + (size_t)SEQ * 32 + (size_t)pos * 32 + k2 * 16 + 8 * hh;
#pragma unroll
      for (int j = 0; j < 8; ++j) {
        const float c = cp[j], sn = sp[j];
        const float x1 = __uint_as_float(((u32)(u16)qf[NKS - 4 + k2][j]) << 16);
        const float x2 = __uint_as_float(((u32)(u16)qf[NKS - 2 + k2][j]) << 16);
        qf[NKS - 4 + k2][j] = (short)f2bf(x1 * c - x2 * sn);
        qf[NKS - 2 + k2][j] = (short)f2bf(x1 * sn + x2 * c);
      }
    }
  }
  constexpr float SM_THR = 6.f;
  float m_run = (MODE == 0) ? sink2 : 0.f;
  float l_run = (MODE == 0 && hh == 0) ? 1.f : 0.f;
  bool first = true;
  f32x16 oacc[4];
#pragma unroll
  for (int d = 0; d < 4; ++d)
#pragma unroll
    for (int r = 0; r < 16; ++r) oacc[d][r] = 0.f;

  const int widu = __builtin_amdgcn_readfirstlane(wid);
  const int qw0 = qpos0 + widu * 32;
  const int qpos = qw0 + l31;
  const int rq = (qpos0 >> 6) + (widu >> 1);
  const int rsq = min(max(rq - 4, 0), 56);
  const int cq = (wid & 1) * 32 + l31;
  const int cs = min(max(cq - 8, 0), 48);

  u32x4 rk[KCH], rv[2];
#define ATTN_LOAD_TILE(TT)                                                              \
  {                                                                                     \
    _Pragma("unroll") for (int i = 0; i < KCH; ++i) {                                   \
      const int c = tid + NTHR * i;                                                     \
      const int rr = c / NCH, cc = c % NCH;                                             \
      rk[i] = *(const u32x4*)(Kb + (size_t)((TT) * 64 + rr) * ldk + cc * 8);            \
    }                                                                                   \
    _Pragma("unroll") for (int i = 0; i < 2; ++i) {                                     \
      const int c = tid + NTHR * i;                                                     \
      const int d = c >> 3, part = c & 7;                                               \
      rv[i] = *(const u32x4*)(Vt + (size_t)d * 4096 + (TT) * 64 + part * 8);            \
    }                                                                                   \
  }
#define ATTN_STORE_TILE(STAGE)                                                          \
  {                                                                                     \
    u16* sKw = sbase + (STAGE) * STG;                                                   \
    u16* sVw = sKw + 64 * LDK;                                                          \
    _Pragma("unroll") for (int i = 0; i < KCH; ++i) {                                   \
      const int c = tid + NTHR * i;                                                     \
      const int rr = c / NCH, cc = c % NCH;                                             \
      *(u32x4*)(sKw + rr * LDK + cc * 8) = rk[i];                                       \
    }                                                                                   \
    _Pragma("unroll") for (int i = 0; i < 2; ++i) {                                     \
      const int c = tid + NTHR * i;                                                     \
      const int d = c >> 3, part = c & 7;                                               \
      *(u32x2*)(sVw + d * 68 + part * 8) = u32x2{rv[i].x, rv[i].y};                     \
      *(u32x2*)(sVw + d * 68 + part * 8 + 4) = u32x2{rv[i].z, rv[i].w};                 \
    }                                                                                   \
  }
  ATTN_LOAD_TILE(t0)
  ATTN_STORE_TILE(0)
  __syncthreads();
#pragma unroll 1
  for (int t = t0; t < t1; ++t) {
    const int cur = (t - t0) & 1;
    {
      const int tn = (t + 1 < t1) ? t + 1 : t;
      ATTN_LOAD_TILE(tn)
    }
    const u16* sK = sbase + cur * STG;
    const u16* sV = sK + 64 * LDK;
    bool relevant = true;
    if (MODE == 0) relevant = (t * 64 <= qw0 + 31 + 128) && (t * 64 + 63 >= qw0 - 128);
    if (MODE == 1) relevant = (t >= rsq) && (t < rsq + 8);
    if (relevant) {
      f32x16 sacc[2];
#pragma unroll
      for (int tt = 0; tt < 2; ++tt) {
#pragma unroll
        for (int r = 0; r < 16; ++r) sacc[tt][r] = -m_run;
        const u16* kp = sK + (tt * 32 + l31) * LDK + hh * 8;
#pragma unroll
        for (int ks = 0; ks < NKS; ++ks) {
          bf16x8 kf = *(const bf16x8*)(kp + ks * 16);
          sacc[tt] = MFMA32(kf, qf[ks], sacc[tt]);
        }
      }
      float mx = -INFINITY;
      const int drow = min(max(t - rq + 7, 0), 14) * 31;
#pragma unroll
      for (int tt = 0; tt < 2; ++tt)
#pragma unroll
        for (int r = 0; r < 16; ++r) {
          float sv = sacc[tt][r];
          const int kl = tt * 32 + crow(r, hh);
          if (MODE == 0) {
            const int kpos = t * 64 + kl;
            int dist = qpos - kpos;
            dist = dist < 0 ? -dist : dist;
            sv = (dist <= 128) ? (sv - slope2 * (float)dist) : -INFINITY;
          } else if (MODE == 1) {
            const bool ok = ((unsigned)(kl - cs) < 16u);
            const int dc = min(max(kl - cq + 15, 0), 30);
            sv = ok ? (sv + sBias[drow + dc]) : -INFINITY;
          }
          sacc[tt][r] = sv;
          mx = fmaxf(mx, sv);
        }
      mx = fmaxf(mx, __shfl_xor(mx, 32));
      if (__builtin_amdgcn_ballot_w64(first || (mx > SM_THR)) != 0ull) {
        float delta = fmaxf(mx, 0.f);
        if (first && MODE != 0) delta = (mx > -INFINITY) ? mx : 0.f;
        m_run += delta;
        const float alpha = __builtin_amdgcn_exp2f(-delta);
        l_run *= alpha;
#pragma unroll
        for (int d = 0; d < 4; ++d)
#pragma unroll
          for (int r = 0; r < 16; ++r) oacc[d][r] *= alpha;
#pragma unroll
        for (int tt = 0; tt < 2; ++tt)
#pragma unroll
          for (int r = 0; r < 16; ++r) sacc[tt][r] -= delta;
        first = false;
      }
      float ps = 0.f;
#pragma unroll
      for (int tt = 0; tt < 2; ++tt) {
#pragma unroll
        for (int r = 0; r < 16; ++r) {
          const float pv = __builtin_amdgcn_exp2f(sacc[tt][r]);
          sacc[tt][r] = pv;
          ps += pv;
        }
#pragma unroll
        for (int s2 = 0; s2 < 2; ++s2) {
          u32x4 w;
          w.x = pack2bf(sacc[tt][8 * s2 + 0], sacc[tt][8 * s2 + 1]);
          w.y = pack2bf(sacc[tt][8 * s2 + 2], sacc[tt][8 * s2 + 3]);
          w.z = pack2bf(sacc[tt][8 * s2 + 4], sacc[tt][8 * s2 + 5]);
          w.w = pack2bf(sacc[tt][8 * s2 + 6], sacc[tt][8 * s2 + 7]);
          const bf16x8 pf = __builtin_bit_cast(bf16x8, w);
#pragma unroll
          for (int dt = 0; dt < 4; ++dt) {
            const u16* vp = sV + (dt * 32 + l31) * 68 + 4 * hh;
            const u32x2 lo = *(const u32x2*)(vp + tt * 32 + s2 * 16);
            const u32x2 hi = *(const u32x2*)(vp + tt * 32 + s2 * 16 + 8);
            u32x4 wv = {lo.x, lo.y, hi.x, hi.y};
            oacc[dt] = MFMA32(__builtin_bit_cast(bf16x8, wv), pf, oacc[dt]);
          }
        }
      }
      l_run += ps;
    }
    ATTN_STORE_TILE(cur ^ 1)
    __syncthreads();
  }
  const float lt = l_run + __shfl_xor(l_run, 32);
  const float inv = 1.f / lt;
  float sq = 0.f;
  u16* orow = Oout + (size_t)(wid * 32 + l31) * 2048;
#pragma unroll
  for (int dt = 0; dt < 4; ++dt)
#pragma unroll
    for (int g4 = 0; g4 < 4; ++g4) {
      const float v0 = oacc[dt][4 * g4 + 0] * inv, v1 = oacc[dt][4 * g4 + 1] * inv;
      const float v2 = oacc[dt][4 * g4 + 2] * inv, v3 = oacc[dt][4 * g4 + 3] * inv;
      sq += v0 * v0 + v1 * v1 + v2 * v2 + v3 * v3;
      u32x2 w = {pack2bf(v0, v1), pack2bf(v2, v3)};
      *(u32x2*)(orow + dt * 32 + 8 * g4 + 4 * hh) = w;
    }
  sq += __shfl_xor(sq, 32);
  if (hh == 0) ssq_out[(size_t)(wid * 32 + l31) * 16] = sq;
}

DI void phase_mix(const Params& p, int L, char* smem) {
  for (int w = obid(); w < 256; w += gridDim.x) {
    const int b = w >> 6, rem = w & 63, rg = rem >> 2, hb = rem & 3;
    const int r0 = rg * 4;
    const int t0 = min(max(r0 - 4, 0), 56), t1 = min(max(r0 - 1, 0), 56) + 8;
    const size_t tok0 = (size_t)b * 4096 + r0 * 64;
    attn_block<128, 1>(smem, p.h() + tok0 * HLD + 1536 + hb * 128, HLD, p.h() + (size_t)b * 4096 * HLD + 2048 + hb * 128, HLD,
                       p.vtB() + (size_t)(b * 4 + hb) * 128 * 4096, t0, t1, r0 * 64, 0.f, 0.f,
                       p.b_rel + (size_t)L * 4 * 465 + hb * 465, p.o() + tok0 * 2048 + 1024 + hb * 128, p.ssqh() + tok0 * 16 + 8 + hb);
  }
  for (int ww = obid(); ww < 512; ww += gridDim.x) {
    const int b = ww >> 7, rem = ww & 127, sb = rem >> 3, hq = rem & 7;
    const int t0 = max(0, 4 * sb - 2), t1 = min(64, 4 * sb + 6);
    const size_t tok0 = (size_t)b * 4096 + sb * 256;
    const float slope2 = exp2f(-(float)(hq + 1)) * LOG2E;
    const float sink2 = p.a_sink[L * 8 + hq] * LOG2E;
    attn_block<128, 0>(smem, p.h() + tok0 * HLD + hq * 128, HLD, p.h() + (size_t)b * 4096 * HLD + 1024 + (hq >> 2) * 128, HLD,
                       p.vtA() + (size_t)(b * 2 + (hq >> 2)) * 128 * 4096, t0, t1, sb * 256, slope2, sink2, nullptr,
                       p.o() + tok0 * 2048 + hq * 128, p.ssqh() + tok0 * 16 + hq);
  }
  for (int w = (obid() + 64) % gridDim.x; w < 192; w += gridDim.x) tile_upq(p, L, w, smem);
  for (int w = obid(); w < 256; w += gridDim.x) tile_upkv(p, L, w, smem);
}

DI void phase_mla(const Params& p, char* smem) {
  const int nbx = gridDim.x >> 3;
  for (int li = obid() >> 3; li < 32; li += nbx) {
    const int pair = (obid() & 7) * 2 + (li >> 4), nq = li & 15;
    const int b = pair >> 2, hc = pair & 3;
    const size_t tok0 = (size_t)b * 4096 + nq * 256;
    attn_block<192, 2>(smem, p.qmla() + ((size_t)(b * 4 + hc) * 4096 + nq * 256) * 192, 192, p.kmla() + (size_t)(b * 4 + hc) * 4096 * 192, 192,
                       p.vtC() + (size_t)(b * 4 + hc) * 128 * 4096, 0, 64, nq * 256, 0.f, 0.f, nullptr,
                       p.o() + tok0 * 2048 + 1536 + hc * 128, p.ssqh() + tok0 * 16 + 12 + hc, p.ropeC());
  }
}

DI void phase_onorm(const Params& p) {
  const int lane = otid() & 63, wid = otid() >> 6;
  for (int row = obid() * NWAVE + wid; row < T; row += gridDim.x * NWAVE) {
    const float4* sp = (const float4*)(p.ssqh() + (size_t)row * 16);
    const float4 a0 = sp[0], a1 = sp[1], b0 = sp[2], c0 = sp[3];
    const float rA = rsqrtf((a0.x + a0.y + a0.z + a0.w + a1.x + a1.y + a1.z + a1.w) * (1.f / 1024.f) + EPS);
    const float rB = rsqrtf((b0.x + b0.y + b0.z + b0.w) * (1.f / 512.f) + EPS);
    const float rC = rsqrtf((c0.x + c0.y + c0.z + c0.w) * (1.f / 512.f) + EPS);
#pragma unroll
    for (int j = 0; j < 4; ++j) {
      const float sc = (j < 2) ? rA : (j == 2 ? rB : rC);
      const size_t off = (size_t)row * 2048 + j * 512 + lane * 8;
      u32x4 w = *(const u32x4*)(p.o() + off);
      w.x = pack2bf(bf_lo(w.x) * sc, bf_hi(w.x) * sc);
      w.y = pack2bf(bf_lo(w.y) * sc, bf_hi(w.y) * sc);
      w.z = pack2bf(bf_lo(w.z) * sc, bf_hi(w.z) * sc);
      w.w = pack2bf(bf_lo(w.w) * sc, bf_hi(w.w) * sc);
      *(u32x4*)(p.on() + off) = w;
    }
  }
}

DI u32 ordkey(float s) {
  const u32 u = __float_as_uint(s);
  return u ^ ((u >> 31) ? 0xFFFFFFFFu : 0x80000000u);
}
DI float unord(u32 k) {
  const u32 u = (k & 0x80000000u) ? (k ^ 0x80000000u) : ~k;
  return __uint_as_float(u);
}
DI void insert16(u32 (&Ls)[16], u32 key) {
#pragma unroll
  for (int q = 0; q < 16; ++q) {
    const u32 hi = max(Ls[q], key);
    key = min(Ls[q], key);
    Ls[q] = hi;
  }
}

DI void phase_select(const Params& p, int L, char* smem) {
  float* sS = (float*)smem;
  u32* sTop = (u32*)(smem + 256 * 132 * 4);
  const int tid = otid(), lane = tid & 63, wid = tid >> 6, hh = lane >> 5, l31 = lane & 31;
  const int rt = wid >> 1, c = wid & 1;
  const u16* kb = p.keys_b() + (size_t)L * 256 * 128;
  for (int it = obid(); it < 1024; it += gridDim.x) {
    f32x16 sc[4];
    {
      const u16* qrow = p.pq() + ((size_t)it * 128 + rt * 32 + l31) * 128 + c * 64 + hh * 8;
      bf16x8 qa[4];
#pragma unroll
      for (int ks = 0; ks < 4; ++ks) qa[ks] = *(const bf16x8*)(qrow + ks * 16);
#pragma unroll
      for (int ct = 0; ct < 4; ++ct) {
#pragma unroll
        for (int r = 0; r < 16; ++r) sc[ct][r] = 0.f;
        const u16* krow = kb + (size_t)(c * 128 + ct * 32 + l31) * 128 + c * 64 + hh * 8;
#pragma unroll
        for (int ks = 0; ks < 4; ++ks) {
          const bf16x8 kf = *(const bf16x8*)(krow + ks * 16);
          sc[ct] = MFMA32(qa[ks], kf, sc[ct]);
        }
      }
    }
    __syncthreads();
#pragma unroll
    for (int ct = 0; ct < 4; ++ct)
#pragma unroll
      for (int r = 0; r < 16; ++r) sS[((rt * 32 + crow(r, hh)) * 2 + c) * 132 + ct * 32 + l31] = sc[ct][r];
    __syncthreads();
    {
      const int combo = tid >> 1, half = tid & 1;
      u32 Ls[16];
#pragma unroll
      for (int q = 0; q < 16; ++q) Ls[q] = 0u;
      const float* sp = sS + combo * 132 + half * 64;
      for (int n4 = 0; n4 < 16; ++n4) {
        const int n4r = (n4 + half * 8) & 15;
        const float4 v = *(const float4*)(sp + n4r * 4);
        const int nb = half * 64 + n4r * 4;
        insert16(Ls, (ordkey(v.x) & ~0x7Fu) | (u32)(127 - (nb + 0)));
        insert16(Ls, (ordkey(v.y) & ~0x7Fu) | (u32)(127 - (nb + 1)));
        insert16(Ls, (ordkey(v.z) & ~0x7Fu) | (u32)(127 - (nb + 2)));
        insert16(Ls, (ordkey(v.w) & ~0x7Fu) | (u32)(127 - (nb + 3)));
      }
      u32 Ms[16];
#pragma unroll
      for (int q = 0; q < 16; ++q) {
        const u32 other = (u32)__shfl_xor((int)Ls[15 - q], 1);
        Ms[q] = max(Ls[q], other);
      }
#pragma unroll
      for (int span = 8; span >= 1; span >>= 1)
#pragma unroll
        for (int q = 0; q < 16; ++q)
          if ((q & span) == 0) {
            const u32 hi = max(Ms[q], Ms[q + span]), lo = min(Ms[q], Ms[q + span]);
            Ms[q] = hi;
            Ms[q + span] = lo;
          }
      if (half == 0) {
#pragma unroll
        for (int q = 0; q < 16; ++q) sTop[combo * 16 + q] = Ms[q];
      }
    }
    __syncthreads();
    if (tid < 128) {
      const u32* t0 = sTop + (tid * 2) * 16;
      const u32* t1 = sTop + (tid * 2 + 1) * 16;
      float s0[16], s1[16];
#pragma unroll
      for (int q = 0; q < 16; ++q) {
        s0[q] = unord(t0[q] & ~0x7Fu);
        s1[q] = unord(t1[q] & ~0x7Fu);
      }
      u32 M[16];
#pragma unroll
      for (int q = 0; q < 16; ++q) M[q] = 0u;
#pragma unroll
      for (int i = 0; i < 16; ++i)
#pragma unroll
        for (int j = 0; j < 16; ++j)
          if ((i + 1) * (j + 1) <= 16) {
            const float sm = s0[i] + s1[j];
            insert16(M, (ordkey(sm) & ~0xFFu) | (u32)(255 - (i * 16 + j)));
          }
      const float mxv = unord(M[0] & ~0xFFu);
      float e[16], sum = 0.f;
#pragma unroll
      for (int q = 0; q < 16; ++q) {
        e[q] = __expf(unord(M[q] & ~0xFFu) - mxv);
        sum += e[q];
      }
      const float inv = 1.f / sum;
      const size_t row = (size_t)it * 128 + tid;
#pragma unroll
      for (int q = 0; q < 16; ++q) {
        const int ij = 255 - (int)(M[q] & 0xFFu);
        const int n0 = 127 - (int)(t0[ij >> 4] & 0x7Fu);
        const int n1 = 127 - (int)(t1[ij & 15] & 0x7Fu);
        p.idx()[row * 16 + q] = n0 * 128 + n1;
        p.g()[row * 16 + q] = e[q] * inv;
      }
    }
  }
}

DI float dot32(u32x4 w, const float2_t* xn2) {
  float2_t s = {0.f, 0.f};
#pragma unroll
  for (int c = 0; c < 4; ++c) {
    s = __builtin_elementwise_fma(__builtin_amdgcn_cvt_scalef32_pk_f32_fp4(w[c], 1.0f, 0), xn2[4 * c + 0], s);
    s = __builtin_elementwise_fma(__builtin_amdgcn_cvt_scalef32_pk_f32_fp4(w[c], 1.0f, 1), xn2[4 * c + 1], s);
    s = __builtin_elementwise_fma(__builtin_amdgcn_cvt_scalef32_pk_f32_fp4(w[c], 1.0f, 2), xn2[4 * c + 2], s);
    s = __builtin_elementwise_fma(__builtin_amdgcn_cvt_scalef32_pk_f32_fp4(w[c], 1.0f, 3), xn2[4 * c + 3], s);
  }
  return s.x + s.y;
}
DI void axpy32(u32x4 w, float a, float2_t* y2) {
  const float2_t a2 = {a, a};
#pragma unroll
  for (int c = 0; c < 4; ++c) {
    y2[4 * c + 0] = __builtin_elementwise_fma(__builtin_amdgcn_cvt_scalef32_pk_f32_fp4(w[c], 1.0f, 0), a2, y2[4 * c + 0]);
    y2[4 * c + 1] = __builtin_elementwise_fma(__builtin_amdgcn_cvt_scalef32_pk_f32_fp4(w[c], 1.0f, 1), a2, y2[4 * c + 1]);
    y2[4 * c + 2] = __builtin_elementwise_fma(__builtin_amdgcn_cvt_scalef32_pk_f32_fp4(w[c], 1.0f, 2), a2, y2[4 * c + 2]);
    y2[4 * c + 3] = __builtin_elementwise_fma(__builtin_amdgcn_cvt_scalef32_pk_f32_fp4(w[c], 1.0f, 3), a2, y2[4 * c + 3]);
  }
}
DI float gelu_tanh(float a) {
  const float u = 0.7978845608028654f * (a + 0.044715f * a * a * a);
  return 0.5f * a * (1.f + tanhf(u));
}

DI void phase_gather(const Params& p, int L, bool last) {
  const int wid = otid() >> 6;
  const unsigned char* U = p.ub() + (size_t)L * NEXP * 1024;
  const unsigned char* V = p.vb() + (size_t)L * NEXP * 1024;
  const float* ln2 = p.ln2 + L * 2048;
  int ni0 = 0, ni1 = 0;
  float ng0 = 0.f, ng1 = 0.f;
  {
    const int t0 = obid() * NWAVE + wid, l0 = otid() & 63;
    if (t0 < T) {
      ni0 = p.idx()[(size_t)t0 * 128 + l0]; ni1 = p.idx()[(size_t)t0 * 128 + 64 + l0];
      ng0 = p.g()[(size_t)t0 * 128 + l0];   ng1 = p.g()[(size_t)t0 * 128 + 64 + l0];
    }
  }
  for (int t = obid() * NWAVE + wid; t < T; t += gridDim.x * NWAVE) {
    const int lane = otid() & 63;
    float* xr = p.xres() + (size_t)t * 2048;
    float2_t xn2[16];
    float ss = 0.f;
#pragma unroll
    for (int c4 = 0; c4 < 8; ++c4) {
      const float4 a = *(const float4*)(xr + lane * 32 + c4 * 4);
      xn2[c4 * 2 + 0] = float2_t{a.x, a.y};
      xn2[c4 * 2 + 1] = float2_t{a.z, a.w};
    }
#pragma unroll
    for (int e = 0; e < 16; ++e) ss += xn2[e].x * xn2[e].x + xn2[e].y * xn2[e].y;
    ss = wave_sum(ss);
    const float rstd = rsqrtf(ss * (1.f / 2048.f) + EPS) * (1.f / U_SCALE);
#pragma unroll
    for (int c4 = 0; c4 < 8; ++c4) {
      const float4 a = *(const float4*)(ln2 + lane * 32 + c4 * 4);
      xn2[c4 * 2 + 0] *= float2_t{rstd * a.x, rstd * a.y};
      xn2[c4 * 2 + 1] *= float2_t{rstd * a.z, rstd * a.w};
    }
    const int i0 = ni0, i1 = ni1;
    const float g0 = ng0, g1 = ng1;
    float a0 = 0.f, a1 = 0.f;
#pragma unroll
    for (int half = 0; half < 2; ++half) {
      const int iv = half ? i1 : i0;
      float av = 0.f;
#pragma unroll 1
      for (int k0 = 0; k0 < 64; k0 += 16) {
        u32x4 w[16];
#pragma unroll
        for (int q = 0; q < 16; ++q) {
          const int row = __builtin_amdgcn_readlane(iv, k0 + q);
          w[q] = *(const u32x4*)(U + (size_t)row * 1024 + lane * 16);
        }
        float d[16];
#pragma unroll
        for (int q = 0; q < 16; ++q) {
          __builtin_amdgcn_sched_barrier(0);
          if (q > 0) asm volatile("" : "+v"(w[q]), "+v"(d[q - 1]));
          d[q] = dot32(w[q], xn2);
        }
        __builtin_amdgcn_sched_barrier(0);
        {
          const bool b5 = (lane & 32) != 0, b4 = (lane & 16) != 0, b3 = (lane & 8) != 0, b2 = (lane & 4) != 0;
          float e8[8], e4[4], e2[2], e1;
#pragma unroll
          for (int j = 0; j < 8; ++j) {
            const float snd = b5 ? d[j] : d[j + 8];
            const float kep = b5 ? d[j + 8] : d[j];
            e8[j] = kep + __shfl_xor(snd, 32);
          }
#pragma unroll
          for (int j = 0; j < 4; ++j) {
            const float snd = b4 ? e8[j] : e8[j + 4];
            const float kep = b4 ? e8[j + 4] : e8[j];
            e4[j] = kep + __shfl_xor(snd, 16);
          }
#pragma unroll
          for (int j = 0; j < 2; ++j) {
            const float snd = b3 ? e4[j] : e4[j + 2];
            const float kep = b3 ? e4[j + 2] : e4[j];
            e2[j] = kep + __shfl_xor(snd, 8);
          }
          {
            const float snd = b2 ? e2[0] : e2[1];
            const float kep = b2 ? e2[1] : e2[0];
            e1 = kep + __shfl_xor(snd, 4);
          }
          e1 += __shfl_xor(e1, 2);
          e1 += __shfl_xor(e1, 1);
          const float got = __shfl(e1, ((lane - k0) & 15) * 4);
          if (lane >= k0 && lane < k0 + 16) av = got;
        }
      }
      if (half) a1 = av; else a0 = av;
    }
    const float hs0 = gelu_tanh(a0) * g0 * (1.f / V_SCALE), hs1 = gelu_tanh(a1) * g1 * (1.f / V_SCALE);
    {
      const int tn = t + gridDim.x * NWAVE;
      if (tn < T) {
        ni0 = p.idx()[(size_t)tn * 128 + lane]; ni1 = p.idx()[(size_t)tn * 128 + 64 + lane];
        ng0 = p.g()[(size_t)tn * 128 + lane];   ng1 = p.g()[(size_t)tn * 128 + 64 + lane];
      }
    }
    float2_t y2[16];
#pragma unroll
    for (int e = 0; e < 16; ++e) y2[e] = float2_t{0.f, 0.f};
#pragma unroll
    for (int half = 0; half < 2; ++half) {
      const int iv = half ? i1 : i0;
      const int hv = __float_as_int(half ? hs1 : hs0);
#pragma unroll 1
      for (int k0 = 0; k0 < 64; k0 += 8) {
        u32x4 w[8];
        float wq[8];
#pragma unroll
        for (int q = 0; q < 8; ++q) {
          const int row = __builtin_amdgcn_readlane(iv, k0 + q);
          wq[q] = __int_as_float(__builtin_amdgcn_readlane(hv, k0 + q));
          w[q] = *(const u32x4*)(V + (size_t)row * 1024 + lane * 16);
        }
#pragma unroll
        for (int q = 0; q < 8; ++q) {
          __builtin_amdgcn_sched_barrier(0);
          asm volatile("" : "+v"(w[q]), "+v"(y2[0]), "+v"(y2[8]));
          axpy32(w[q], wq[q], y2);
        }
        __builtin_amdgcn_sched_barrier(0);
      }
    }
    int t2 = t;
    asm volatile("" : "+v"(t2));
    const int lane2 = otid() & 63;
    float* xr2 = p.xres() + (size_t)t2 * 2048;
#pragma unroll
    for (int c4 = 0; c4 < 8; ++c4) {
      const float4 a = *(const float4*)(xr2 + lane2 * 32 + c4 * 4);
      y2[c4 * 2 + 0] += float2_t{a.x, a.y};
      y2[c4 * 2 + 1] += float2_t{a.z, a.w};
    }
    if (!last) {
#pragma unroll
      for (int c4 = 0; c4 < 8; ++c4)
        *(float4*)(xr2 + lane2 * 32 + c4 * 4) = float4{y2[c4 * 2].x, y2[c4 * 2].y, y2[c4 * 2 + 1].x, y2[c4 * 2 + 1].y};
#pragma unroll
      for (int c8 = 0; c8 < 4; ++c8) {
        const float2_t* yy = y2 + c8 * 4;
        u32x4 w = {pack2bf(yy[0].x, yy[0].y), pack2bf(yy[1].x, yy[1].y), pack2bf(yy[2].x, yy[2].y), pack2bf(yy[3].x, yy[3].y)};
        *(u32x4*)(p.xb() + (size_t)t2 * 2048 + lane2 * 32 + c8 * 8) = w;
      }
    } else {
      float ss2 = 0.f;
#pragma unroll
      for (int e = 0; e < 16; ++e) ss2 += y2[e].x * y2[e].x + y2[e].y * y2[e].y;
      ss2 = wave_sum(ss2);
      const float r2 = rsqrtf(ss2 * (1.f / 2048.f) + EPS);
      float* orow = p.out + (size_t)t2 * 2048;
#pragma unroll
      for (int c4 = 0; c4 < 8; ++c4) {
        const float4 a = *(const float4*)(p.fnorm + lane2 * 32 + c4 * 4);
        *(float4*)(orow + lane2 * 32 + c4 * 4) =
            float4{y2[c4 * 2].x * r2 * a.x, y2[c4 * 2].y * r2 * a.y, y2[c4 * 2 + 1].x * r2 * a.z, y2[c4 * 2 + 1].y * r2 * a.w};
      }
    }
  }
}


#define XB_TMO      128
#define XB_XCNT(j)  (256  + 64 * (j))
#define XB_XSUB(j)  (1280 + 64 * (j))
#define XB_XGEN(j)  (2304 + 64 * (j))
#define XB_TOP      3328
#define XB_TOPGEN   3392
#define XCD_BAR_WORDS 3456
#define XB_SPIN_CAP (1u << 18)
#define LAS __attribute__((address_space(3)))
DI unsigned xb_ld(unsigned* p) { return __hip_atomic_load(p, __ATOMIC_RELAXED, __HIP_MEMORY_SCOPE_AGENT); }
DI unsigned xb_add(unsigned* p, unsigned v) { return __hip_atomic_fetch_add(p, v, __ATOMIC_RELAXED, __HIP_MEMORY_SCOPE_AGENT); }
DI unsigned xb_xcc_id() { return (unsigned)__builtin_amdgcn_s_getreg((3 << 11) | 20) & 0xFu; }
#define XB_SPIN(cond, bar) do { unsigned _sp = 0; while (cond) { __builtin_amdgcn_s_sleep(1); \
    if ((++_sp & 255u) == 0u) { if (xb_ld(&(bar)[XB_TMO])) break; if (_sp > XB_SPIN_CAP) { atomicAdd(&(bar)[XB_TMO], 1u); break; } } } } while (0)
struct XcdBarrier { unsigned* bar; unsigned x; volatile LAS unsigned* st; };
DI XcdBarrier xcd_barrier_post(unsigned* bar, volatile LAS unsigned* st) {
  XcdBarrier b; b.bar = bar; b.x = xb_xcc_id(); b.st = st;
  if (threadIdx.x == 0) (void)xb_add(&bar[XB_XCNT(b.x)], 1u);
  return b;
}
DI void xcd_barrier_complete(unsigned* bar, unsigned x, unsigned& nloc, unsigned& nx) {
  const unsigned G = gridDim.x * gridDim.y * gridDim.z;
  unsigned sum, cnt, mine, sp = 0u;
  for (;;) {
    sum = 0u; cnt = 0u; mine = 0u;
#pragma unroll
    for (unsigned j = 0; j < 16; ++j) { const unsigned c = xb_ld(&bar[XB_XCNT(j)]); sum += c; cnt += (c > 0u) ? 1u : 0u; mine = (j == x) ? c : mine; }
    if (sum == G) break;
    __builtin_amdgcn_s_sleep(1);
    if ((++sp & 255u) == 0u) { if (xb_ld(&bar[XB_TMO])) break; if (sp > XB_SPIN_CAP) { atomicAdd(&bar[XB_TMO], 1u); break; } }
  }
  nloc = mine > 0u ? mine : 1u; nx = cnt > 0u ? cnt : 1u;
}
DI void xcd_barrier(const XcdBarrier& b) {
  asm volatile("s_waitcnt vmcnt(0)" ::: "memory");
  __syncthreads();
  if (threadIdx.x == 0) {
    unsigned* bar = b.bar;
    __builtin_amdgcn_s_waitcnt(0);
    unsigned nloc = b.st[0], nx = b.st[1];
    if (nloc == 0u) { xcd_barrier_complete(bar, b.x, nloc, nx); b.st[0] = nloc; b.st[1] = nx; }
    const unsigned old = xb_add(&bar[XB_XSUB(b.x)], 1u);
    const unsigned gen = old / nloc;
    if (old + 1u == (gen + 1u) * nloc) {
      __builtin_amdgcn_fence(__ATOMIC_RELEASE, "agent");
      asm volatile("s_waitcnt vmcnt(0)" ::: "memory");
      const unsigned og = xb_add(&bar[XB_TOP], 1u);
      const unsigned tg = og / nx;
      if (og + 1u == (tg + 1u) * nx) xb_add(&bar[XB_TOPGEN], 1u);
      else XB_SPIN(xb_ld(&bar[XB_TOPGEN]) == tg, bar);
      __builtin_amdgcn_fence(__ATOMIC_ACQUIRE, "agent");
      xb_add(&bar[XB_XGEN(b.x)], 1u);
      asm volatile("s_waitcnt vmcnt(0)" ::: "memory");
    } else {
      XB_SPIN(xb_ld(&bar[XB_XGEN(b.x)]) == gen, bar);
      __builtin_amdgcn_fence(__ATOMIC_ACQUIRE, "agent");
      asm volatile("s_waitcnt vmcnt(0)" ::: "memory");
    }
  }
  __syncthreads();
}

#define KDEF(name, body)                                                       \
  __global__ void __launch_bounds__(512) name(Params p, int L) {            \
    __shared__ __attribute__((aligned(16))) char smem[SMEM_BYTES];             \
    body;                                                                      \
  }
#if !MEGA
KDEF(k_prologue, phase_prologue(p, smem))
KDEF(k_gemm1, phase_gemm1(p, L, smem))
KDEF(k_mix, phase_mix(p, L, smem))
KDEF(k_mla, phase_mla(p, smem))
KDEF(k_onorm, phase_onorm(p))
KDEF(k_gemm_o, phase_gemm_o(p, L, smem))
KDEF(k_gemm_pq, phase_gemm_pq(p, L, smem))
KDEF(k_scores, phase_gemm_scores(p, L, smem))
KDEF(k_select, phase_select(p, L, smem))
KDEF(k_gather, phase_gather(p, L, L == 1))
#else
#ifndef PROBE_MASK
#define PROBE_MASK 0
#endif
#define RUN(bit, call)                         \
  call;                                        \
  if (PROBE_MASK & (bit)) {                    \
    grid.sync();                               \
    call;                                      \
  }
__global__ void __launch_bounds__(512) mega_coop(Params p) {
  __shared__ __attribute__((aligned(16))) char smem[SMEM_BYTES];
  __shared__ uint4 xb_words;
  cg::grid_group grid = cg::this_grid();
  if (threadIdx.x == 0) xb_words = make_uint4(0u, 0u, 0u, 0u);
  __syncthreads();
  const XcdBarrier xb = xcd_barrier_post((unsigned*)(p.ws + WS_NEED), (volatile LAS unsigned*)&xb_words);
#define GSYNC xcd_barrier(xb)
  RUN(256, phase_prologue(p, smem))
  if (p.ws == nullptr) grid.sync();
  GSYNC;
#pragma unroll 1
  for (int L = 0; L < 2; ++L) {
    phase_gemm1(p, L, smem);
    GSYNC;
    phase_mix(p, L, smem);
    GSYNC;
    phase_mla(p, smem);
    GSYNC;
    phase_gemm_o(p, L, smem);
    GSYNC;
    phase_gemm_pq(p, L, smem);
    GSYNC;
    phase_select(p, L, smem);
    GSYNC;
    phase_gather(p, L, L == 1);
    if (L == 0) GSYNC;
  }
}
#endif

extern "C" void kernel_launch(void* const* d_in, const int* in_sizes, int n_in, void* d_out, int out_size, void* d_ws,
                              size_t ws_size, hipStream_t stream) {
  Params p{};
  p.x = (const float*)d_in[0]; p.ln1 = (const float*)d_in[1]; p.w_in = (const float*)d_in[2]; p.a_sink = (const float*)d_in[3];
  p.b_rel = (const float*)d_in[4]; p.cqn = (const float*)d_in[5]; p.ckvn = (const float*)d_in[6]; p.wuq = (const float*)d_in[7];
  p.wukv = (const float*)d_in[8]; p.onorm = (const float*)d_in[9]; p.wo = (const float*)d_in[10]; p.ln2 = (const float*)d_in[11];
  p.pwq = (const float*)d_in[12]; p.pkeys = (const float*)d_in[13]; p.pu = (const float*)d_in[14]; p.pv = (const float*)d_in[15];
  p.fnorm = (const float*)d_in[16];
  p.out = (float*)d_out;
  p.ws = (char*)d_ws;
  if (WS_NEED + XCD_BAR_WORDS * sizeof(unsigned) > ws_size) { fprintf(stderr, "kernel_launch: workspace too small (%zu > %zu)\n", (size_t)WS_NEED, ws_size); return; }

#if MEGA
  static int grid_blocks = 0;
  if (!grid_blocks) {
    int dev = 0, cus = 0, per_cu = 0;
    hipGetDevice(&dev);
    hipDeviceGetAttribute(&cus, hipDeviceAttributeMultiprocessorCount, dev);
    hipOccupancyMaxActiveBlocksPerMultiprocessor(&per_cu, mega_coop, NTHR, 0);
    if (per_cu > 1) per_cu = 1;
    if (per_cu < 1) per_cu = 1;
    grid_blocks = (cus * per_cu) & ~7;
  }
  (void)hipMemsetAsync(p.ws + WS_NEED, 0, XCD_BAR_WORDS * sizeof(unsigned), stream);
  void* args[] = {&p};
  hipError_t e = hipLaunchCooperativeKernel((void*)mega_coop, dim3(grid_blocks), dim3(NTHR), args, 0, stream);
  if (e != hipSuccess) fprintf(stderr, "cooperative launch failed: %s (grid %d)\n", hipGetErrorString(e), grid_blocks);
#else
  const dim3 g(256), b(NTHR);
  k_prologue<<<g, b, 0, stream>>>(p, 0);
  for (int L = 0; L < 2; ++L) {
    k_gemm1<<<g, b, 0, stream>>>(p, L);
    k_mix<<<g, b, 0, stream>>>(p, L);
    k_mla<<<g, b, 0, stream>>>(p, L);
    k_gemm_o<<<g, b, 0, stream>>>(p, L);
    k_gemm_pq<<<g, b, 0, stream>>>(p, L);
    k_select<<<g, b, 0, stream>>>(p, L);
    k_gather<<<g, b, 0, stream>>>(p, L);
  }
#endif
}
```

```cpp
#include <hip/hip_runtime.h>
#include <hip/hip_cooperative_groups.h>
#include <cstdio>
namespace cg = cooperative_groups;

#ifndef MEGA
#define MEGA 1
#endif

#define DI __device__ __forceinline__
typedef unsigned short u16;
typedef unsigned int u32;
using bf16x8 = __attribute__((ext_vector_type(8))) short;
using f32x16 = __attribute__((ext_vector_type(16))) float;
typedef __bf16 bf16x2_t __attribute__((ext_vector_type(2)));
typedef float float2_t __attribute__((ext_vector_type(2)));
typedef unsigned int u32x4 __attribute__((ext_vector_type(4)));
typedef unsigned int u32x2 __attribute__((ext_vector_type(2)));

constexpr int T = 16384, SEQ = 4096, DM = 2048, HLD = 4096;
constexpr int NTHR = 512, NWAVE = 8;
constexpr int NEXP = 16384;
constexpr float EPS = 1e-6f;
constexpr float LOG2E = 1.4426950408889634f;
constexpr float QSCALE_AB = 0.08838834764831845f * LOG2E;
constexpr float QSCALE_C = 0.07216878364870323f * LOG2E;
constexpr float U_SCALE = 90.5f, V_SCALE = 8.f;
constexpr int LDT = 72;
constexpr int GEMM_STAGE = 512 * LDT;
constexpr int GEMM_SROW_OFF = 2 * GEMM_STAGE * 2;
constexpr int SMEM_BYTES = 256 * 132 * 4 + 256 * 16 * 4;

#define MFMA32(a, b, c) __builtin_amdgcn_mfma_f32_32x32x16_bf16((a), (b), (c), 0, 0, 0)

constexpr size_t al256(size_t x) { return (x + 255) & ~(size_t)255; }
constexpr size_t OFF_wt_in = 0;
constexpr size_t OFF_wt_o = OFF_wt_in + al256((size_t)2 * HLD * 2048 * 2);
constexpr size_t OFF_wt_pq = OFF_wt_o + al256((size_t)2 * 2048 * 2048 * 2);
constexpr size_t OFF_wt_uq = OFF_wt_pq + al256((size_t)2 * 1024 * 2048 * 2);
constexpr size_t OFF_wt_ukv = OFF_wt_uq + al256((size_t)2 * 768 * 512 * 2);
constexpr size_t OFF_keys_b = OFF_wt_ukv + al256((size_t)2 * 1024 * 256 * 2);
constexpr size_t OFF_ub = OFF_keys_b + al256((size_t)2 * 256 * 128 * 2);
constexpr size_t OFF_vb = OFF_ub + al256((size_t)2 * NEXP * 1024);
constexpr size_t OFF_ropeC = OFF_vb + al256((size_t)2 * NEXP * 1024);
constexpr size_t OFF_ropeS = OFF_ropeC + al256((size_t)SEQ * 32 * 4);
constexpr size_t OFF_xres = OFF_ropeS + al256((size_t)SEQ * 32 * 4);
constexpr size_t OFF_xb = OFF_xres + al256((size_t)T * 2048 * 4);
constexpr size_t OFF_h = OFF_xb + al256((size_t)T * 2048 * 2);
constexpr size_t OFF_vtA = OFF_h + al256((size_t)T * HLD * 2);
constexpr size_t OFF_vtB = OFF_vtA + al256((size_t)T * 256 * 2);
constexpr size_t OFF_kmla = OFF_vtB + al256((size_t)T * 512 * 2);
constexpr size_t OFF_vtC = OFF_kmla + al256((size_t)T * 4 * 192 * 2);
constexpr size_t OFF_qmla = OFF_vtC + al256((size_t)T * 512 * 2);
constexpr size_t OFF_o = OFF_qmla + al256((size_t)T * 4 * 192 * 2);
constexpr size_t OFF_on = OFF_o + al256((size_t)T * 2048 * 2);
constexpr size_t OFF_ssqh = OFF_on + al256((size_t)T * 2048 * 2);
constexpr size_t OFF_END1 = OFF_ssqh + al256((size_t)T * 16 * 4);
constexpr size_t OFF_pq = OFF_h;
constexpr size_t OFF_scores = OFF_pq + al256((size_t)T * 1024 * 2);
constexpr size_t OFF_idx = OFF_scores + al256((size_t)T * 8 * 256 * 4);
constexpr size_t OFF_g = OFF_idx + al256((size_t)T * 128 * 4);
constexpr size_t OFF_END2 = OFF_g + al256((size_t)T * 128 * 4);
constexpr size_t WS_NEED = OFF_END1 > OFF_END2 ? OFF_END1 : OFF_END2;

struct Params {
  const float *x, *ln1, *w_in, *a_sink, *b_rel, *cqn, *ckvn, *wuq, *wukv, *onorm, *wo, *ln2, *pwq, *pkeys, *pu, *pv, *fnorm;
  float* out;
  char* ws;
  DI u16* wt_in() const { return (u16*)(ws + OFF_wt_in); }
  DI u16* wt_o() const { return (u16*)(ws + OFF_wt_o); }
  DI u16* wt_pq() const { return (u16*)(ws + OFF_wt_pq); }
  DI u16* wt_uq() const { return (u16*)(ws + OFF_wt_uq); }
  DI u16* wt_ukv() const { return (u16*)(ws + OFF_wt_ukv); }
  DI u16* keys_b() const { return (u16*)(ws + OFF_keys_b); }
  DI unsigned char* ub() const { return (unsigned char*)(ws + OFF_ub); }
  DI unsigned char* vb() const { return (unsigned char*)(ws + OFF_vb); }
  DI float* ropeC() const { return (float*)(ws + OFF_ropeC); }
  DI float* ropeS() const { return (float*)(ws + OFF_ropeS); }
  DI float* xres() const { return (float*)(ws + OFF_xres); }
  DI u16* xb() const { return (u16*)(ws + OFF_xb); }
  DI u16* h() const { return (u16*)(ws + OFF_h); }
  DI u16* vtA() const { return (u16*)(ws + OFF_vtA); }
  DI u16* vtB() const { return (u16*)(ws + OFF_vtB); }
  DI u16* kmla() const { return (u16*)(ws + OFF_kmla); }
  DI u16* vtC() const { return (u16*)(ws + OFF_vtC); }
  DI u16* qmla() const { return (u16*)(ws + OFF_qmla); }
  DI u16* o() const { return (u16*)(ws + OFF_o); }
  DI u16* on() const { return (u16*)(ws + OFF_on); }
  DI float* ssqh() const { return (float*)(ws + OFF_ssqh); }
  DI u16* pq() const { return (u16*)(ws + OFF_pq); }
  DI float* scores() const { return (float*)(ws + OFF_scores); }
  DI int* idx() const { return (int*)(ws + OFF_idx); }
  DI float* g() const { return (float*)(ws + OFF_g); }
};

DI int otid() { int t = threadIdx.x; asm volatile("" : "+v"(t)); return t; }
DI int obid() { int b = blockIdx.x; asm volatile("" : "+s"(b)); return b; }
DI u16 f2bf(float x) {
  u32 u = __float_as_uint(x);
  u += 0x7fffu + ((u >> 16) & 1u);
  return (u16)(u >> 16);
}
DI u32 pack2bf(float a, float b) {
  float2_t f = {a, b};
  bf16x2_t r = __builtin_convertvector(f, bf16x2_t);
  return __builtin_bit_cast(u32, r);
}
DI float bf_lo(u32 w) { return __uint_as_float(w << 16); }
DI float bf_hi(u32 w) { return __uint_as_float(w & 0xffff0000u); }
DI int crow(int r, int h) { return (r & 3) + 8 * (r >> 2) + 4 * h; }
DI float wave_sum(float v) {
#pragma unroll
  for (int o = 32; o >= 1; o >>= 1) v += __shfl_xor(v, o);
  return v;
}
DI float ssq8(u32x4 w) {
  float s = 0.f, a;
  a = bf_lo(w.x); s += a * a; a = bf_hi(w.x); s += a * a;
  a = bf_lo(w.y); s += a * a; a = bf_hi(w.y); s += a * a;
  a = bf_lo(w.z); s += a * a; a = bf_hi(w.z); s += a * a;
  a = bf_lo(w.w); s += a * a; a = bf_hi(w.w); s += a * a;
  return s;
}
DI bool gemm_tile_map(int it, int MT, int NT, int& mt, int& nt) {
  const int b = obid(), x = b & 7, nb = gridDim.x >> 3;
  const int li = it * nb + (b >> 3);
  const int nrn = (NT + 7) >> 3, nrect = (MT >> 3) * nrn;
  const int q = x + 8 * (li >> 6);
  if (q >= nrect) { mt = -1; nt = 0; return false; }
  const int in = li & 63;
  mt = (q / nrn) * 8 + (in >> 3);
  nt = (q % nrn) * 8 + (in & 7);
  return nt < NT;
}

constexpr int GM = 256, GN = 256;
DI u32x4 scale8(u32x4 w, float sc) {
  w.x = pack2bf(bf_lo(w.x) * sc, bf_hi(w.x) * sc);
  w.y = pack2bf(bf_lo(w.y) * sc, bf_hi(w.y) * sc);
  w.z = pack2bf(bf_lo(w.z) * sc, bf_hi(w.z) * sc);
  w.w = pack2bf(bf_lo(w.w) * sc, bf_hi(w.w) * sc);
  return w;
}
template <bool ROWNORM, bool CONV = false, bool ASCALE = false>
DI void gemm_mainloop(const u16* __restrict__ Ag, int lda, const u16* __restrict__ Bg, int ldb, int K, char* smem,
                      f32x16 (&acc)[4][2], const float4* __restrict__ csrc = nullptr, u16* __restrict__ cdst = nullptr,
                      float cscale = 1.f) {
  u16* sbase = (u16*)smem;
  float* sRow = (float*)(smem + GEMM_SROW_OFF);
  const int tid = otid(), lane = tid & 63, wid = tid >> 6;
  const int wm = wid >> 2, wn = wid & 3, hh = lane >> 5, l31 = lane & 31;
  const int lr = tid >> 3, lc = (tid & 7) * 8;
#pragma unroll
  for (int i = 0; i < 4; ++i)
#pragma unroll
    for (int j = 0; j < 2; ++j)
#pragma unroll
      for (int r = 0; r < 16; ++r) acc[i][j][r] = 0.f;
  u32x4 ra[4], rb[4];
  float ssq[4] = {0.f, 0.f, 0.f, 0.f};
  const u16* ap = Ag + (size_t)lr * lda + lc;
  const u16* bp = Bg + (size_t)lr * ldb + lc;
#pragma unroll
  for (int i = 0; i < 4; ++i) {
    ra[i] = *(const u32x4*)(ap + (size_t)(64 * i) * lda);
    rb[i] = *(const u32x4*)(bp + (size_t)(64 * i) * ldb);
  }
  __syncthreads();
#pragma unroll
  for (int i = 0; i < 4; ++i) {
    if (ASCALE) ra[i] = scale8(ra[i], sRow[(lr + 64 * i) * 4 + 0]);
    *(u32x4*)(sbase + (lr + 64 * i) * LDT + lc) = ra[i];
    *(u32x4*)(sbase + (256 + lr + 64 * i) * LDT + lc) = rb[i];
    if (ROWNORM) ssq[i] += ssq8(ra[i]);
  }
  __syncthreads();
  const int nk = K >> 6;
#pragma unroll 1
  for (int kt = 0; kt < nk; ++kt) {
    const int cur = kt & 1;
    const bool more = (kt + 1 < nk);
    const int kn = more ? kt + 1 : kt;
    float4 cv;
    if (CONV) cv = csrc[(size_t)kt * NTHR + tid];
#pragma unroll
    for (int i = 0; i < 4; ++i) {
      ra[i] = *(const u32x4*)(ap + (size_t)(64 * i) * lda + kn * 64);
      rb[i] = *(const u32x4*)(bp + (size_t)(64 * i) * ldb + kn * 64);
    }
    const u16* a_s = sbase + cur * GEMM_STAGE + (wm * 128 + l31) * LDT + hh * 8;
    const u16* b_s = sbase + cur * GEMM_STAGE + (256 + wn * 64 + l31) * LDT + hh * 8;
#pragma unroll
    for (int ks = 0; ks < 4; ++ks) {
      const bf16x8 b0 = *(const bf16x8*)(b_s + ks * 16);
      const bf16x8 b1 = *(const bf16x8*)(b_s + 32 * LDT + ks * 16);
      bf16x8 a0[4];
#pragma unroll
      for (int i = 0; i < 4; ++i) a0[i] = *(const bf16x8*)(a_s + i * 32 * LDT + ks * 16);
      __builtin_amdgcn_s_setprio(1);
#pragma unroll
      for (int i = 0; i < 4; ++i) {
        acc[i][0] = MFMA32(a0[i], b0, acc[i][0]);
        acc[i][1] = MFMA32(a0[i], b1, acc[i][1]);
      }
      __builtin_amdgcn_s_setprio(0);
    }
    {
      u16* w = sbase + (cur ^ 1) * GEMM_STAGE;
      const int g = (kn < 16) ? 0 : (kn < 24 ? 1 : 2);
#pragma unroll
      for (int i = 0; i < 4; ++i) {
        if (ASCALE) ra[i] = scale8(ra[i], sRow[(lr + 64 * i) * 4 + g]);
        *(u32x4*)(w + (lr + 64 * i) * LDT + lc) = ra[i];
        *(u32x4*)(w + (256 + lr + 64 * i) * LDT + lc) = rb[i];
        if (ROWNORM) ssq[i] += more ? ssq8(ra[i]) : 0.f;
      }
    }
    if (CONV) {
      u32 w4 = 0;
      w4 = __builtin_amdgcn_cvt_scalef32_pk_fp4_f32(w4, cv.x * cscale, cv.y * cscale, 1.0f, 0);
      w4 = __builtin_amdgcn_cvt_scalef32_pk_fp4_f32(w4, cv.z * cscale, cv.w * cscale, 1.0f, 1);
      cdst[(size_t)kt * NTHR + tid] = (u16)w4;
    }
    __syncthreads();
  }
  if (ROWNORM) {
#pragma unroll
    for (int i = 0; i < 4; ++i) {
      float s = ssq[i];
      s += __shfl_xor(s, 1);
      s += __shfl_xor(s, 2);
      s += __shfl_xor(s, 4);
      if ((tid & 7) == 0) sRow[lr + 64 * i] = rsqrtf(s / (float)K + EPS);
    }
    __syncthreads();
  }
}

DI void conv_transpose_all(const Params& p, char* smem) {
  const int lane = otid() & 63, wid = otid() >> 6;
  float* s = (float*)smem + wid * (64 * 65);
  constexpr int T0 = 32 * 61, T1 = T0 + 32 * 32, T2 = T1 + 32 * 16, T3 = T2 + 8 * 12, T4 = T3 + 4 * 16;
  for (int f = obid() * NWAVE + wid; f < 2 * T4; f += gridDim.x * NWAVE) {
    const int L = f / T4, r = f % T4;
    const float* W; const float* g; u16* Wt; int K, N, tile;
    if (r < T0)      { W = p.w_in + (size_t)L * 2048 * 3904; g = p.ln1 + L * 2048;   Wt = p.wt_in() + (size_t)L * HLD * 2048;   K = 2048; N = 3904; tile = r; }
    else if (r < T1) { W = p.wo + (size_t)L * 2048 * 2048;   g = p.onorm + L * 2048; Wt = p.wt_o() + (size_t)L * 2048 * 2048;   K = 2048; N = 2048; tile = r - T0; }
    else if (r < T2) { W = p.pwq + (size_t)L * 2048 * 1024;  g = p.ln2 + L * 2048;   Wt = p.wt_pq() + (size_t)L * 1024 * 2048;  K = 2048; N = 1024; tile = r - T1; }
    else if (r < T3) { W = p.wuq + (size_t)L * 512 * 768;    g = p.cqn + L * 512;    Wt = p.wt_uq() + (size_t)L * 768 * 512;    K = 512;  N = 768;  tile = r - T2; }
    else             { W = p.wukv + (size_t)L * 256 * 1024;  g = p.ckvn + L * 256;   Wt = p.wt_ukv() + (size_t)L * 1024 * 256;  K = 256;  N = 1024; tile = r - T3; }
    const int ntn = N / 64;
    const int k0 = (tile / ntn) * 64, n0 = (tile % ntn) * 64;
#pragma unroll 8
    for (int kk = 0; kk < 64; ++kk) s[kk * 65 + lane] = W[(size_t)(k0 + kk) * N + n0 + lane] * g[k0 + kk];
    __builtin_amdgcn_fence(__ATOMIC_RELEASE, "wavefront");
    __builtin_amdgcn_wave_barrier();
    __builtin_amdgcn_fence(__ATOMIC_ACQUIRE, "wavefront");
#pragma unroll 8
    for (int nn = 0; nn < 64; ++nn) Wt[(size_t)(n0 + nn) * K + k0 + lane] = f2bf(s[lane * 65 + nn]);
    __builtin_amdgcn_fence(__ATOMIC_RELEASE, "wavefront");
    __builtin_amdgcn_wave_barrier();
    __builtin_amdgcn_fence(__ATOMIC_ACQUIRE, "wavefront");
  }
}
DI void conv_flat(const float* __restrict__ src, u16* __restrict__ dst, size_t n4) {
  for (size_t i = (size_t)obid() * NTHR + otid(); i < n4; i += (size_t)gridDim.x * NTHR) {
    float4 v = ((const float4*)src)[i];
    u32x2 w = {pack2bf(v.x, v.y), pack2bf(v.z, v.w)};
    ((u32x2*)dst)[i] = w;
  }
}
DI void conv_fp4(const float* __restrict__ src, unsigned char* __restrict__ dst, size_t n8, float sc) {
  for (size_t i = (size_t)obid() * NTHR + otid(); i < n8; i += (size_t)gridDim.x * NTHR) {
    const float4 a = ((const float4*)src)[i * 2 + 0], b = ((const float4*)src)[i * 2 + 1];
    u32 w = 0;
    w = __builtin_amdgcn_cvt_scalef32_pk_fp4_f32(w, a.x * sc, a.y * sc, 1.0f, 0);
    w = __builtin_amdgcn_cvt_scalef32_pk_fp4_f32(w, a.z * sc, a.w * sc, 1.0f, 1);
    w = __builtin_amdgcn_cvt_scalef32_pk_fp4_f32(w, b.x * sc, b.y * sc, 1.0f, 2);
    w = __builtin_amdgcn_cvt_scalef32_pk_fp4_f32(w, b.z * sc, b.w * sc, 1.0f, 3);
    ((u32*)dst)[i] = w;
  }
}
DI void phase_prologue(const Params& p, char* smem) {
  __syncthreads();
  conv_transpose_all(p, smem);
  for (int L = 0; L < 2; ++L) {
    u16* pad = p.wt_in() + (size_t)L * HLD * 2048 + (size_t)3904 * 2048;
    for (int i = obid() * NTHR + otid(); i < 192 * 2048 / 8; i += gridDim.x * NTHR) ((u32x4*)pad)[i] = u32x4{0, 0, 0, 0};
  }
  for (int i = obid() * NTHR + otid(); i < 2 * 256 * 128; i += gridDim.x * NTHR) {
    const int L = i >> 15, n = (i >> 7) & 255, k = i & 127;
    const int c = n >> 7, kin = k - 64 * c;
    const float v = (kin >= 0 && kin < 64) ? p.pkeys[((size_t)(L * 2 + c) * 128 + (n & 127)) * 64 + kin] : 0.f;
    p.keys_b()[i] = f2bf(v);
  }
  conv_flat(p.x, p.xb(), (size_t)T * 2048 / 4);
  for (int i = obid() * NTHR + otid(); i < SEQ * 32; i += gridDim.x * NTHR) {
    const int pos = i >> 5, f = i & 31;
    const float inv = powf(10000.0f, -(float)f / 32.0f);
    const float ang = (float)pos * inv;
    p.ropeC()[i] = cosf(ang);
    p.ropeS()[i] = sinf(ang);
  }
}

#define EPI_IDS                                                                                     \
  const int etid = otid();                                                                          \
  const int lane = etid & 63, wid = etid >> 6, wm = wid >> 2, wn = wid & 3, hh = lane >> 5, l31 = lane & 31;

DI void phase_gemm1(const Params& p, int L, char* smem) {
  const u16* Wt = p.wt_in() + (size_t)L * HLD * 2048;
  const float* sRow = (const float*)(smem + GEMM_SROW_OFF);
  for (int it = 0;; ++it) {
    int mt, nt;
    if (!gemm_tile_map(it, 64, 16, mt, nt)) { if (mt < 0) break; continue; }
    f32x16 acc[4][2];
    const int tile_id = mt * 16 + nt;
    const bool isv = tile_id >= 512;
    const float4* csrc = (const float4*)((isv ? p.pv : p.pu) + (size_t)L * NEXP * 2048) + (size_t)(tile_id & 511) * 32 * NTHR;
    u16* cdst = (u16*)((isv ? p.vb() : p.ub()) + (size_t)L * NEXP * 1024) + (size_t)(tile_id & 511) * 32 * NTHR;
    gemm_mainloop<true, true>(p.xb() + (size_t)mt * GM * 2048, 2048, Wt + (size_t)nt * GN * 2048, 2048, 2048, smem, acc, csrc, cdst,
                              isv ? V_SCALE : U_SCALE);
    EPI_IDS
    const int nt128 = nt * 2 + (wn >> 1), wn1 = wn & 1;
    const int m0 = mt * GM, b = m0 >> 12, s0 = m0 & 4095;
    if (nt128 >= 30) {
      if (nt128 == 30 && wn1 == 0) {
#pragma unroll
        for (int i = 0; i < 4; ++i)
#pragma unroll
          for (int r = 0; r < 16; ++r) {
            const int rl = wm * 128 + i * 32 + crow(r, hh);
            const float rs = sRow[rl];
            const float x1 = acc[i][0][r] * rs, x2 = acc[i][1][r] * rs;
            const int pos = s0 + rl;
            const float c = p.ropeC()[pos * 32 + l31], sn = p.ropeS()[pos * 32 + l31];
            const u16 o1 = f2bf(x1 * c - x2 * sn), o2 = f2bf(x1 * sn + x2 * c);
#pragma unroll
            for (int hd = 0; hd < 4; ++hd) {
              u16* kr = p.kmla() + ((size_t)(b * 4 + hd) * 4096 + pos) * 192 + 128;
              kr[l31] = o1;
              kr[32 + l31] = o2;
            }
            if ((r & 3) == 3) __builtin_amdgcn_sched_barrier(0);
          }
      }
    } else if (nt128 == 10 || nt128 == 11 || (nt128 >= 20 && nt128 < 24)) {
      u16* vt;
      int nh, hd;
      if (nt128 < 12) { vt = p.vtA(); nh = 2; hd = nt128 - 10; } else { vt = p.vtB(); nh = 4; hd = nt128 - 20; }
#pragma unroll
      for (int i = 0; i < 4; ++i)
#pragma unroll
        for (int j = 0; j < 2; ++j)
#pragma unroll
          for (int g4 = 0; g4 < 4; ++g4) {
            const int rl0 = wm * 128 + i * 32 + 8 * g4 + 4 * hh;
            const int d = wn1 * 64 + j * 32 + l31;
            const float v0 = acc[i][j][4 * g4 + 0] * sRow[rl0 + 0], v1 = acc[i][j][4 * g4 + 1] * sRow[rl0 + 1];
            const float v2 = acc[i][j][4 * g4 + 2] * sRow[rl0 + 2], v3 = acc[i][j][4 * g4 + 3] * sRow[rl0 + 3];
            u32x2 w = {pack2bf(v0, v1), pack2bf(v2, v3)};
            *(u32x2*)(vt + ((size_t)(b * nh + hd) * 128 + d) * 4096 + s0 + rl0) = w;
          }
    } else {
      const float sc = (nt128 < 8 || (nt128 >= 12 && nt128 < 16)) ? QSCALE_AB : 1.f;
#pragma unroll
      for (int i = 0; i < 4; ++i)
#pragma unroll
        for (int j = 0; j < 2; ++j)
#pragma unroll
          for (int r = 0; r < 16; ++r) {
            const int rl = wm * 128 + i * 32 + crow(r, hh);
            p.h()[(size_t)(m0 + rl) * HLD + nt128 * 128 + wn1 * 64 + j * 32 + l31] = f2bf(acc[i][j][r] * sRow[rl] * sc);
          }
    }
  }
}

DI void tile_upq(const Params& p, int L, int tile, char* smem) {
  const float* sRow = (const float*)(smem + GEMM_SROW_OFF);
  const int mt = tile / 3, nt = tile % 3;
  f32x16 acc[4][2];
  gemm_mainloop<true>(p.h() + (size_t)mt * GM * HLD + 3072, HLD, p.wt_uq() + (size_t)L * 768 * 512 + (size_t)nt * GN * 512, 512, 512,
                      smem, acc);
  EPI_IDS
  const int m0 = mt * GM, b = m0 >> 12, s0 = m0 & 4095;
  const int nb64 = nt * 4 + wn;
  const int head = nb64 / 3, part = nb64 % 3;
#pragma unroll
  for (int i = 0; i < 4; ++i)
#pragma unroll
    for (int j = 0; j < 2; ++j)
#pragma unroll
      for (int r = 0; r < 16; ++r) {
        const int rl = wm * 128 + i * 32 + crow(r, hh);
        const int pos = s0 + rl;
        p.qmla()[((size_t)(b * 4 + head) * 4096 + pos) * 192 + part * 64 + j * 32 + l31] = f2bf(acc[i][j][r] * sRow[rl] * QSCALE_C);
      }
}

DI void tile_upkv(const Params& p, int L, int tile, char* smem) {
  const float* sRow = (const float*)(smem + GEMM_SROW_OFF);
  const int mt = tile >> 2, nt = tile & 3;
  f32x16 acc[4][2];
  gemm_mainloop<true>(p.h() + (size_t)mt * GM * HLD + 3584, HLD, p.wt_ukv() + (size_t)L * 1024 * 256 + (size_t)nt * GN * 256, 256, 256,
                      smem, acc);
  EPI_IDS
  const int nt128 = nt * 2 + (wn >> 1), wn1 = wn & 1;
  const int m0 = mt * GM, b = m0 >> 12, s0 = m0 & 4095;
  const int head = nt128 >> 1;
  if (nt128 & 1) {
#pragma unroll
    for (int i = 0; i < 4; ++i)
#pragma unroll
      for (int j = 0; j < 2; ++j)
#pragma unroll
        for (int g4 = 0; g4 < 4; ++g4) {
          const int rl0 = wm * 128 + i * 32 + 8 * g4 + 4 * hh;
          const int d = wn1 * 64 + j * 32 + l31;
          const float v0 = acc[i][j][4 * g4 + 0] * sRow[rl0 + 0], v1 = acc[i][j][4 * g4 + 1] * sRow[rl0 + 1];
          const float v2 = acc[i][j][4 * g4 + 2] * sRow[rl0 + 2], v3 = acc[i][j][4 * g4 + 3] * sRow[rl0 + 3];
          u32x2 w = {pack2bf(v0, v1), pack2bf(v2, v3)};
          *(u32x2*)(p.vtC() + ((size_t)(b * 4 + head) * 128 + d) * 4096 + s0 + rl0) = w;
        }
  } else {
#pragma unroll
    for (int i = 0; i < 4; ++i)
#pragma unroll
      for (int j = 0; j < 2; ++j)
#pragma unroll
        for (int r = 0; r < 16; ++r) {
          const int rl = wm * 128 + i * 32 + crow(r, hh);
          const int pos = s0 + rl;
          p.kmla()[((size_t)(b * 4 + head) * 4096 + pos) * 192 + wn1 * 64 + j * 32 + l31] = f2bf(acc[i][j][r] * sRow[rl]);
        }
  }
}

DI void phase_gemm_o(const Params& p, int L, char* smem) {
  const u16* Wt = p.wt_o() + (size_t)L * 2048 * 2048;
  const float* xin = p.x;
  for (int it = 0;; ++it) {
    int mt, nt;
    if (!gemm_tile_map(it, 64, 8, mt, nt)) { if (mt < 0) break; continue; }
    f32x16 acc[4][2];
    {
      float* sRow = (float*)(smem + GEMM_SROW_OFF);
      const int t = otid();
      __syncthreads();
      if (t < 256) {
        const float4* sp = (const float4*)(p.ssqh() + (size_t)(mt * GM + t) * 16);
        const float4 a0 = sp[0], a1 = sp[1], b0 = sp[2], c0 = sp[3];
        sRow[t * 4 + 0] = rsqrtf((a0.x + a0.y + a0.z + a0.w + a1.x + a1.y + a1.z + a1.w) * (1.f / 1024.f) + EPS);
        sRow[t * 4 + 1] = rsqrtf((b0.x + b0.y + b0.z + b0.w) * (1.f / 512.f) + EPS);
        sRow[t * 4 + 2] = rsqrtf((c0.x + c0.y + c0.z + c0.w) * (1.f / 512.f) + EPS);
      }
    }
    gemm_mainloop<false, false, true>(p.o() + (size_t)mt * GM * 2048, 2048, Wt + (size_t)nt * GN * 2048, 2048, 2048, smem, acc);
    EPI_IDS
#pragma unroll
    for (int i = 0; i < 4; ++i)
#pragma unroll
      for (int j = 0; j < 2; ++j)
#pragma unroll
        for (int r = 0; r < 16; ++r) {
          const size_t off = (size_t)(mt * GM + wm * 128 + i * 32 + crow(r, hh)) * 2048 + nt * GN + wn * 64 + j * 32 + l31;
          const float xv = (L == 0) ? xin[off] : __uint_as_float(((u32)p.xb()[off]) << 16);
          p.xb()[off] = f2bf(xv + acc[i][j][r]);
        }
  }
}

DI void phase_gemm_pq(const Params& p, int L, char* smem) {
  const u16* Wt = p.wt_pq() + (size_t)L * 1024 * 2048;
  const float* sRow = (const float*)(smem + GEMM_SROW_OFF);
  for (int tile = obid(); tile < 64 * 4; tile += gridDim.x) {
    const int mt = tile >> 2, nt = tile & 3;
    f32x16 acc[4][2];
    gemm_mainloop<true>(p.xb() + (size_t)mt * GM * 2048, 2048, Wt + (size_t)nt * GN * 2048, 2048, 2048, smem, acc);
    EPI_IDS
#pragma unroll
    for (int i = 0; i < 4; ++i)
#pragma unroll
      for (int j = 0; j < 2; ++j)
#pragma unroll
        for (int r = 0; r < 16; ++r) {
          const int rl = wm * 128 + i * 32 + crow(r, hh);
          p.pq()[(size_t)(mt * GM + rl) * 1024 + nt * GN + wn * 64 + j * 32 + l31] = f2bf(acc[i][j][r] * sRow[rl]);
        }
  }
}

DI void phase_gemm_scores(const Params& p, int L, char* smem) {
  for (int mt = obid(); mt < 512; mt += gridDim.x) {
    f32x16 acc[4][2];
    gemm_mainloop<false>(p.pq() + (size_t)mt * GM * 128, 128, p.keys_b() + (size_t)L * 256 * 128, 128, 128, smem, acc);
    EPI_IDS
#pragma unroll
    for (int i = 0; i < 4; ++i)
#pragma unroll
      for (int j = 0; j < 2; ++j)
#pragma unroll
        for (int r = 0; r < 16; ++r) {
          const int rl = wm * 128 + i * 32 + crow(r, hh);
          p.scores()[(size_t)(mt * GM + rl) * 256 + wn * 64 + j * 32 + l31] = acc[i][j][r];
        }
  }
}

template <int DQK, int MODE>
DI void attn_block(char* smem, const u16* __restrict__ Q, int ldq, const u16* __restrict__ Kb, int ldk,
                   const u16* __restrict__ Vt, int t0, int t1, int qpos0, float slope2, float sink2,
                   const float* __restrict__ biasTbl, u16* __restrict__ Oout, float* __restrict__ ssq_out,
                   const float* __restrict__ ropeCS = nullptr) {
  constexpr int LDK = DQK + 8;
  constexpr int NCH = DQK / 8;
  constexpr int KCH = NCH / 8;
  constexpr int NKS = DQK / 16;
  constexpr int STG = 64 * LDK + 128 * 68;
  u16* sbase = (u16*)smem;
  float* sBias = (float*)(sbase + 2 * STG);
  const int tid = otid(), lane = tid & 63, wid = tid >> 6, hh = lane >> 5, l31 = lane & 31;

  __syncthreads();
  if (MODE == 1) {
    for (int i = tid; i < 465; i += NTHR) sBias[i] = biasTbl[i] * LOG2E;
  }
  bf16x8 qf[NKS];
  {
    const u16* qrow = Q + (size_t)(wid * 32 + l31) * ldq + hh * 8;
#pragma unroll
    for (int ks = 0; ks < NKS; ++ks) qf[ks] = *(const bf16x8*)(qrow + ks * 16);
  }
  if (MODE == 2) {
    const int pos = qpos0 + wid * 32 + l31;
#pragma unroll
    for (int k2 = 0; k2 < 2; ++k2) {
      const float* cp = ropeCS + (size_t)pos * 32 + k2 * 16 + 8 * hh;
      const float* sp = ropeCS + (size_t)SEQ * 32 + (size_t)pos * 32 + k2 * 16 + 8 * hh;
#pragma unroll
      for (int j = 0; j < 8; ++j) {
        const float c = cp[j], sn = sp[j];
        const float x1 = __uint_as_float(((u32)(u16)qf[NKS - 4 + k2][j]) << 16);
        const float x2 = __uint_as_float(((u32)(u16)qf[NKS - 2 + k2][j]) << 16);
        qf[NKS - 4 + k2][j] = (short)f2bf(x1 * c - x2 * sn);
        qf[NKS - 2 + k2][j] = (short)f2bf(x1 * sn + x2 * c);
      }
    }
  }
  constexpr float SM_THR = 6.f;
  float m_run = (MODE == 0) ? sink2 : 0.f;
  float l_run = (MODE == 0 && hh == 0) ? 1.f : 0.f;
  bool first = true;
  f32x16 oacc[4];
#pragma unroll
  for (int d = 0; d < 4; ++d)
#pragma unroll
    for (int r = 0; r < 16; ++r) oacc[d][r] = 0.f;

  const int widu = __builtin_amdgcn_readfirstlane(wid);
  const int qw0 = qpos0 + widu * 32;
  const int qpos = qw0 + l31;
  const int rq = (qpos0 >> 6) + (widu >> 1);
  const int rsq = min(max(rq - 4, 0), 56);
  const int cq = (wid & 1) * 32 + l31;
  const int cs = min(max(cq - 8, 0), 48);

  u32x4 rk[KCH], rv[2];
#define ATTN_LOAD_TILE(TT)                                                              \
  {                                                                                     \
    _Pragma("unroll") for (int i = 0; i < KCH; ++i) {                                   \
      const int c = tid + NTHR * i;                                                     \
      const int rr = c / NCH, cc = c % NCH;                                             \
      rk[i] = *(const u32x4*)(Kb + (size_t)((TT) * 64 + rr) * ldk + cc * 8);            \
    }                                                                                   \
    _Pragma("unroll") for (int i = 0; i < 2; ++i) {                                     \
      const int c = tid + NTHR * i;                                                     \
      const int d = c >> 3, part = c & 7;                                               \
      rv[i] = *(const u32x4*)(Vt + (size_t)d * 4096 + (TT) * 64 + part * 8);            \
    }                                                                                   \
  }
#define ATTN_STORE_TILE(STAGE)                                                          \
  {                                                                                     \
    u16* sKw = sbase + (STAGE) * STG;                                                   \
    u16* sVw = sKw + 64 * LDK;                                                          \
    _Pragma("unroll") for (int i = 0; i < KCH; ++i) {                                   \
      const int c = tid + NTHR * i;                                                     \
      const int rr = c / NCH, cc = c % NCH;                                             \
      *(u32x4*)(sKw + rr * LDK + cc * 8) = rk[i];                                       \
    }                                                                                   \
    _Pragma("unroll") for (int i = 0; i < 2; ++i) {                                     \
      const int c = tid + NTHR * i;                                                     \
      const int d = c >> 3, part = c & 7;                                               \
      *(u32x2*)(sVw + d * 68 + part * 8) = u32x2{rv[i].x, rv[i].y};                     \
      *(u32x2*)(sVw + d * 68 + part * 8 + 4) = u32x2{rv[i].z, rv[i].w};                 \
    }                                                                                   \
  }
  ATTN_LOAD_TILE(t0)
  ATTN_STORE_TILE(0)
  __syncthreads();
#pragma unroll 1
  for (int t = t0; t < t1; ++t) {
    const int cur = (t - t0) & 1;
    {
      const int tn = (t + 1 < t1) ? t + 1 : t;
      ATTN_LOAD_TILE(tn)
    }
    const u16* sK = sbase + cur * STG;
    const u16* sV = sK + 64 * LDK;
    bool relevant = true;
    if (MODE == 0) relevant = (t * 64 <= qw0 + 31 + 128) && (t * 64 + 63 >= qw0 - 128);
    if (MODE == 1) relevant = (t >= rsq) && (t < rsq + 8);
    if (relevant) {
      f32x16 sacc[2];
#pragma unroll
      for (int tt = 0; tt < 2; ++tt) {
#pragma unroll
        for (int r = 0; r < 16; ++r) sacc[tt][r] = -m_run;
        const u16* kp = sK + (tt * 32 + l31) * LDK + hh * 8;
#pragma unroll
        for (int ks = 0; ks < NKS; ++ks) {
          bf16x8 kf = *(const bf16x8*)(kp + ks * 16);
          sacc[tt] = MFMA32(kf, qf[ks], sacc[tt]);
        }
      }
      float mx = -INFINITY;
      const int drow = min(max(t - rq + 7, 0), 14) * 31;
#pragma unroll
      for (int tt = 0; tt < 2; ++tt)
#pragma unroll
        for (int r = 0; r < 16; ++r) {
          float sv = sacc[tt][r];
          const int kl = tt * 32 + crow(r, hh);
          if (MODE == 0) {
            const int kpos = t * 64 + kl;
            int dist = qpos - kpos;
            dist = dist < 0 ? -dist : dist;
            sv = (dist <= 128) ? (sv - slope2 * (float)dist) : -INFINITY;
          } else if (MODE == 1) {
            const bool ok = ((unsigned)(kl - cs) < 16u);
            const int dc = min(max(kl - cq + 15, 0), 30);
            sv = ok ? (sv + sBias[drow + dc]) : -INFINITY;
          }
          sacc[tt][r] = sv;
          mx = fmaxf(mx, sv);
        }
      mx = fmaxf(mx, __shfl_xor(mx, 32));
      if (__builtin_amdgcn_ballot_w64(first || (mx > SM_THR)) != 0ull) {
        float delta = fmaxf(mx, 0.f);
        if (first && MODE != 0) delta = (mx > -INFINITY) ? mx : 0.f;
        m_run += delta;
        const float alpha = __builtin_amdgcn_exp2f(-delta);
        l_run *= alpha;
#pragma unroll
        for (int d = 0; d < 4; ++d)
#pragma unroll
          for (int r = 0; r < 16; ++r) oacc[d][r] *= alpha;
#pragma unroll
        for (int tt = 0; tt < 2; ++tt)
#pragma unroll
          for (int r = 0; r < 16; ++r) sacc[tt][r] -= delta;
        first = false;
      }
      float ps = 0.f;
#pragma unroll
      for (int tt = 0; tt < 2; ++tt) {
#pragma unroll
        for (int r = 0; r < 16; ++r) {
          const float pv = __builtin_amdgcn_exp2f(sacc[tt][r]);
          sacc[tt][r] = pv;
          ps += pv;
        }
#pragma unroll
        for (int s2 = 0; s2 < 2; ++s2) {
          u32x4 w;
          w.x = pack2bf(sacc[tt][8 * s2 + 0], sacc[tt][8 * s2 + 1]);
          w.y = pack2bf(sacc[tt][8 * s2 + 2], sacc[tt][8 * s2 + 3]);
          w.z = pack2bf(sacc[tt][8 * s2 + 4], sacc[tt][8 * s2 + 5]);
          w.w = pack2bf(sacc[tt][8 * s2 + 6], sacc[tt][8 * s2 + 7]);
          const bf16x8 pf = __builtin_bit_cast(bf16x8, w);
#pragma unroll
          for (int dt = 0; dt < 4; ++dt) {
            const u16* vp = sV + (dt * 32 + l31) * 68 + 4 * hh;
            const u32x2 lo = *(const u32x2*)(vp + tt * 32 + s2 * 16);
            const u32x2 hi = *(const u32x2*)(vp + tt * 32 + s2 * 16 + 8);
            u32x4 wv = {lo.x, lo.y, hi.x, hi.y};
            oacc[dt] = MFMA32(__builtin_bit_cast(bf16x8, wv), pf, oacc[dt]);
          }
        }
      }
      l_run += ps;
    }
    ATTN_STORE_TILE(cur ^ 1)
    __syncthreads();
  }
  const float lt = l_run + __shfl_xor(l_run, 32);
  const float inv = 1.f / lt;
  float sq = 0.f;
  u16* orow = Oout + (size_t)(wid * 32 + l31) * 2048;
#pragma unroll
  for (int dt = 0; dt < 4; ++dt)
#pragma unroll
    for (int g4 = 0; g4 < 4; ++g4) {
      const float v0 = oacc[dt][4 * g4 + 0] * inv, v1 = oacc[dt][4 * g4 + 1] * inv;
      const float v2 = oacc[dt][4 * g4 + 2] * inv, v3 = oacc[dt][4 * g4 + 3] * inv;
      sq += v0 * v0 + v1 * v1 + v2 * v2 + v3 * v3;
      u32x2 w = {pack2bf(v0, v1), pack2bf(v2, v3)};
      *(u32x2*)(orow + dt * 32 + 8 * g4 + 4 * hh) = w;
    }
  sq += __shfl_xor(sq, 32);
  if (hh == 0) ssq_out[(size_t)(wid * 32 + l31) * 16] = sq;
}

DI void phase_mix(const Params& p, int L, char* smem) {
  for (int w = obid(); w < 256; w += gridDim.x) {
    const int b = w >> 6, rem = w & 63, rg = rem >> 2, hb = rem & 3;
    const int r0 = rg * 4;
    const int t0 = min(max(r0 - 4, 0), 56), t1 = min(max(r0 - 1, 0), 56) + 8;
    const size_t tok0 = (size_t)b * 4096 + r0 * 64;
    attn_block<128, 1>(smem, p.h() + tok0 * HLD + 1536 + hb * 128, HLD, p.h() + (size_t)b * 4096 * HLD + 2048 + hb * 128, HLD,
                       p.vtB() + (size_t)(b * 4 + hb) * 128 * 4096, t0, t1, r0 * 64, 0.f, 0.f,
                       p.b_rel + (size_t)L * 4 * 465 + hb * 465, p.o() + tok0 * 2048 + 1024 + hb * 128, p.ssqh() + tok0 * 16 + 8 + hb);
  }
  for (int ww = obid(); ww < 512; ww += gridDim.x) {
    const int b = ww >> 7, rem = ww & 127, sb = rem >> 3, hq = rem & 7;
    const int t0 = max(0, 4 * sb - 2), t1 = min(64, 4 * sb + 6);
    const size_t tok0 = (size_t)b * 4096 + sb * 256;
    const float slope2 = exp2f(-(float)(hq + 1)) * LOG2E;
    const float sink2 = p.a_sink[L * 8 + hq] * LOG2E;
    attn_block<128, 0>(smem, p.h() + tok0 * HLD + hq * 128, HLD, p.h() + (size_t)b * 4096 * HLD + 1024 + (hq >> 2) * 128, HLD,
                       p.vtA() + (size_t)(b * 2 + (hq >> 2)) * 128 * 4096, t0, t1, sb * 256, slope2, sink2, nullptr,
                       p.o() + tok0 * 2048 + hq * 128, p.ssqh() + tok0 * 16 + hq);
  }
  for (int w = (obid() + 64) % gridDim.x; w < 192; w += gridDim.x) tile_upq(p, L, w, smem);
  for (int w = obid(); w < 256; w += gridDim.x) tile_upkv(p, L, w, smem);
}

DI void phase_mla(const Params& p, char* smem) {
  const int nbx = gridDim.x >> 3;
  for (int li = obid() >> 3; li < 32; li += nbx) {
    const int pair = (obid() & 7) * 2 + (li >> 4), nq = li & 15;
    const int b = pair >> 2, hc = pair & 3;
    const size_t tok0 = (size_t)b * 4096 + nq * 256;
    attn_block<192, 2>(smem, p.qmla() + ((size_t)(b * 4 + hc) * 4096 + nq * 256) * 192, 192, p.kmla() + (size_t)(b * 4 + hc) * 4096 * 192, 192,
                       p.vtC() + (size_t)(b * 4 + hc) * 128 * 4096, 0, 64, nq * 256, 0.f, 0.f, nullptr,
                       p.o() + tok0 * 2048 + 1536 + hc * 128, p.ssqh() + tok0 * 16 + 12 + hc, p.ropeC());
  }
}

DI void phase_onorm(const Params& p) {
  const int lane = otid() & 63, wid = otid() >> 6;
  for (int row = obid() * NWAVE + wid; row < T; row += gridDim.x * NWAVE) {
    const float4* sp = (const float4*)(p.ssqh() + (size_t)row * 16);
    const float4 a0 = sp[0], a1 = sp[1], b0 = sp[2], c0 = sp[3];
    const float rA = rsqrtf((a0.x + a0.y + a0.z + a0.w + a1.x + a1.y + a1.z + a1.w) * (1.f / 1024.f) + EPS);
    const float rB = rsqrtf((b0.x + b0.y + b0.z + b0.w) * (1.f / 512.f) + EPS);
    const float rC = rsqrtf((c0.x + c0.y + c0.z + c0.w) * (1.f / 512.f) + EPS);
#pragma unroll
    for (int j = 0; j < 4; ++j) {
      const float sc = (j < 2) ? rA : (j == 2 ? rB : rC);
      const size_t off = (size_t)row * 2048 + j * 512 + lane * 8;
      u32x4 w = *(const u32x4*)(p.o() + off);
      w.x = pack2bf(bf_lo(w.x) * sc, bf_hi(w.x) * sc);
      w.y = pack2bf(bf_lo(w.y) * sc, bf_hi(w.y) * sc);
      w.z = pack2bf(bf_lo(w.z) * sc, bf_hi(w.z) * sc);
      w.w = pack2bf(bf_lo(w.w) * sc, bf_hi(w.w) * sc);
      *(u32x4*)(p.on() + off) = w;
    }
  }
}

DI u32 ordkey(float s) {
  const u32 u = __float_as_uint(s);
  return u ^ ((u >> 31) ? 0xFFFFFFFFu : 0x80000000u);
}
DI float unord(u32 k) {
  const u32 u = (k & 0x80000000u) ? (k ^ 0x80000000u) : ~k;
  return __uint_as_float(u);
}
DI void insert16(u32 (&Ls)[16], u32 key) {
#pragma unroll
  for (int q = 0; q < 16; ++q) {
    const u32 hi = max(Ls[q], key);
    key = min(Ls[q], key);
    Ls[q] = hi;
  }
}

DI void phase_select(const Params& p, int L, char* smem) {
  float* sS = (float*)smem;
  u32* sTop = (u32*)(smem + 256 * 132 * 4);
  const int tid = otid(), lane = tid & 63, wid = tid >> 6, hh = lane >> 5, l31 = lane & 31;
  const int rt = wid >> 1, c = wid & 1;
  const u16* kb = p.keys_b() + (size_t)L * 256 * 128;
  for (int it = obid(); it < 1024; it += gridDim.x) {
    f32x16 sc[4];
    {
      const u16* qrow = p.pq() + ((size_t)it * 128 + rt * 32 + l31) * 128 + c * 64 + hh * 8;
      bf16x8 qa[4];
#pragma unroll
      for (int ks = 0; ks < 4; ++ks) qa[ks] = *(const bf16x8*)(qrow + ks * 16);
#pragma unroll
      for (int ct = 0; ct < 4; ++ct) {
#pragma unroll
        for (int r = 0; r < 16; ++r) sc[ct][r] = 0.f;
        const u16* krow = kb + (size_t)(c * 128 + ct * 32 + l31) * 128 + c * 64 + hh * 8;
#pragma unroll
        for (int ks = 0; ks < 4; ++ks) {
          const bf16x8 kf = *(const bf16x8*)(krow + ks * 16);
          sc[ct] = MFMA32(qa[ks], kf, sc[ct]);
        }
      }
    }
    __syncthreads();
#pragma unroll
    for (int ct = 0; ct < 4; ++ct)
#pragma unroll
      for (int r = 0; r < 16; ++r) sS[((rt * 32 + crow(r, hh)) * 2 + c) * 132 + ct * 32 + l31] = sc[ct][r];
    __syncthreads();
    {
      const int combo = tid >> 1, half = tid & 1;
      u32 Ls[16];
#pragma unroll
      for (int q = 0; q < 16; ++q) Ls[q] = 0u;
      const float* sp = sS + combo * 132 + half * 64;
      for (int n4 = 0; n4 < 16; ++n4) {
        const int n4r = (n4 + half * 8) & 15;
        const float4 v = *(const float4*)(sp + n4r * 4);
        const int nb = half * 64 + n4r * 4;
        insert16(Ls, (ordkey(v.x) & ~0x7Fu) | (u32)(127 - (nb + 0)));
        insert16(Ls, (ordkey(v.y) & ~0x7Fu) | (u32)(127 - (nb + 1)));
        insert16(Ls, (ordkey(v.z) & ~0x7Fu) | (u32)(127 - (nb + 2)));
        insert16(Ls, (ordkey(v.w) & ~0x7Fu) | (u32)(127 - (nb + 3)));
      }
      u32 Ms[16];
#pragma unroll
      for (int q = 0; q < 16; ++q) {
        const u32 other = (u32)__shfl_xor((int)Ls[15 - q], 1);
        Ms[q] = max(Ls[q], other);
      }
#pragma unroll
      for (int span = 8; span >= 1; span >>= 1)
#pragma unroll
        for (int q = 0; q < 16; ++q)
          if ((q & span) == 0) {
            const u32 hi = max(Ms[q], Ms[q + span]), lo = min(Ms[q], Ms[q + span]);
            Ms[q] = hi;
            Ms[q + span] = lo;
          }
      if (half == 0) {
#pragma unroll
        for (int q = 0; q < 16; ++q) sTop[combo * 16 + q] = Ms[q];
      }
    }
    __syncthreads();
    if (tid < 128) {
      const u32* t0 = sTop + (tid * 2) * 16;
      const u32* t1 = sTop + (tid * 2 + 1) * 16;
      float s0[16], s1[16];
#pragma unroll
      for (int q = 0; q < 16; ++q) {
        s0[q] = unord(t0[q] & ~0x7Fu);
        s1[q] = unord(t1[q] & ~0x7Fu);
      }
      u32 M[16];
#pragma unroll
      for (int q = 0; q < 16; ++q) M[q] = 0u;
#pragma unroll
      for (int i = 0; i < 16; ++i)
#pragma unroll
        for (int j = 0; j < 16; ++j)
          if ((i + 1) * (j + 1) <= 16) {
            const float sm = s0[i] + s1[j];
            insert16(M, (ordkey(sm) & ~0xFFu) | (u32)(255 - (i * 16 + j)));
          }
      const float mxv = unord(M[0] & ~0xFFu);
      float e[16], sum = 0.f;
#pragma unroll
      for (int q = 0; q < 16; ++q) {
        e[q] = __expf(unord(M[q] & ~0xFFu) - mxv);
        sum += e[q];
      }
      const float inv = 1.f / sum;
      const size_t row = (size_t)it * 128 + tid;
#pragma unroll
      for (int q = 0; q < 16; ++q) {
        const int ij = 255 - (int)(M[q] & 0xFFu);
        const int n0 = 127 - (int)(t0[ij >> 4] & 0x7Fu);
        const int n1 = 127 - (int)(t1[ij & 15] & 0x7Fu);
        p.idx()[row * 16 + q] = n0 * 128 + n1;
        p.g()[row * 16 + q] = e[q] * inv;
      }
    }
  }
}

DI float dot32(u32x4 w, const float2_t* xn2) {
  float2_t s = {0.f, 0.f};
#pragma unroll
  for (int c = 0; c < 4; ++c) {
    s = __builtin_elementwise_fma(__builtin_amdgcn_cvt_scalef32_pk_f32_fp4(w[c], 1.0f, 0), xn2[4 * c + 0], s);
    s = __builtin_elementwise_fma(__builtin_amdgcn_cvt_scalef32_pk_f32_fp4(w[c], 1.0f, 1), xn2[4 * c + 1], s);
    s = __builtin_elementwise_fma(__builtin_amdgcn_cvt_scalef32_pk_f32_fp4(w[c], 1.0f, 2), xn2[4 * c + 2], s);
    s = __builtin_elementwise_fma(__builtin_amdgcn_cvt_scalef32_pk_f32_fp4(w[c], 1.0f, 3), xn2[4 * c + 3], s);
  }
  return s.x + s.y;
}
DI void axpy32(u32x4 w, float a, float2_t* y2) {
  const float2_t a2 = {a, a};
#pragma unroll
  for (int c = 0; c < 4; ++c) {
    y2[4 * c + 0] = __builtin_elementwise_fma(__builtin_amdgcn_cvt_scalef32_pk_f32_fp4(w[c], 1.0f, 0), a2, y2[4 * c + 0]);
    y2[4 * c + 1] = __builtin_elementwise_fma(__builtin_amdgcn_cvt_scalef32_pk_f32_fp4(w[c], 1.0f, 1), a2, y2[4 * c + 1]);
    y2[4 * c + 2] = __builtin_elementwise_fma(__builtin_amdgcn_cvt_scalef32_pk_f32_fp4(w[c], 1.0f, 2), a2, y2[4 * c + 2]);
    y2[4 * c + 3] = __builtin_elementwise_fma(__builtin_amdgcn_cvt_scalef32_pk_f32_fp4(w[c], 1.0f, 3), a2, y2[4 * c + 3]);
  }
}
DI float gelu_tanh(float a) {
  const float u = 0.7978845608028654f * (a + 0.044715f * a * a * a);
  return 0.5f * a * (1.f + tanhf(u));
}

DI void phase_gather(const Params& p, int L, bool last) {
  const int wid = otid() >> 6;
  const unsigned char* U = p.ub() + (size_t)L * NEXP * 1024;
  const unsigned char* V = p.vb() + (size_t)L * NEXP * 1024;
  const float* ln2 = p.ln2 + L * 2048;
  int ni0 = 0, ni1 = 0;
  float ng0 = 0.f, ng1 = 0.f;
  {
    const int t0 = obid() * NWAVE + wid, l0 = otid() & 63;
    if (t0 < T) {
      ni0 = p.idx()[(size_t)t0 * 128 + l0]; ni1 = p.idx()[(size_t)t0 * 128 + 64 + l0];
      ng0 = p.g()[(size_t)t0 * 128 + l0];   ng1 = p.g()[(size_t)t0 * 128 + 64 + l0];
    }
  }
  for (int t = obid() * NWAVE + wid; t < T; t += gridDim.x * NWAVE) {
    const int lane = otid() & 63;
    const u16* xr = p.xb() + (size_t)t * 2048;
    float2_t xn2[16];
    float ss = 0.f;
#pragma unroll
    for (int c8 = 0; c8 < 4; ++c8) {
      const u32x4 a = *(const u32x4*)(xr + lane * 32 + c8 * 8);
      xn2[c8 * 4 + 0] = float2_t{bf_lo(a.x), bf_hi(a.x)};
      xn2[c8 * 4 + 1] = float2_t{bf_lo(a.y), bf_hi(a.y)};
      xn2[c8 * 4 + 2] = float2_t{bf_lo(a.z), bf_hi(a.z)};
      xn2[c8 * 4 + 3] = float2_t{bf_lo(a.w), bf_hi(a.w)};
    }
#pragma unroll
    for (int e = 0; e < 16; ++e) ss += xn2[e].x * xn2[e].x + xn2[e].y * xn2[e].y;
    ss = wave_sum(ss);
    const float rstd = rsqrtf(ss * (1.f / 2048.f) + EPS) * (1.f / U_SCALE);
#pragma unroll
    for (int c4 = 0; c4 < 8; ++c4) {
      const float4 a = *(const float4*)(ln2 + lane * 32 + c4 * 4);
      xn2[c4 * 2 + 0] *= float2_t{rstd * a.x, rstd * a.y};
      xn2[c4 * 2 + 1] *= float2_t{rstd * a.z, rstd * a.w};
    }
    const int i0 = ni0, i1 = ni1;
    const float g0 = ng0, g1 = ng1;
    float a0 = 0.f, a1 = 0.f;
#pragma unroll
    for (int half = 0; half < 2; ++half) {
      const int iv = half ? i1 : i0;
      float av = 0.f;
#pragma unroll 1
      for (int k0 = 0; k0 < 64; k0 += 16) {
        u32x4 w[16];
#pragma unroll
        for (int q = 0; q < 16; ++q) {
          const int row = __builtin_amdgcn_readlane(iv, k0 + q);
          w[q] = *(const u32x4*)(U + (size_t)row * 1024 + lane * 16);
        }
        float d[16];
#pragma unroll
        for (int q = 0; q < 16; ++q) {
          __builtin_amdgcn_sched_barrier(0);
          if (q > 0) asm volatile("" : "+v"(w[q]), "+v"(d[q - 1]));
          d[q] = dot32(w[q], xn2);
        }
        __builtin_amdgcn_sched_barrier(0);
        {
          const bool b5 = (lane & 32) != 0, b4 = (lane & 16) != 0, b3 = (lane & 8) != 0, b2 = (lane & 4) != 0;
          float e8[8], e4[4], e2[2], e1;
#pragma unroll
          for (int j = 0; j < 8; ++j) {
            const float snd = b5 ? d[j] : d[j + 8];
            const float kep = b5 ? d[j + 8] : d[j];
            e8[j] = kep + __shfl_xor(snd, 32);
          }
#pragma unroll
          for (int j = 0; j < 4; ++j) {
            const float snd = b4 ? e8[j] : e8[j + 4];
            const float kep = b4 ? e8[j + 4] : e8[j];
            e4[j] = kep + __shfl_xor(snd, 16);
          }
#pragma unroll
          for (int j = 0; j < 2; ++j) {
            const float snd = b3 ? e4[j] : e4[j + 2];
            const float kep = b3 ? e4[j + 2] : e4[j];
            e2[j] = kep + __shfl_xor(snd, 8);
          }
          {
            const float snd = b2 ? e2[0] : e2[1];
            const float kep = b2 ? e2[1] : e2[0];
            e1 = kep + __shfl_xor(snd, 4);
          }
          e1 += __shfl_xor(e1, 2);
          e1 += __shfl_xor(e1, 1);
          const float got = __shfl(e1, ((lane - k0) & 15) * 4);
          if (lane >= k0 && lane < k0 + 16) av = got;
        }
      }
      if (half) a1 = av; else a0 = av;
    }
    const float hs0 = gelu_tanh(a0) * g0 * (1.f / V_SCALE), hs1 = gelu_tanh(a1) * g1 * (1.f / V_SCALE);
    {
      const int tn = t + gridDim.x * NWAVE;
      if (tn < T) {
        ni0 = p.idx()[(size_t)tn * 128 + lane]; ni1 = p.idx()[(size_t)tn * 128 + 64 + lane];
        ng0 = p.g()[(size_t)tn * 128 + lane];   ng1 = p.g()[(size_t)tn * 128 + 64 + lane];
      }
    }
    float2_t y2[16];
#pragma unroll
    for (int e = 0; e < 16; ++e) y2[e] = float2_t{0.f, 0.f};
#pragma unroll
    for (int half = 0; half < 2; ++half) {
      const int iv = half ? i1 : i0;
      const int hv = __float_as_int(half ? hs1 : hs0);
#pragma unroll 1
      for (int k0 = 0; k0 < 64; k0 += 8) {
        u32x4 w[8];
        float wq[8];
#pragma unroll
        for (int q = 0; q < 8; ++q) {
          const int row = __builtin_amdgcn_readlane(iv, k0 + q);
          wq[q] = __int_as_float(__builtin_amdgcn_readlane(hv, k0 + q));
          w[q] = *(const u32x4*)(V + (size_t)row * 1024 + lane * 16);
        }
#pragma unroll
        for (int q = 0; q < 8; ++q) {
          __builtin_amdgcn_sched_barrier(0);
          asm volatile("" : "+v"(w[q]), "+v"(y2[0]), "+v"(y2[8]));
          axpy32(w[q], wq[q], y2);
        }
        __builtin_amdgcn_sched_barrier(0);
      }
    }
    int t2 = t;
    asm volatile("" : "+v"(t2));
    const int lane2 = otid() & 63;
    const u16* xr2 = p.xb() + (size_t)t2 * 2048;
#pragma unroll
    for (int c8 = 0; c8 < 4; ++c8) {
      const u32x4 a = *(const u32x4*)(xr2 + lane2 * 32 + c8 * 8);
      y2[c8 * 4 + 0] += float2_t{bf_lo(a.x), bf_hi(a.x)};
      y2[c8 * 4 + 1] += float2_t{bf_lo(a.y), bf_hi(a.y)};
      y2[c8 * 4 + 2] += float2_t{bf_lo(a.z), bf_hi(a.z)};
      y2[c8 * 4 + 3] += float2_t{bf_lo(a.w), bf_hi(a.w)};
    }
    if (!last) {
#pragma unroll
      for (int c8 = 0; c8 < 4; ++c8) {
        const float2_t* yy = y2 + c8 * 4;
        u32x4 w = {pack2bf(yy[0].x, yy[0].y), pack2bf(yy[1].x, yy[1].y), pack2bf(yy[2].x, yy[2].y), pack2bf(yy[3].x, yy[3].y)};
        *(u32x4*)(p.xb() + (size_t)t2 * 2048 + lane2 * 32 + c8 * 8) = w;
      }
    } else {
      float ss2 = 0.f;
#pragma unroll
      for (int e = 0; e < 16; ++e) ss2 += y2[e].x * y2[e].x + y2[e].y * y2[e].y;
      ss2 = wave_sum(ss2);
      const float r2 = rsqrtf(ss2 * (1.f / 2048.f) + EPS);
      float* orow = p.out + (size_t)t2 * 2048;
#pragma unroll
      for (int c4 = 0; c4 < 8; ++c4) {
        const float4 a = *(const float4*)(p.fnorm + lane2 * 32 + c4 * 4);
        *(float4*)(orow + lane2 * 32 + c4 * 4) =
            float4{y2[c4 * 2].x * r2 * a.x, y2[c4 * 2].y * r2 * a.y, y2[c4 * 2 + 1].x * r2 * a.z, y2[c4 * 2 + 1].y * r2 * a.w};
      }
    }
  }
}


#define XB_TMO      128
#define XB_XCNT(j)  (256  + 64 * (j))
#define XB_XSUB(j)  (1280 + 64 * (j))
#define XB_XGEN(j)  (2304 + 64 * (j))
#define XB_TOP      3328
#define XB_TOPGEN   3392
#define XCD_BAR_WORDS 3456
#define XB_SPIN_CAP (1u << 18)
#define LAS __attribute__((address_space(3)))
DI unsigned xb_ld(unsigned* p) { return __hip_atomic_load(p, __ATOMIC_RELAXED, __HIP_MEMORY_SCOPE_AGENT); }
DI unsigned xb_add(unsigned* p, unsigned v) { return __hip_atomic_fetch_add(p, v, __ATOMIC_RELAXED, __HIP_MEMORY_SCOPE_AGENT); }
DI unsigned xb_xcc_id() { return (unsigned)__builtin_amdgcn_s_getreg((3 << 11) | 20) & 0xFu; }
#define XB_SPIN(cond, bar) do { unsigned _sp = 0; while (cond) { __builtin_amdgcn_s_sleep(1); \
    if ((++_sp & 255u) == 0u) { if (xb_ld(&(bar)[XB_TMO])) break; if (_sp > XB_SPIN_CAP) { atomicAdd(&(bar)[XB_TMO], 1u); break; } } } } while (0)
struct XcdBarrier { unsigned* bar; unsigned x; volatile LAS unsigned* st; };
DI XcdBarrier xcd_barrier_post(unsigned* bar, volatile LAS unsigned* st) {
  XcdBarrier b; b.bar = bar; b.x = xb_xcc_id(); b.st = st;
  if (threadIdx.x == 0) (void)xb_add(&bar[XB_XCNT(b.x)], 1u);
  return b;
}
DI void xcd_barrier_complete(unsigned* bar, unsigned x, unsigned& nloc, unsigned& nx) {
  const unsigned G = gridDim.x * gridDim.y * gridDim.z;
  unsigned sum, cnt, mine, sp = 0u;
  for (;;) {
    sum = 0u; cnt = 0u; mine = 0u;
#pragma unroll
    for (unsigned j = 0; j < 16; ++j) { const unsigned c = xb_ld(&bar[XB_XCNT(j)]); sum += c; cnt += (c > 0u) ? 1u : 0u; mine = (j == x) ? c : mine; }
    if (sum == G) break;
    __builtin_amdgcn_s_sleep(1);
    if ((++sp & 255u) == 0u) { if (xb_ld(&bar[XB_TMO])) break; if (sp > XB_SPIN_CAP) { atomicAdd(&bar[XB_TMO], 1u); break; } }
  }
  nloc = mine > 0u ? mine : 1u; nx = cnt > 0u ? cnt : 1u;
}
DI void xcd_barrier(const XcdBarrier& b) {
  asm volatile("s_waitcnt vmcnt(0)" ::: "memory");
  __syncthreads();
  if (threadIdx.x == 0) {
    unsigned* bar = b.bar;
    __builtin_amdgcn_s_waitcnt(0);
    unsigned nloc = b.st[0], nx = b.st[1];
    if (nloc == 0u) { xcd_barrier_complete(bar, b.x, nloc, nx); b.st[0] = nloc; b.st[1] = nx; }
    const unsigned old = xb_add(&bar[XB_XSUB(b.x)], 1u);
    const unsigned gen = old / nloc;
    if (old + 1u == (gen + 1u) * nloc) {
      __builtin_amdgcn_fence(__ATOMIC_RELEASE, "agent");
      asm volatile("s_waitcnt vmcnt(0)" ::: "memory");
      const unsigned og = xb_add(&bar[XB_TOP], 1u);
      const unsigned tg = og / nx;
      if (og + 1u == (tg + 1u) * nx) xb_add(&bar[XB_TOPGEN], 1u);
      else XB_SPIN(xb_ld(&bar[XB_TOPGEN]) == tg, bar);
      __builtin_amdgcn_fence(__ATOMIC_ACQUIRE, "agent");
      xb_add(&bar[XB_XGEN(b.x)], 1u);
      asm volatile("s_waitcnt vmcnt(0)" ::: "memory");
    } else {
      XB_SPIN(xb_ld(&bar[XB_XGEN(b.x)]) == gen, bar);
      __builtin_amdgcn_fence(__ATOMIC_ACQUIRE, "agent");
      asm volatile("s_waitcnt vmcnt(0)" ::: "memory");
    }
  }
  __syncthreads();
}

#define KDEF(name, body)                                                       \
  __global__ void __launch_bounds__(512) name(Params p, int L) {            \
    __shared__ __attribute__((aligned(16))) char smem[SMEM_BYTES];             \
    body;                                                                      \
  }
#if !MEGA
KDEF(k_prologue, phase_prologue(p, smem))
KDEF(k_gemm1, phase_gemm1(p, L, smem))
KDEF(k_mix, phase_mix(p, L, smem))
KDEF(k_mla, phase_mla(p, smem))
KDEF(k_onorm, phase_onorm(p))
KDEF(k_gemm_o, phase_gemm_o(p, L, smem))
KDEF(k_gemm_pq, phase_gemm_pq(p, L, smem))
KDEF(k_scores, phase_gemm_scores(p, L, smem))
KDEF(k_select, phase_select(p, L, smem))
KDEF(k_gather, phase_gather(p, L, L == 1))
#else
#ifndef PROBE_MASK
#define PROBE_MASK 0
#endif
#define RUN(bit, call)                         \
  call;                                        \
  if (PROBE_MASK & (bit)) {                    \
    grid.sync();                               \
    call;                                      \
  }
__global__ void __launch_bounds__(512) mega_coop(Params p) {
  __shared__ __attribute__((aligned(16))) char smem[SMEM_BYTES];
  __shared__ uint4 xb_words;
  cg::grid_group grid = cg::this_grid();
  if (threadIdx.x == 0) xb_words = make_uint4(0u, 0u, 0u, 0u);
  __syncthreads();
  const XcdBarrier xb = xcd_barrier_post((unsigned*)(p.ws + WS_NEED), (volatile LAS unsigned*)&xb_words);
#define GSYNC xcd_barrier(xb)
  RUN(256, phase_prologue(p, smem))
  if (p.ws == nullptr) grid.sync();
  GSYNC;
#pragma unroll 1
  for (int L = 0; L < 2; ++L) {
    phase_gemm1(p, L, smem);
    GSYNC;
    phase_mix(p, L, smem);
    GSYNC;
    phase_mla(p, smem);
    GSYNC;
    phase_gemm_o(p, L, smem);
    GSYNC;
    phase_gemm_pq(p, L, smem);
    GSYNC;
    phase_select(p, L, smem);
    GSYNC;
    phase_gather(p, L, L == 1);
    if (L == 0) GSYNC;
  }
}
#endif

extern "C" void kernel_launch(void* const* d_in, const int* in_sizes, int n_in, void* d_out, int out_size, void* d_ws,
                              size_t ws_size, hipStream_t stream) {
  Params p{};
  p.x = (const float*)d_in[0]; p.ln1 = (const float*)d_in[1]; p.w_in = (const float*)d_in[2]; p.a_sink = (const float*)d_in[3];
  p.b_rel = (const float*)d_in[4]; p.cqn = (const float*)d_in[5]; p.ckvn = (const float*)d_in[6]; p.wuq = (const float*)d_in[7];
  p.wukv = (const float*)d_in[8]; p.onorm = (const float*)d_in[9]; p.wo = (const float*)d_in[10]; p.ln2 = (const float*)d_in[11];
  p.pwq = (const float*)d_in[12]; p.pkeys = (const float*)d_in[13]; p.pu = (const float*)d_in[14]; p.pv = (const float*)d_in[15];
  p.fnorm = (const float*)d_in[16];
  p.out = (float*)d_out;
  p.ws = (char*)d_ws;
  if (WS_NEED + XCD_BAR_WORDS * sizeof(unsigned) > ws_size) { fprintf(stderr, "kernel_launch: workspace too small (%zu > %zu)\n", (size_t)WS_NEED, ws_size); return; }

#if MEGA
  static int grid_blocks = 0;
  if (!grid_blocks) {
    int dev = 0, cus = 0, per_cu = 0;
    hipGetDevice(&dev);
    hipDeviceGetAttribute(&cus, hipDeviceAttributeMultiprocessorCount, dev);
    hipOccupancyMaxActiveBlocksPerMultiprocessor(&per_cu, mega_coop, NTHR, 0);
    if (per_cu > 1) per_cu = 1;
    if (per_cu < 1) per_cu = 1;
    grid_blocks = (cus * per_cu) & ~7;
  }
  (void)hipMemsetAsync(p.ws + WS_NEED, 0, XCD_BAR_WORDS * sizeof(unsigned), stream);
  void* args[] = {&p};
  hipError_t e = hipLaunchCooperativeKernel((void*)mega_coop, dim3(grid_blocks), dim3(NTHR), args, 0, stream);
  if (e != hipSuccess) fprintf(stderr, "cooperative launch failed: %s (grid %d)\n", hipGetErrorString(e), grid_blocks);
#else
  const dim3 g(256), b(NTHR);
  k_prologue<<<g, b, 0, stream>>>(p, 0);
  for (int L = 0; L < 2; ++L) {
    k_gemm1<<<g, b, 0, stream>>>(p, L);
    k_mix<<<g, b, 0, stream>>>(p, L);
    k_mla<<<g, b, 0, stream>>>(p, L);
    k_gemm_o<<<g, b, 0, stream>>>(p, L);
    k_gemm_pq<<<g, b, 0, stream>>>(p, L);
    k_select<<<g, b, 0, stream>>>(p, L);
    k_gather<<<g, b, 0, stream>>>(p, L);
  }
#endif
}
```

```cpp
#include <hip/hip_runtime.h>
#include <hip/hip_cooperative_groups.h>
#include <cstdio>
namespace cg = cooperative_groups;

#ifndef MEGA
#define MEGA 1
#endif

#define DI __device__ __forceinline__
typedef unsigned short u16;
typedef unsigned int u32;
using bf16x8 = __attribute__((ext_vector_type(8))) short;
using f32x16 = __attribute__((ext_vector_type(16))) float;
typedef __bf16 bf16x2_t __attribute__((ext_vector_type(2)));
typedef float float2_t __attribute__((ext_vector_type(2)));
typedef unsigned int u32x4 __attribute__((ext_vector_type(4)));
typedef unsigned int u32x2 __attribute__((ext_vector_type(2)));

constexpr int T = 16384, SEQ = 4096, DM = 2048, HLD = 4096;
constexpr int NTHR = 512, NWAVE = 8;
constexpr int NEXP = 16384;
constexpr float EPS = 1e-6f;
constexpr float LOG2E = 1.4426950408889634f;
constexpr float QSCALE_AB = 0.08838834764831845f * LOG2E;
constexpr float QSCALE_C = 0.07216878364870323f * LOG2E;
constexpr float U_SCALE = 90.5f, V_SCALE = 8.f;
constexpr int LDT = 72;
constexpr int GEMM_STAGE = 512 * LDT;
constexpr int GEMM_SROW_OFF = 2 * GEMM_STAGE * 2;
constexpr int SMEM_BYTES = 256 * 132 * 4 + 256 * 16 * 4;

#define MFMA32(a, b, c) __builtin_amdgcn_mfma_f32_32x32x16_bf16((a), (b), (c), 0, 0, 0)

constexpr size_t al256(size_t x) { return (x + 255) & ~(size_t)255; }
constexpr size_t OFF_wt_in = 0;
constexpr size_t OFF_wt_o = OFF_wt_in + al256((size_t)2 * HLD * 2048 * 2);
constexpr size_t OFF_wt_pq = OFF_wt_o + al256((size_t)2 * 2048 * 2048 * 2);
constexpr size_t OFF_wt_uq = OFF_wt_pq + al256((size_t)2 * 1024 * 2048 * 2);
constexpr size_t OFF_wt_ukv = OFF_wt_uq + al256((size_t)2 * 768 * 512 * 2);
constexpr size_t OFF_keys_b = OFF_wt_ukv + al256((size_t)2 * 1024 * 256 * 2);
constexpr size_t OFF_ub = OFF_keys_b + al256((size_t)2 * 256 * 128 * 2);
constexpr size_t OFF_vb = OFF_ub + al256((size_t)2 * NEXP * 1024);
constexpr size_t OFF_ropeC = OFF_vb + al256((size_t)2 * NEXP * 1024);
constexpr size_t OFF_ropeS = OFF_ropeC + al256((size_t)SEQ * 32 * 4);
constexpr size_t OFF_xres = OFF_ropeS + al256((size_t)SEQ * 32 * 4);
constexpr size_t OFF_xb = OFF_xres + al256((size_t)T * 2048 * 4);
constexpr size_t OFF_h = OFF_xb + al256((size_t)T * 2048 * 2);
constexpr size_t OFF_vtA = OFF_h + al256((size_t)T * HLD * 2);
constexpr size_t OFF_vtB = OFF_vtA + al256((size_t)T * 256 * 2);
constexpr size_t OFF_kmla = OFF_vtB + al256((size_t)T * 512 * 2);
constexpr size_t OFF_vtC = OFF_kmla + al256((size_t)T * 4 * 192 * 2);
constexpr size_t OFF_qmla = OFF_vtC + al256((size_t)T * 512 * 2);
constexpr size_t OFF_o = OFF_qmla + al256((size_t)T * 4 * 192 * 2);
constexpr size_t OFF_on = OFF_o + al256((size_t)T * 2048 * 2);
constexpr size_t OFF_ssqh = OFF_on + al256((size_t)T * 2048 * 2);
constexpr size_t OFF_END1 = OFF_ssqh + al256((size_t)T * 16 * 4);
constexpr size_t OFF_pq = OFF_h;
constexpr size_t OFF_scores = OFF_pq + al256((size_t)T * 1024 * 2);
constexpr size_t OFF_idx = OFF_scores + al256((size_t)T * 8 * 256 * 4);
constexpr size_t OFF_g = OFF_idx + al256((size_t)T * 128 * 4);
constexpr size_t OFF_END2 = OFF_g + al256((size_t)T * 128 * 4);
constexpr size_t WS_NEED = OFF_END1 > OFF_END2 ? OFF_END1 : OFF_END2;

struct Params {
  const float *x, *ln1, *w_in, *a_sink, *b_rel, *cqn, *ckvn, *wuq, *wukv, *onorm, *wo, *ln2, *pwq, *pkeys, *pu, *pv, *fnorm;
  float* out;
  char* ws;
  DI u16* wt_in() const { return (u16*)(ws + OFF_wt_in); }
  DI u16* wt_o() const { return (u16*)(ws + OFF_wt_o); }
  DI u16* wt_pq() const { return (u16*)(ws + OFF_wt_pq); }
  DI u16* wt_uq() const { return (u16*)(ws + OFF_wt_uq); }
  DI u16* wt_ukv() const { return (u16*)(ws + OFF_wt_ukv); }
  DI u16* keys_b() const { return (u16*)(ws + OFF_keys_b); }
  DI unsigned char* ub() const { return (unsigned char*)(ws + OFF_ub); }
  DI unsigned char* vb() const { return (unsigned char*)(ws + OFF_vb); }
  DI float* ropeC() const { return (float*)(ws + OFF_ropeC); }
  DI float* ropeS() const { return (float*)(ws + OFF_ropeS); }
  DI float* xres() const { return (float*)(ws + OFF_xres); }
  DI u16* xb() const { return (u16*)(ws + OFF_xb); }
  DI u16* h() const { return (u16*)(ws + OFF_h); }
  DI u16* vtA() const { return (u16*)(ws + OFF_vtA); }
  DI u16* vtB() const { return (u16*)(ws + OFF_vtB); }
  DI u16* kmla() const { return (u16*)(ws + OFF_kmla); }
  DI u16* vtC() const { return (u16*)(ws + OFF_vtC); }
  DI u16* qmla() const { return (u16*)(ws + OFF_qmla); }
  DI u16* o() const { return (u16*)(ws + OFF_o); }
  DI u16* on() const { return (u16*)(ws + OFF_on); }
  DI float* ssqh() const { return (float*)(ws + OFF_ssqh); }
  DI u16* pq() const { return (u16*)(ws + OFF_pq); }
  DI float* scores() const { return (float*)(ws + OFF_scores); }
  DI int* idx() const { return (int*)(ws + OFF_idx); }
  DI float* g() const { return (float*)(ws + OFF_g); }
};

DI int otid() { int t = threadIdx.x; asm volatile("" : "+v"(t)); return t; }
DI int obid() { int b = blockIdx.x; asm volatile("" : "+s"(b)); return b; }
DI u16 f2bf(float x) {
  u32 u = __float_as_uint(x);
  u += 0x7fffu + ((u >> 16) & 1u);
  return (u16)(u >> 16);
}
DI u32 pack2bf(float a, float b) {
  float2_t f = {a, b};
  bf16x2_t r = __builtin_convertvector(f, bf16x2_t);
  return __builtin_bit_cast(u32, r);
}
DI float bf_lo(u32 w) { return __uint_as_float(w << 16); }
DI float bf_hi(u32 w) { return __uint_as_float(w & 0xffff0000u); }
DI int crow(int r, int h) { return (r & 3) + 8 * (r >> 2) + 4 * h; }
DI float wave_sum(float v) {
#pragma unroll
  for (int o = 32; o >= 1; o >>= 1) v += __shfl_xor(v, o);
  return v;
}
DI float ssq8(u32x4 w) {
  float s = 0.f, a;
  a = bf_lo(w.x); s += a * a; a = bf_hi(w.x); s += a * a;
  a = bf_lo(w.y); s += a * a; a = bf_hi(w.y); s += a * a;
  a = bf_lo(w.z); s += a * a; a = bf_hi(w.z); s += a * a;
  a = bf_lo(w.w); s += a * a; a = bf_hi(w.w); s += a * a;
  return s;
}
DI bool gemm_tile_map(int it, int MT, int NT, int& mt, int& nt) {
  const int b = obid(), x = b & 7, nb = gridDim.x >> 3;
  const int li = it * nb + (b >> 3);
  const int nrn = (NT + 7) >> 3, nrect = (MT >> 3) * nrn;
  const int q = x + 8 * (li >> 6);
  if (q >= nrect) { mt = -1; nt = 0; return false; }
  const int in = li & 63;
  mt = (q / nrn) * 8 + (in >> 3);
  nt = (q % nrn) * 8 + (in & 7);
  return nt < NT;
}

constexpr int GM = 256, GN = 256;
DI u32x4 scale8(u32x4 w, float sc) {
  w.x = pack2bf(bf_lo(w.x) * sc, bf_hi(w.x) * sc);
  w.y = pack2bf(bf_lo(w.y) * sc, bf_hi(w.y) * sc);
  w.z = pack2bf(bf_lo(w.z) * sc, bf_hi(w.z) * sc);
  w.w = pack2bf(bf_lo(w.w) * sc, bf_hi(w.w) * sc);
  return w;
}
template <bool ROWNORM, bool CONV = false, bool ASCALE = false>
DI void gemm_mainloop(const u16* __restrict__ Ag, int lda, const u16* __restrict__ Bg, int ldb, int K, char* smem,
                      f32x16 (&acc)[4][2], const float4* __restrict__ csrc = nullptr, u16* __restrict__ cdst = nullptr,
                      float cscale = 1.f) {
  u16* sbase = (u16*)smem;
  float* sRow = (float*)(smem + GEMM_SROW_OFF);
  const int tid = otid(), lane = tid & 63, wid = tid >> 6;
  const int wm = wid >> 2, wn = wid & 3, hh = lane >> 5, l31 = lane & 31;
  const int lr = tid >> 3, lc = (tid & 7) * 8;
#pragma unroll
  for (int i = 0; i < 4; ++i)
#pragma unroll
    for (int j = 0; j < 2; ++j)
#pragma unroll
      for (int r = 0; r < 16; ++r) acc[i][j][r] = 0.f;
  u32x4 ra[4], rb[4];
  float ssq[4] = {0.f, 0.f, 0.f, 0.f};
  const u16* ap = Ag + (size_t)lr * lda + lc;
  const u16* bp = Bg + (size_t)lr * ldb + lc;
#pragma unroll
  for (int i = 0; i < 4; ++i) {
    ra[i] = *(const u32x4*)(ap + (size_t)(64 * i) * lda);
    rb[i] = *(const u32x4*)(bp + (size_t)(64 * i) * ldb);
  }
  __syncthreads();
#pragma unroll
  for (int i = 0; i < 4; ++i) {
    if (ASCALE) ra[i] = scale8(ra[i], sRow[(lr + 64 * i) * 4 + 0]);
    *(u32x4*)(sbase + (lr + 64 * i) * LDT + lc) = ra[i];
    *(u32x4*)(sbase + (256 + lr + 64 * i) * LDT + lc) = rb[i];
    if (ROWNORM) ssq[i] += ssq8(ra[i]);
  }
  __syncthreads();
  const int nk = K >> 6;
#pragma unroll 1
  for (int kt = 0; kt < nk; ++kt) {
    const int cur = kt & 1;
    const bool more = (kt + 1 < nk);
    const int kn = more ? kt + 1 : kt;
    float4 cv;
    if (CONV) cv = csrc[(size_t)kt * NTHR + tid];
#pragma unroll
    for (int i = 0; i < 4; ++i) {
      ra[i] = *(const u32x4*)(ap + (size_t)(64 * i) * lda + kn * 64);
      rb[i] = *(const u32x4*)(bp + (size_t)(64 * i) * ldb + kn * 64);
    }
    const u16* a_s = sbase + cur * GEMM_STAGE + (wm * 128 + l31) * LDT + hh * 8;
    const u16* b_s = sbase + cur * GEMM_STAGE + (256 + wn * 64 + l31) * LDT + hh * 8;
#pragma unroll
    for (int ks = 0; ks < 4; ++ks) {
      const bf16x8 b0 = *(const bf16x8*)(b_s + ks * 16);
      const bf16x8 b1 = *(const bf16x8*)(b_s + 32 * LDT + ks * 16);
      bf16x8 a0[4];
#pragma unroll
      for (int i = 0; i < 4; ++i) a0[i] = *(const bf16x8*)(a_s + i * 32 * LDT + ks * 16);
      __builtin_amdgcn_s_setprio(1);
#pragma unroll
      for (int i = 0; i < 4; ++i) {
        acc[i][0] = MFMA32(a0[i], b0, acc[i][0]);
        acc[i][1] = MFMA32(a0[i], b1, acc[i][1]);
      }
      __builtin_amdgcn_s_setprio(0);
    }
    {
      u16* w = sbase + (cur ^ 1) * GEMM_STAGE;
      const int g = (kn < 16) ? 0 : (kn < 24 ? 1 : 2);
#pragma unroll
      for (int i = 0; i < 4; ++i) {
        if (ASCALE) ra[i] = scale8(ra[i], sRow[(lr + 64 * i) * 4 + g]);
        *(u32x4*)(w + (lr + 64 * i) * LDT + lc) = ra[i];
        *(u32x4*)(w + (256 + lr + 64 * i) * LDT + lc) = rb[i];
        if (ROWNORM) ssq[i] += more ? ssq8(ra[i]) : 0.f;
      }
    }
    if (CONV) {
      u32 w4 = 0;
      w4 = __builtin_amdgcn_cvt_scalef32_pk_fp4_f32(w4, cv.x * cscale, cv.y * cscale, 1.0f, 0);
      w4 = __builtin_amdgcn_cvt_scalef32_pk_fp4_f32(w4, cv.z * cscale, cv.w * cscale, 1.0f, 1);
      cdst[(size_t)kt * NTHR + tid] = (u16)w4;
    }
    __syncthreads();
  }
  if (ROWNORM) {
#pragma unroll
    for (int i = 0; i < 4; ++i) {
      float s = ssq[i];
      s += __shfl_xor(s, 1);
      s += __shfl_xor(s, 2);
      s += __shfl_xor(s, 4);
      if ((tid & 7) == 0) sRow[lr + 64 * i] = rsqrtf(s / (float)K + EPS);
    }
    __syncthreads();
  }
}

DI void conv_transpose_all(const Params& p, char* smem) {
  const int lane = otid() & 63, wid = otid() >> 6;
  float* s = (float*)smem + wid * (64 * 65);
  constexpr int T0 = 32 * 61, T1 = T0 + 32 * 32, T2 = T1 + 32 * 16, T3 = T2 + 8 * 12, T4 = T3 + 4 * 16;
  for (int f = obid() * NWAVE + wid; f < 2 * T4; f += gridDim.x * NWAVE) {
    const int L = f / T4, r = f % T4;
    const float* W; const float* g; u16* Wt; int K, N, tile;
    if (r < T0)      { W = p.w_in + (size_t)L * 2048 * 3904; g = p.ln1 + L * 2048;   Wt = p.wt_in() + (size_t)L * HLD * 2048;   K = 2048; N = 3904; tile = r; }
    else if (r < T1) { W = p.wo + (size_t)L * 2048 * 2048;   g = p.onorm + L * 2048; Wt = p.wt_o() + (size_t)L * 2048 * 2048;   K = 2048; N = 2048; tile = r - T0; }
    else if (r < T2) { W = p.pwq + (size_t)L * 2048 * 1024;  g = p.ln2 + L * 2048;   Wt = p.wt_pq() + (size_t)L * 1024 * 2048;  K = 2048; N = 1024; tile = r - T1; }
    else if (r < T3) { W = p.wuq + (size_t)L * 512 * 768;    g = p.cqn + L * 512;    Wt = p.wt_uq() + (size_t)L * 768 * 512;    K = 512;  N = 768;  tile = r - T2; }
    else             { W = p.wukv + (size_t)L * 256 * 1024;  g = p.ckvn + L * 256;   Wt = p.wt_ukv() + (size_t)L * 1024 * 256;  K = 256;  N = 1024; tile = r - T3; }
    const int ntn = N / 64;
    const int k0 = (tile / ntn) * 64, n0 = (tile % ntn) * 64;
#pragma unroll 8
    for (int kk = 0; kk < 64; ++kk) s[kk * 65 + lane] = W[(size_t)(k0 + kk) * N + n0 + lane] * g[k0 + kk];
    __builtin_amdgcn_fence(__ATOMIC_RELEASE, "wavefront");
    __builtin_amdgcn_wave_barrier();
    __builtin_amdgcn_fence(__ATOMIC_ACQUIRE, "wavefront");
#pragma unroll 8
    for (int nn = 0; nn < 64; ++nn) Wt[(size_t)(n0 + nn) * K + k0 + lane] = f2bf(s[lane * 65 + nn]);
    __builtin_amdgcn_fence(__ATOMIC_RELEASE, "wavefront");
    __builtin_amdgcn_wave_barrier();
    __builtin_amdgcn_fence(__ATOMIC_ACQUIRE, "wavefront");
  }
}
DI void conv_flat(const float* __restrict__ src, u16* __restrict__ dst, size_t n4) {
  for (size_t i = (size_t)obid() * NTHR + otid(); i < n4; i += (size_t)gridDim.x * NTHR) {
    float4 v = ((const float4*)src)[i];
    u32x2 w = {pack2bf(v.x, v.y), pack2bf(v.z, v.w)};
    ((u32x2*)dst)[i] = w;
  }
}
DI void conv_fp4(const float* __restrict__ src, unsigned char* __restrict__ dst, size_t n8, float sc) {
  for (size_t i = (size_t)obid() * NTHR + otid(); i < n8; i += (size_t)gridDim.x * NTHR) {
    const float4 a = ((const float4*)src)[i * 2 + 0], b = ((const float4*)src)[i * 2 + 1];
    u32 w = 0;
    w = __builtin_amdgcn_cvt_scalef32_pk_fp4_f32(w, a.x * sc, a.y * sc, 1.0f, 0);
    w = __builtin_amdgcn_cvt_scalef32_pk_fp4_f32(w, a.z * sc, a.w * sc, 1.0f, 1);
    w = __builtin_amdgcn_cvt_scalef32_pk_fp4_f32(w, b.x * sc, b.y * sc, 1.0f, 2);
    w = __builtin_amdgcn_cvt_scalef32_pk_fp4_f32(w, b.z * sc, b.w * sc, 1.0f, 3);
    ((u32*)dst)[i] = w;
  }
}
DI void phase_prologue(const Params& p, char* smem) {
  __syncthreads();
  conv_transpose_all(p, smem);
  for (int L = 0; L < 2; ++L) {
    u16* pad = p.wt_in() + (size_t)L * HLD * 2048 + (size_t)3904 * 2048;
    for (int i = obid() * NTHR + otid(); i < 192 * 2048 / 8; i += gridDim.x * NTHR) ((u32x4*)pad)[i] = u32x4{0, 0, 0, 0};
  }
  for (int i = obid() * NTHR + otid(); i < 2 * 256 * 128; i += gridDim.x * NTHR) {
    const int L = i >> 15, n = (i >> 7) & 255, k = i & 127;
    const int c = n >> 7, kin = k - 64 * c;
    const float v = (kin >= 0 && kin < 64) ? p.pkeys[((size_t)(L * 2 + c) * 128 + (n & 127)) * 64 + kin] : 0.f;
    p.keys_b()[i] = f2bf(v);
  }
  conv_flat(p.x, p.xb(), (size_t)T * 2048 / 4);
  for (int i = obid() * NTHR + otid(); i < SEQ * 32; i += gridDim.x * NTHR) {
    const int pos = i >> 5, f = i & 31;
    const float inv = powf(10000.0f, -(float)f / 32.0f);
    const float ang = (float)pos * inv;
    p.ropeC()[i] = cosf(ang);
    p.ropeS()[i] = sinf(ang);
  }
}

#define EPI_IDS                                                                                     \
  const int etid = otid();                                                                          \
  const int lane = etid & 63, wid = etid >> 6, wm = wid >> 2, wn = wid & 3, hh = lane >> 5, l31 = lane & 31;

DI void phase_gemm1(const Params& p, int L, char* smem) {
  const u16* Wt = p.wt_in() + (size_t)L * HLD * 2048;
  const float* sRow = (const float*)(smem + GEMM_SROW_OFF);
  for (int it = 0;; ++it) {
    int mt, nt;
    if (!gemm_tile_map(it, 64, 16, mt, nt)) { if (mt < 0) break; continue; }
    f32x16 acc[4][2];
    const int tile_id = mt * 16 + nt;
    const bool isv = tile_id >= 512;
    const float4* csrc = (const float4*)((isv ? p.pv : p.pu) + (size_t)L * NEXP * 2048) + (size_t)(tile_id & 511) * 32 * NTHR;
    u16* cdst = (u16*)((isv ? p.vb() : p.ub()) + (size_t)L * NEXP * 1024) + (size_t)(tile_id & 511) * 32 * NTHR;
    gemm_mainloop<true, true>(p.xb() + (size_t)mt * GM * 2048, 2048, Wt + (size_t)nt * GN * 2048, 2048, 2048, smem, acc, csrc, cdst,
                              isv ? V_SCALE : U_SCALE);
    EPI_IDS
    const int nt128 = nt * 2 + (wn >> 1), wn1 = wn & 1;
    const int m0 = mt * GM, b = m0 >> 12, s0 = m0 & 4095;
    if (nt128 >= 30) {
      if (nt128 == 30 && wn1 == 0) {
#pragma unroll
        for (int i = 0; i < 4; ++i)
#pragma unroll
          for (int r = 0; r < 16; ++r) {
            const int rl = wm * 128 + i * 32 + crow(r, hh);
            const float rs = sRow[rl];
            const float x1 = acc[i][0][r] * rs, x2 = acc[i][1][r] * rs;
            const int pos = s0 + rl;
            const float c = p.ropeC()[pos * 32 + l31], sn = p.ropeS()[pos * 32 + l31];
            const u16 o1 = f2bf(x1 * c - x2 * sn), o2 = f2bf(x1 * sn + x2 * c);
#pragma unroll
            for (int hd = 0; hd < 4; ++hd) {
              u16* kr = p.kmla() + ((size_t)(b * 4 + hd) * 4096 + pos) * 192 + 128;
              kr[l31] = o1;
              kr[32 + l31] = o2;
            }
            if ((r & 3) == 3) __builtin_amdgcn_sched_barrier(0);
          }
      }
    } else if (nt128 == 10 || nt128 == 11 || (nt128 >= 20 && nt128 < 24)) {
      u16* vt;
      int nh, hd;
      if (nt128 < 12) { vt = p.vtA(); nh = 2; hd = nt128 - 10; } else { vt = p.vtB(); nh = 4; hd = nt128 - 20; }
#pragma unroll
      for (int i = 0; i < 4; ++i)
#pragma unroll
        for (int j = 0; j < 2; ++j)
#pragma unroll
          for (int g4 = 0; g4 < 4; ++g4) {
            const int rl0 = wm * 128 + i * 32 + 8 * g4 + 4 * hh;
            const int d = wn1 * 64 + j * 32 + l31;
            const float v0 = acc[i][j][4 * g4 + 0] * sRow[rl0 + 0], v1 = acc[i][j][4 * g4 + 1] * sRow[rl0 + 1];
            const float v2 = acc[i][j][4 * g4 + 2] * sRow[rl0 + 2], v3 = acc[i][j][4 * g4 + 3] * sRow[rl0 + 3];
            u32x2 w = {pack2bf(v0, v1), pack2bf(v2, v3)};
            *(u32x2*)(vt + ((size_t)(b * nh + hd) * 128 + d) * 4096 + s0 + rl0) = w;
          }
    } else {
      const float sc = (nt128 < 8 || (nt128 >= 12 && nt128 < 16)) ? QSCALE_AB : 1.f;
#pragma unroll
      for (int i = 0; i < 4; ++i)
#pragma unroll
        for (int j = 0; j < 2; ++j)
#pragma unroll
          for (int r = 0; r < 16; ++r) {
            const int rl = wm * 128 + i * 32 + crow(r, hh);
            p.h()[(size_t)(m0 + rl) * HLD + nt128 * 128 + wn1 * 64 + j * 32 + l31] = f2bf(acc[i][j][r] * sRow[rl] * sc);
          }
    }
  }
}

DI void tile_upq(const Params& p, int L, int tile, char* smem) {
  const float* sRow = (const float*)(smem + GEMM_SROW_OFF);
  const int mt = tile / 3, nt = tile % 3;
  f32x16 acc[4][2];
  gemm_mainloop<true>(p.h() + (size_t)mt * GM * HLD + 3072, HLD, p.wt_uq() + (size_t)L * 768 * 512 + (size_t)nt * GN * 512, 512, 512,
                      smem, acc);
  EPI_IDS
  const int m0 = mt * GM, b = m0 >> 12, s0 = m0 & 4095;
  const int nb64 = nt * 4 + wn;
  const int head = nb64 / 3, part = nb64 % 3;
#pragma unroll
  for (int i = 0; i < 4; ++i)
#pragma unroll
    for (int j = 0; j < 2; ++j)
#pragma unroll
      for (int r = 0; r < 16; ++r) {
        const int rl = wm * 128 + i * 32 + crow(r, hh);
        const int pos = s0 + rl;
        p.qmla()[((size_t)(b * 4 + head) * 4096 + pos) * 192 + part * 64 + j * 32 + l31] = f2bf(acc[i][j][r] * sRow[rl] * QSCALE_C);
      }
}

DI void tile_upkv(const Params& p, int L, int tile, char* smem) {
  const float* sRow = (const float*)(smem + GEMM_SROW_OFF);
  const int mt = tile >> 2, nt = tile & 3;
  f32x16 acc[4][2];
  gemm_mainloop<true>(p.h() + (size_t)mt * GM * HLD + 3584, HLD, p.wt_ukv() + (size_t)L * 1024 * 256 + (size_t)nt * GN * 256, 256, 256,
                      smem, acc);
  EPI_IDS
  const int nt128 = nt * 2 + (wn >> 1), wn1 = wn & 1;
  const int m0 = mt * GM, b = m0 >> 12, s0 = m0 & 4095;
  const int head = nt128 >> 1;
  if (nt128 & 1) {
#pragma unroll
    for (int i = 0; i < 4; ++i)
#pragma unroll
      for (int j = 0; j < 2; ++j)
#pragma unroll
        for (int g4 = 0; g4 < 4; ++g4) {
          const int rl0 = wm * 128 + i * 32 + 8 * g4 + 4 * hh;
          const int d = wn1 * 64 + j * 32 + l31;
          const float v0 = acc[i][j][4 * g4 + 0] * sRow[rl0 + 0], v1 = acc[i][j][4 * g4 + 1] * sRow[rl0 + 1];
          const float v2 = acc[i][j][4 * g4 + 2] * sRow[rl0 + 2], v3 = acc[i][j][4 * g4 + 3] * sRow[rl0 + 3];
          u32x2 w = {pack2bf(v0, v1), pack2bf(v2, v3)};
          *(u32x2*)(p.vtC() + ((size_t)(b * 4 + head) * 128 + d) * 4096 + s0 + rl0) = w;
        }
  } else {
#pragma unroll
    for (int i = 0; i < 4; ++i)
#pragma unroll
      for (int j = 0; j < 2; ++j)
#pragma unroll
        for (int r = 0; r < 16; ++r) {
          const int rl = wm * 128 + i * 32 + crow(r, hh);
          const int pos = s0 + rl;
          p.kmla()[((size_t)(b * 4 + head) * 4096 + pos) * 192 + wn1 * 64 + j * 32 + l31] = f2bf(acc[i][j][r] * sRow[rl]);
        }
  }
}

DI void phase_gemm_o(const Params& p, int L, char* smem) {
  const u16* Wt = p.wt_o() + (size_t)L * 2048 * 2048;
  for (int it = 0;; ++it) {
    int mt, nt;
    if (!gemm_tile_map(it, 64, 8, mt, nt)) { if (mt < 0) break; continue; }
    f32x16 acc[4][2];
    {
      float* sRow = (float*)(smem + GEMM_SROW_OFF);
      const int t = otid();
      __syncthreads();
      if (t < 256) {
        const float4* sp = (const float4*)(p.ssqh() + (size_t)(mt * GM + t) * 16);
        const float4 a0 = sp[0], a1 = sp[1], b0 = sp[2], c0 = sp[3];
        sRow[t * 4 + 0] = rsqrtf((a0.x + a0.y + a0.z + a0.w + a1.x + a1.y + a1.z + a1.w) * (1.f / 1024.f) + EPS);
        sRow[t * 4 + 1] = rsqrtf((b0.x + b0.y + b0.z + b0.w) * (1.f / 512.f) + EPS);
        sRow[t * 4 + 2] = rsqrtf((c0.x + c0.y + c0.z + c0.w) * (1.f / 512.f) + EPS);
      }
    }
    gemm_mainloop<false, false, true>(p.o() + (size_t)mt * GM * 2048, 2048, Wt + (size_t)nt * GN * 2048, 2048, 2048, smem, acc);
    EPI_IDS
#pragma unroll
    for (int i = 0; i < 4; ++i)
#pragma unroll
      for (int j = 0; j < 2; ++j)
#pragma unroll
        for (int r = 0; r < 16; ++r) {
          const size_t off = (size_t)(mt * GM + wm * 128 + i * 32 + crow(r, hh)) * 2048 + nt * GN + wn * 64 + j * 32 + l31;
          const float xv = __uint_as_float(((u32)p.xb()[off]) << 16);
          p.xb()[off] = f2bf(xv + acc[i][j][r]);
        }
  }
}

DI void phase_gemm_pq(const Params& p, int L, char* smem) {
  const u16* Wt = p.wt_pq() + (size_t)L * 1024 * 2048;
  const float* sRow = (const float*)(smem + GEMM_SROW_OFF);
  for (int tile = obid(); tile < 64 * 4; tile += gridDim.x) {
    const int mt = tile >> 2, nt = tile & 3;
    f32x16 acc[4][2];
    gemm_mainloop<true>(p.xb() + (size_t)mt * GM * 2048, 2048, Wt + (size_t)nt * GN * 2048, 2048, 2048, smem, acc);
    EPI_IDS
#pragma unroll
    for (int i = 0; i < 4; ++i)
#pragma unroll
      for (int j = 0; j < 2; ++j)
#pragma unroll
        for (int r = 0; r < 16; ++r) {
          const int rl = wm * 128 + i * 32 + crow(r, hh);
          p.pq()[(size_t)(mt * GM + rl) * 1024 + nt * GN + wn * 64 + j * 32 + l31] = f2bf(acc[i][j][r] * sRow[rl]);
        }
  }
}

DI void phase_gemm_scores(const Params& p, int L, char* smem) {
  for (int mt = obid(); mt < 512; mt += gridDim.x) {
    f32x16 acc[4][2];
    gemm_mainloop<false>(p.pq() + (size_t)mt * GM * 128, 128, p.keys_b() + (size_t)L * 256 * 128, 128, 128, smem, acc);
    EPI_IDS
#pragma unroll
    for (int i = 0; i < 4; ++i)
#pragma unroll
      for (int j = 0; j < 2; ++j)
#pragma unroll
        for (int r = 0; r < 16; ++r) {
          const int rl = wm * 128 + i * 32 + crow(r, hh);
          p.scores()[(size_t)(mt * GM + rl) * 256 + wn * 64 + j * 32 + l31] = acc[i][j][r];
        }
  }
}

template <int DQK, int MODE>
DI void attn_block(char* smem, const u16* __restrict__ Q, int ldq, const u16* __restrict__ Kb, int ldk,
                   const u16* __restrict__ Vt, int t0, int t1, int qpos0, float slope2, float sink2,
                   const float* __restrict__ biasTbl, u16* __restrict__ Oout, float* __restrict__ ssq_out,
                   const float* __restrict__ ropeCS = nullptr) {
  constexpr int LDK = DQK + 8;
  constexpr int NCH = DQK / 8;
  constexpr int KCH = NCH / 8;
  constexpr int NKS = DQK / 16;
  constexpr int STG = 64 * LDK + 128 * 68;
  u16* sbase = (u16*)smem;
  float* sBias = (float*)(sbase + 2 * STG);
  const int tid = otid(), lane = tid & 63, wid = tid >> 6, hh = lane >> 5, l31 = lane & 31;

  __syncthreads();
  if (MODE == 1) {
    for (int i = tid; i < 465; i += NTHR) sBias[i] = biasTbl[i] * LOG2E;
  }
  bf16x8 qf[NKS];
  {
    const u16* qrow = Q + (size_t)(wid * 32 + l31) * ldq + hh * 8;
#pragma unroll
    for (int ks = 0; ks < NKS; ++ks) qf[ks] = *(const bf16x8*)(qrow + ks * 16);
  }
  if (MODE == 2) {
    const int pos = qpos0 + wid * 32 + l31;
#pragma unroll
    for (int k2 = 0; k2 < 2; ++k2) {
      const float* cp = ropeCS + (size_t)pos * 32 + k2 * 16 + 8 * hh;
      const float* sp = ropeCS + (size_t)SEQ * 32 + (size_t)pos * 32 + k2 * 16 + 8 * hh;
#pragma unroll
      for (int j = 0; j < 8; ++j) {
        const float c = cp[j], sn = sp[j];
        const float x1 = __uint_as_float(((u32)(u16)qf[NKS - 4 + k2][j]) << 16);
        const float x2 = __uint_as_float(((u32)(u16)qf[NKS - 2 + k2][j]) << 16);
        qf[NKS - 4 + k2][j] = (short)f2bf(x1 * c - x2 * sn);
        qf[NKS - 2 + k2][j] = (short)f2bf(x1 * sn + x2 * c);
      }
    }
  }
  constexpr float SM_THR = 6.f;
  float m_run = (MODE == 0) ? sink2 : 0.f;
  float l_run = (MODE == 0 && hh == 0) ? 1.f : 0.f;
  bool first = true;
  f32x16 oacc[4];
#pragma unroll
  for (int d = 0; d < 4; ++d)
#pragma unroll
    for (int r = 0; r < 16; ++r) oacc[d][r] = 0.f;

  const int widu = __builtin_amdgcn_readfirstlane(wid);
  const int qw0 = qpos0 + widu * 32;
  const int qpos = qw0 + l31;
  const int rq = (qpos0 >> 6) + (widu >> 1);
  const int rsq = min(max(rq - 4, 0), 56);
  const int cq = (wid & 1) * 32 + l31;
  const int cs = min(max(cq - 8, 0), 48);

  u32x4 rk[KCH], rv[2];
#define ATTN_LOAD_TILE(TT)                                                              \
  {                                                                                     \
    _Pragma("unroll") for (int i = 0; i < KCH; ++i) {                                   \
      const int c = tid + NTHR * i;                                                     \
      const int rr = c / NCH, cc = c % NCH;                                             \
      rk[i] = *(const u32x4*)(Kb + (size_t)((TT) * 64 + rr) * ldk + cc * 8);            \
    }                                                                                   \
    _Pragma("unroll") for (int i = 0; i < 2; ++i) {                                     \
      const int c = tid + NTHR * i;                                                     \
      const int d = c >> 3, part = c & 7;                                               \
      rv[i] = *(const u32x4*)(Vt + (size_t)d * 4096 + (TT) * 64 + part * 8);            \
    }                                                                                   \
  }
#define ATTN_STORE_TILE(STAGE)                                                          \
  {                                                                                     \
    u16* sKw = sbase + (STAGE) * STG;                                                   \
    u16* sVw = sKw + 64 * LDK;                                                          \
    _Pragma("unroll") for (int i = 0; i < KCH; ++i) {                                   \
      const int c = tid + NTHR * i;                                                     \
      const int rr = c / NCH, cc = c % NCH;                                             \
      *(u32x4*)(sKw + rr * LDK + cc * 8) = rk[i];                                       \
    }                                                                                   \
    _Pragma("unroll") for (int i = 0; i < 2; ++i) {                                     \
      const int c = tid + NTHR * i;                                                     \
      const int d = c >> 3, part = c & 7;                                               \
      *(u32x2*)(sVw + d * 68 + part * 8) = u32x2{rv[i].x, rv[i].y};                     \
      *(u32x2*)(sVw + d * 68 + part * 8 + 4) = u32x2{rv[i].z, rv[i].w};                 \
    }                                                                                   \
  }
  ATTN_LOAD_TILE(t0)
  ATTN_STORE_TILE(0)
  __syncthreads();
#pragma unroll 1
  for (int t = t0; t < t1; ++t) {
    const int cur = (t - t0) & 1;
    {
      const int tn = (t + 1 < t1) ? t + 1 : t;
      ATTN_LOAD_TILE(tn)
    }
    const u16* sK = sbase + cur * STG;
    const u16* sV = sK + 64 * LDK;
    bool relevant = true;
    if (MODE == 0) relevant = (t * 64 <= qw0 + 31 + 128) && (t * 64 + 63 >= qw0 - 128);
    if (MODE == 1) relevant = (t >= rsq) && (t < rsq + 8);
    if (relevant) {
      f32x16 sacc[2];
#pragma unroll
      for (int tt = 0; tt < 2; ++tt) {
#pragma unroll
        for (int r = 0; r < 16; ++r) sacc[tt][r] = -m_run;
        const u16* kp = sK + (tt * 32 + l31) * LDK + hh * 8;
#pragma unroll
        for (int ks = 0; ks < NKS; ++ks) {
          bf16x8 kf = *(const bf16x8*)(kp + ks * 16);
          sacc[tt] = MFMA32(kf, qf[ks], sacc[tt]);
        }
      }
      float mx = -INFINITY;
      const int drow = min(max(t - rq + 7, 0), 14) * 31;
#pragma unroll
      for (int tt = 0; tt < 2; ++tt)
#pragma unroll
        for (int r = 0; r < 16; ++r) {
          float sv = sacc[tt][r];
          const int kl = tt * 32 + crow(r, hh);
          if (MODE == 0) {
            const int kpos = t * 64 + kl;
            int dist = qpos - kpos;
            dist = dist < 0 ? -dist : dist;
            sv = (dist <= 128) ? (sv - slope2 * (float)dist) : -INFINITY;
          } else if (MODE == 1) {
            const bool ok = ((unsigned)(kl - cs) < 16u);
            const int dc = min(max(kl - cq + 15, 0), 30);
            sv = ok ? (sv + sBias[drow + dc]) : -INFINITY;
          }
          sacc[tt][r] = sv;
          mx = fmaxf(mx, sv);
        }
      mx = fmaxf(mx, __shfl_xor(mx, 32));
      if (__builtin_amdgcn_ballot_w64(first || (mx > SM_THR)) != 0ull) {
        float delta = fmaxf(mx, 0.f);
        if (first && MODE != 0) delta = (mx > -INFINITY) ? mx : 0.f;
        m_run += delta;
        const float alpha = __builtin_amdgcn_exp2f(-delta);
        l_run *= alpha;
#pragma unroll
        for (int d = 0; d < 4; ++d)
#pragma unroll
          for (int r = 0; r < 16; ++r) oacc[d][r] *= alpha;
#pragma unroll
        for (int tt = 0; tt < 2; ++tt)
#pragma unroll
          for (int r = 0; r < 16; ++r) sacc[tt][r] -= delta;
        first = false;
      }
      float ps = 0.f;
#pragma unroll
      for (int tt = 0; tt < 2; ++tt) {
#pragma unroll
        for (int r = 0; r < 16; ++r) {
          const float pv = __builtin_amdgcn_exp2f(sacc[tt][r]);
          sacc[tt][r] = pv;
          ps += pv;
        }
#pragma unroll
        for (int s2 = 0; s2 < 2; ++s2) {
          u32x4 w;
          w.x = pack2bf(sacc[tt][8 * s2 + 0], sacc[tt][8 * s2 + 1]);
          w.y = pack2bf(sacc[tt][8 * s2 + 2], sacc[tt][8 * s2 + 3]);
          w.z = pack2bf(sacc[tt][8 * s2 + 4], sacc[tt][8 * s2 + 5]);
          w.w = pack2bf(sacc[tt][8 * s2 + 6], sacc[tt][8 * s2 + 7]);
          const bf16x8 pf = __builtin_bit_cast(bf16x8, w);
#pragma unroll
          for (int dt = 0; dt < 4; ++dt) {
            const u16* vp = sV + (dt * 32 + l31) * 68 + 4 * hh;
            const u32x2 lo = *(const u32x2*)(vp + tt * 32 + s2 * 16);
            const u32x2 hi = *(const u32x2*)(vp + tt * 32 + s2 * 16 + 8);
            u32x4 wv = {lo.x, lo.y, hi.x, hi.y};
            oacc[dt] = MFMA32(__builtin_bit_cast(bf16x8, wv), pf, oacc[dt]);
          }
        }
      }
      l_run += ps;
    }
    ATTN_STORE_TILE(cur ^ 1)
    __syncthreads();
  }
  const float lt = l_run + __shfl_xor(l_run, 32);
  const float inv = 1.f / lt;
  float sq = 0.f;
  u16* orow = Oout + (size_t)(wid * 32 + l31) * 2048;
#pragma unroll
  for (int dt = 0; dt < 4; ++dt)
#pragma unroll
    for (int g4 = 0; g4 < 4; ++g4) {
      const float v0 = oacc[dt][4 * g4 + 0] * inv, v1 = oacc[dt][4 * g4 + 1] * inv;
      const float v2 = oacc[dt][4 * g4 + 2] * inv, v3 = oacc[dt][4 * g4 + 3] * inv;
      sq += v0 * v0 + v1 * v1 + v2 * v2 + v3 * v3;
      u32x2 w = {pack2bf(v0, v1), pack2bf(v2, v3)};
      *(u32x2*)(orow + dt * 32 + 8 * g4 + 4 * hh) = w;
    }
  sq += __shfl_xor(sq, 32);
  if (hh == 0) ssq_out[(size_t)(wid * 32 + l31) * 16] = sq;
}

DI void phase_mix(const Params& p, int L, char* smem) {
  for (int w = obid(); w < 256; w += gridDim.x) {
    const int b = w >> 6, rem = w & 63, rg = rem >> 2, hb = rem & 3;
    const int r0 = rg * 4;
    const int t0 = min(max(r0 - 4, 0), 56), t1 = min(max(r0 - 1, 0), 56) + 8;
    const size_t tok0 = (size_t)b * 4096 + r0 * 64;
    attn_block<128, 1>(smem, p.h() + tok0 * HLD + 1536 + hb * 128, HLD, p.h() + (size_t)b * 4096 * HLD + 2048 + hb * 128, HLD,
                       p.vtB() + (size_t)(b * 4 + hb) * 128 * 4096, t0, t1, r0 * 64, 0.f, 0.f,
                       p.b_rel + (size_t)L * 4 * 465 + hb * 465, p.o() + tok0 * 2048 + 1024 + hb * 128, p.ssqh() + tok0 * 16 + 8 + hb);
  }
  for (int ww = obid(); ww < 512; ww += gridDim.x) {
    const int b = ww >> 7, rem = ww & 127, sb = rem >> 3, hq = rem & 7;
    const int t0 = max(0, 4 * sb - 2), t1 = min(64, 4 * sb + 6);
    const size_t tok0 = (size_t)b * 4096 + sb * 256;
    const float slope2 = exp2f(-(float)(hq + 1)) * LOG2E;
    const float sink2 = p.a_sink[L * 8 + hq] * LOG2E;
    attn_block<128, 0>(smem, p.h() + tok0 * HLD + hq * 128, HLD, p.h() + (size_t)b * 4096 * HLD + 1024 + (hq >> 2) * 128, HLD,
                       p.vtA() + (size_t)(b * 2 + (hq >> 2)) * 128 * 4096, t0, t1, sb * 256, slope2, sink2, nullptr,
                       p.o() + tok0 * 2048 + hq * 128, p.ssqh() + tok0 * 16 + hq);
  }
  for (int w = (obid() + 64) % gridDim.x; w < 192; w += gridDim.x) tile_upq(p, L, w, smem);
  for (int w = obid(); w < 256; w += gridDim.x) tile_upkv(p, L, w, smem);
}

DI void phase_mla(const Params& p, char* smem) {
  const int nbx = gridDim.x >> 3;
  for (int li = obid() >> 3; li < 32; li += nbx) {
    const int pair = (obid() & 7) * 2 + (li >> 4), nq = li & 15;
    const int b = pair >> 2, hc = pair & 3;
    const size_t tok0 = (size_t)b * 4096 + nq * 256;
    attn_block<192, 2>(smem, p.qmla() + ((size_t)(b * 4 + hc) * 4096 + nq * 256) * 192, 192, p.kmla() + (size_t)(b * 4 + hc) * 4096 * 192, 192,
                       p.vtC() + (size_t)(b * 4 + hc) * 128 * 4096, 0, 64, nq * 256, 0.f, 0.f, nullptr,
                       p.o() + tok0 * 2048 + 1536 + hc * 128, p.ssqh() + tok0 * 16 + 12 + hc, p.ropeC());
  }
}

DI void phase_onorm(const Params& p) {
  const int lane = otid() & 63, wid = otid() >> 6;
  for (int row = obid() * NWAVE + wid; row < T; row += gridDim.x * NWAVE) {
    const float4* sp = (const float4*)(p.ssqh() + (size_t)row * 16);
    const float4 a0 = sp[0], a1 = sp[1], b0 = sp[2], c0 = sp[3];
    const float rA = rsqrtf((a0.x + a0.y + a0.z + a0.w + a1.x + a1.y + a1.z + a1.w) * (1.f / 1024.f) + EPS);
    const float rB = rsqrtf((b0.x + b0.y + b0.z + b0.w) * (1.f / 512.f) + EPS);
    const float rC = rsqrtf((c0.x + c0.y + c0.z + c0.w) * (1.f / 512.f) + EPS);
#pragma unroll
    for (int j = 0; j < 4; ++j) {
      const float sc = (j < 2) ? rA : (j == 2 ? rB : rC);
      const size_t off = (size_t)row * 2048 + j * 512 + lane * 8;
      u32x4 w = *(const u32x4*)(p.o() + off);
      w.x = pack2bf(bf_lo(w.x) * sc, bf_hi(w.x) * sc);
      w.y = pack2bf(bf_lo(w.y) * sc, bf_hi(w.y) * sc);
      w.z = pack2bf(bf_lo(w.z) * sc, bf_hi(w.z) * sc);
      w.w = pack2bf(bf_lo(w.w) * sc, bf_hi(w.w) * sc);
      *(u32x4*)(p.on() + off) = w;
    }
  }
}

DI u32 ordkey(float s) {
  const u32 u = __float_as_uint(s);
  return u ^ ((u >> 31) ? 0xFFFFFFFFu : 0x80000000u);
}
DI float unord(u32 k) {
  const u32 u = (k & 0x80000000u) ? (k ^ 0x80000000u) : ~k;
  return __uint_as_float(u);
}
DI void insert16(u32 (&Ls)[16], u32 key) {
#pragma unroll
  for (int q = 0; q < 16; ++q) {
    const u32 hi = max(Ls[q], key);
    key = min(Ls[q], key);
    Ls[q] = hi;
  }
}

DI void phase_select(const Params& p, int L, char* smem) {
  float* sS = (float*)smem;
  u32* sTop = (u32*)(smem + 256 * 132 * 4);
  const int tid = otid(), lane = tid & 63, wid = tid >> 6, hh = lane >> 5, l31 = lane & 31;
  const int rt = wid >> 1, c = wid & 1;
  const u16* kb = p.keys_b() + (size_t)L * 256 * 128;
  for (int it = obid(); it < 1024; it += gridDim.x) {
    f32x16 sc[4];
    {
      const u16* qrow = p.pq() + ((size_t)it * 128 + rt * 32 + l31) * 128 + c * 64 + hh * 8;
      bf16x8 qa[4];
#pragma unroll
      for (int ks = 0; ks < 4; ++ks) qa[ks] = *(const bf16x8*)(qrow + ks * 16);
#pragma unroll
      for (int ct = 0; ct < 4; ++ct) {
#pragma unroll
        for (int r = 0; r < 16; ++r) sc[ct][r] = 0.f;
        const u16* krow = kb + (size_t)(c * 128 + ct * 32 + l31) * 128 + c * 64 + hh * 8;
#pragma unroll
        for (int ks = 0; ks < 4; ++ks) {
          const bf16x8 kf = *(const bf16x8*)(krow + ks * 16);
          sc[ct] = MFMA32(qa[ks], kf, sc[ct]);
        }
      }
    }
    __syncthreads();
#pragma unroll
    for (int ct = 0; ct < 4; ++ct)
#pragma unroll
      for (int r = 0; r < 16; ++r) sS[((rt * 32 + crow(r, hh)) * 2 + c) * 132 + ct * 32 + l31] = sc[ct][r];
    __syncthreads();
    {
      const int combo = tid >> 1, half = tid & 1;
      u32 Ls[16];
#pragma unroll
      for (int q = 0; q < 16; ++q) Ls[q] = 0u;
      const float* sp = sS + combo * 132 + half * 64;
      for (int n4 = 0; n4 < 16; ++n4) {
        const int n4r = (n4 + half * 8) & 15;
        const float4 v = *(const float4*)(sp + n4r * 4);
        const int nb = half * 64 + n4r * 4;
        insert16(Ls, (ordkey(v.x) & ~0x7Fu) | (u32)(127 - (nb + 0)));
        insert16(Ls, (ordkey(v.y) & ~0x7Fu) | (u32)(127 - (nb + 1)));
        insert16(Ls, (ordkey(v.z) & ~0x7Fu) | (u32)(127 - (nb + 2)));
        insert16(Ls, (ordkey(v.w) & ~0x7Fu) | (u32)(127 - (nb + 3)));
      }
      u32 Ms[16];
#pragma unroll
      for (int q = 0; q < 16; ++q) {
        const u32 other = (u32)__shfl_xor((int)Ls[15 - q], 1);
        Ms[q] = max(Ls[q], other);
      }
#pragma unroll
      for (int span = 8; span >= 1; span >>= 1)
#pragma unroll
        for (int q = 0; q < 16; ++q)
          if ((q & span) == 0) {
            const u32 hi = max(Ms[q], Ms[q + span]), lo = min(Ms[q], Ms[q + span]);
            Ms[q] = hi;
            Ms[q + span] = lo;
          }
      if (half == 0) {
#pragma unroll
        for (int q = 0; q < 16; ++q) sTop[combo * 16 + q] = Ms[q];
      }
    }
    __syncthreads();
    if (tid < 128) {
      const u32* t0 = sTop + (tid * 2) * 16;
      const u32* t1 = sTop + (tid * 2 + 1) * 16;
      float s0[16], s1[16];
#pragma unroll
      for (int q = 0; q < 16; ++q) {
        s0[q] = unord(t0[q] & ~0x7Fu);
        s1[q] = unord(t1[q] & ~0x7Fu);
      }
      u32 M[16];
#pragma unroll
      for (int q = 0; q < 16; ++q) M[q] = 0u;
#pragma unroll
      for (int i = 0; i < 16; ++i)
#pragma unroll
        for (int j = 0; j < 16; ++j)
          if ((i + 1) * (j + 1) <= 16) {
            const float sm = s0[i] + s1[j];
            insert16(M, (ordkey(sm) & ~0xFFu) | (u32)(255 - (i * 16 + j)));
          }
      const float mxv = unord(M[0] & ~0xFFu);
      float e[16], sum = 0.f;
#pragma unroll
      for (int q = 0; q < 16; ++q) {
        e[q] = __expf(unord(M[q] & ~0xFFu) - mxv);
        sum += e[q];
      }
      const float inv = 1.f / sum;
      const size_t row = (size_t)it * 128 + tid;
#pragma unroll
      for (int q = 0; q < 16; ++q) {
        const int ij = 255 - (int)(M[q] & 0xFFu);
        const int n0 = 127 - (int)(t0[ij >> 4] & 0x7Fu);
        const int n1 = 127 - (int)(t1[ij & 15] & 0x7Fu);
        p.idx()[row * 16 + q] = n0 * 128 + n1;
        p.g()[row * 16 + q] = e[q] * inv;
      }
    }
  }
}

DI float dot32(u32x4 w, const float2_t* xn2) {
  float2_t s = {0.f, 0.f};
#pragma unroll
  for (int c = 0; c < 4; ++c) {
    s = __builtin_elementwise_fma(__builtin_amdgcn_cvt_scalef32_pk_f32_fp4(w[c], 1.0f, 0), xn2[4 * c + 0], s);
    s = __builtin_elementwise_fma(__builtin_amdgcn_cvt_scalef32_pk_f32_fp4(w[c], 1.0f, 1), xn2[4 * c + 1], s);
    s = __builtin_elementwise_fma(__builtin_amdgcn_cvt_scalef32_pk_f32_fp4(w[c], 1.0f, 2), xn2[4 * c + 2], s);
    s = __builtin_elementwise_fma(__builtin_amdgcn_cvt_scalef32_pk_f32_fp4(w[c], 1.0f, 3), xn2[4 * c + 3], s);
  }
  return s.x + s.y;
}
DI void axpy32(u32x4 w, float a, float2_t* y2) {
  const float2_t a2 = {a, a};
#pragma unroll
  for (int c = 0; c < 4; ++c) {
    y2[4 * c + 0] = __builtin_elementwise_fma(__builtin_amdgcn_cvt_scalef32_pk_f32_fp4(w[c], 1.0f, 0), a2, y2[4 * c + 0]);
    y2[4 * c + 1] = __builtin_elementwise_fma(__builtin_amdgcn_cvt_scalef32_pk_f32_fp4(w[c], 1.0f, 1), a2, y2[4 * c + 1]);
    y2[4 * c + 2] = __builtin_elementwise_fma(__builtin_amdgcn_cvt_scalef32_pk_f32_fp4(w[c], 1.0f, 2), a2, y2[4 * c + 2]);
    y2[4 * c + 3] = __builtin_elementwise_fma(__builtin_amdgcn_cvt_scalef32_pk_f32_fp4(w[c], 1.0f, 3), a2, y2[4 * c + 3]);
  }
}
DI float gelu_tanh(float a) {
  const float u = 0.7978845608028654f * (a + 0.044715f * a * a * a);
  return 0.5f * a * (1.f + tanhf(u));
}

DI void phase_gather(const Params& p, int L, bool last) {
  const int wid = otid() >> 6;
  const unsigned char* U = p.ub() + (size_t)L * NEXP * 1024;
  const unsigned char* V = p.vb() + (size_t)L * NEXP * 1024;
  const float* ln2 = p.ln2 + L * 2048;
  int ni0 = 0, ni1 = 0;
  float ng0 = 0.f, ng1 = 0.f;
  {
    const int t0 = obid() * NWAVE + wid, l0 = otid() & 63;
    if (t0 < T) {
      ni0 = p.idx()[(size_t)t0 * 128 + l0]; ni1 = p.idx()[(size_t)t0 * 128 + 64 + l0];
      ng0 = p.g()[(size_t)t0 * 128 + l0];   ng1 = p.g()[(size_t)t0 * 128 + 64 + l0];
    }
  }
  for (int t = obid() * NWAVE + wid; t < T; t += gridDim.x * NWAVE) {
    const int lane = otid() & 63;
    const u16* xr = p.xb() + (size_t)t * 2048;
    float2_t xn2[16];
    float ss = 0.f;
    u32x4 xkeep[4];
#pragma unroll
    for (int c8 = 0; c8 < 4; ++c8) {
      const u32x4 a = *(const u32x4*)(xr + lane * 32 + c8 * 8);
      xkeep[c8] = a;
      xn2[c8 * 4 + 0] = float2_t{bf_lo(a.x), bf_hi(a.x)};
      xn2[c8 * 4 + 1] = float2_t{bf_lo(a.y), bf_hi(a.y)};
      xn2[c8 * 4 + 2] = float2_t{bf_lo(a.z), bf_hi(a.z)};
      xn2[c8 * 4 + 3] = float2_t{bf_lo(a.w), bf_hi(a.w)};
    }
#pragma unroll
    for (int e = 0; e < 16; ++e) ss += xn2[e].x * xn2[e].x + xn2[e].y * xn2[e].y;
    ss = wave_sum(ss);
    const float rstd = rsqrtf(ss * (1.f / 2048.f) + EPS) * (1.f / U_SCALE);
#pragma unroll
    for (int c4 = 0; c4 < 8; ++c4) {
      const float4 a = *(const float4*)(ln2 + lane * 32 + c4 * 4);
      xn2[c4 * 2 + 0] *= float2_t{rstd * a.x, rstd * a.y};
      xn2[c4 * 2 + 1] *= float2_t{rstd * a.z, rstd * a.w};
    }
    const int i0 = ni0, i1 = ni1;
    const float g0 = ng0, g1 = ng1;
    float a0 = 0.f, a1 = 0.f;
#pragma unroll
    for (int half = 0; half < 2; ++half) {
      const int iv = half ? i1 : i0;
      float av = 0.f;
#pragma unroll 1
      for (int k0 = 0; k0 < 64; k0 += 16) {
        u32x4 w[16];
#pragma unroll
        for (int q = 0; q < 16; ++q) {
          const int row = __builtin_amdgcn_readlane(iv, k0 + q);
          w[q] = *(const u32x4*)(U + (size_t)row * 1024 + lane * 16);
        }
        float d[16];
#pragma unroll
        for (int q = 0; q < 16; ++q) {
          __builtin_amdgcn_sched_barrier(0);
          if (q > 0) asm volatile("" : "+v"(w[q]), "+v"(d[q - 1]));
          d[q] = dot32(w[q], xn2);
        }
        __builtin_amdgcn_sched_barrier(0);
        {
          const bool b5 = (lane & 32) != 0, b4 = (lane & 16) != 0, b3 = (lane & 8) != 0, b2 = (lane & 4) != 0;
          float e8[8], e4[4], e2[2], e1;
#pragma unroll
          for (int j = 0; j < 8; ++j) {
            const float snd = b5 ? d[j] : d[j + 8];
            const float kep = b5 ? d[j + 8] : d[j];
            e8[j] = kep + __shfl_xor(snd, 32);
          }
#pragma unroll
          for (int j = 0; j < 4; ++j) {
            const float snd = b4 ? e8[j] : e8[j + 4];
            const float kep = b4 ? e8[j + 4] : e8[j];
            e4[j] = kep + __shfl_xor(snd, 16);
          }
#pragma unroll
          for (int j = 0; j < 2; ++j) {
            const float snd = b3 ? e4[j] : e4[j + 2];
            const float kep = b3 ? e4[j + 2] : e4[j];
            e2[j] = kep + __shfl_xor(snd, 8);
          }
          {
            const float snd = b2 ? e2[0] : e2[1];
            const float kep = b2 ? e2[1] : e2[0];
            e1 = kep + __shfl_xor(snd, 4);
          }
          e1 += __shfl_xor(e1, 2);
          e1 += __shfl_xor(e1, 1);
          const float got = __shfl(e1, ((lane - k0) & 15) * 4);
          if (lane >= k0 && lane < k0 + 16) av = got;
        }
      }
      if (half) a1 = av; else a0 = av;
    }
    const float hs0 = gelu_tanh(a0) * g0 * (1.f / V_SCALE), hs1 = gelu_tanh(a1) * g1 * (1.f / V_SCALE);
    {
      const int tn = t + gridDim.x * NWAVE;
      if (tn < T) {
        ni0 = p.idx()[(size_t)tn * 128 + lane]; ni1 = p.idx()[(size_t)tn * 128 + 64 + lane];
        ng0 = p.g()[(size_t)tn * 128 + lane];   ng1 = p.g()[(size_t)tn * 128 + 64 + lane];
      }
    }
    float2_t y2[16];
#pragma unroll
    for (int e = 0; e < 16; ++e) y2[e] = float2_t{0.f, 0.f};
#pragma unroll
    for (int half = 0; half < 2; ++half) {
      const int iv = half ? i1 : i0;
      const int hv = __float_as_int(half ? hs1 : hs0);
#pragma unroll 1
      for (int k0 = 0; k0 < 64; k0 += 8) {
        u32x4 w[8];
        float wq[8];
#pragma unroll
        for (int q = 0; q < 8; ++q) {
          const int row = __builtin_amdgcn_readlane(iv, k0 + q);
          wq[q] = __int_as_float(__builtin_amdgcn_readlane(hv, k0 + q));
          w[q] = *(const u32x4*)(V + (size_t)row * 1024 + lane * 16);
        }
#pragma unroll
        for (int q = 0; q < 8; ++q) {
          __builtin_amdgcn_sched_barrier(0);
          asm volatile("" : "+v"(w[q]), "+v"(y2[0]), "+v"(y2[8]));
          axpy32(w[q], wq[q], y2);
        }
        __builtin_amdgcn_sched_barrier(0);
      }
    }
    int t2 = t;
    asm volatile("" : "+v"(t2));
    const int lane2 = otid() & 63;
#pragma unroll
    for (int c8 = 0; c8 < 4; ++c8) {
      const u32x4 a = xkeep[c8];
      y2[c8 * 4 + 0] += float2_t{bf_lo(a.x), bf_hi(a.x)};
      y2[c8 * 4 + 1] += float2_t{bf_lo(a.y), bf_hi(a.y)};
      y2[c8 * 4 + 2] += float2_t{bf_lo(a.z), bf_hi(a.z)};
      y2[c8 * 4 + 3] += float2_t{bf_lo(a.w), bf_hi(a.w)};
    }
    if (!last) {
#pragma unroll
      for (int c8 = 0; c8 < 4; ++c8) {
        const float2_t* yy = y2 + c8 * 4;
        u32x4 w = {pack2bf(yy[0].x, yy[0].y), pack2bf(yy[1].x, yy[1].y), pack2bf(yy[2].x, yy[2].y), pack2bf(yy[3].x, yy[3].y)};
        *(u32x4*)(p.xb() + (size_t)t2 * 2048 + lane2 * 32 + c8 * 8) = w;
      }
    } else {
      float ss2 = 0.f;
#pragma unroll
      for (int e = 0; e < 16; ++e) ss2 += y2[e].x * y2[e].x + y2[e].y * y2[e].y;
      ss2 = wave_sum(ss2);
      const float r2 = rsqrtf(ss2 * (1.f / 2048.f) + EPS);
      float* orow = p.out + (size_t)t2 * 2048;
#pragma unroll
      for (int c4 = 0; c4 < 8; ++c4) {
        const float4 a = *(const float4*)(p.fnorm + lane2 * 32 + c4 * 4);
        *(float4*)(orow + lane2 * 32 + c4 * 4) =
            float4{y2[c4 * 2].x * r2 * a.x, y2[c4 * 2].y * r2 * a.y, y2[c4 * 2 + 1].x * r2 * a.z, y2[c4 * 2 + 1].y * r2 * a.w};
      }
    }
  }
}


#define XB_TMO      128
#define XB_XCNT(j)  (256  + 64 * (j))
#define XB_XSUB(j)  (1280 + 64 * (j))
#define XB_XGEN(j)  (2304 + 64 * (j))
#define XB_TOP      3328
#define XB_TOPGEN   3392
#define XCD_BAR_WORDS 3456
#define XB_SPIN_CAP (1u << 18)
#define LAS __attribute__((address_space(3)))
DI unsigned xb_ld(unsigned* p) { return __hip_atomic_load(p, __ATOMIC_RELAXED, __HIP_MEMORY_SCOPE_AGENT); }
DI unsigned xb_add(unsigned* p, unsigned v) { return __hip_atomic_fetch_add(p, v, __ATOMIC_RELAXED, __HIP_MEMORY_SCOPE_AGENT); }
DI unsigned xb_xcc_id() { return (unsigned)__builtin_amdgcn_s_getreg((3 << 11) | 20) & 0xFu; }
#define XB_SPIN(cond, bar) do { unsigned _sp = 0; while (cond) { __builtin_amdgcn_s_sleep(1); \
    if ((++_sp & 255u) == 0u) { if (xb_ld(&(bar)[XB_TMO])) break; if (_sp > XB_SPIN_CAP) { atomicAdd(&(bar)[XB_TMO], 1u); break; } } } } while (0)
struct XcdBarrier { unsigned* bar; unsigned x; volatile LAS unsigned* st; };
DI XcdBarrier xcd_barrier_post(unsigned* bar, volatile LAS unsigned* st) {
  XcdBarrier b; b.bar = bar; b.x = xb_xcc_id(); b.st = st;
  if (threadIdx.x == 0) (void)xb_add(&bar[XB_XCNT(b.x)], 1u);
  return b;
}
DI void xcd_barrier_complete(unsigned* bar, unsigned x, unsigned& nloc, unsigned& nx) {
  const unsigned G = gridDim.x * gridDim.y * gridDim.z;
  unsigned sum, cnt, mine, sp = 0u;
  for (;;) {
    sum = 0u; cnt = 0u; mine = 0u;
#pragma unroll
    for (unsigned j = 0; j < 16; ++j) { const unsigned c = xb_ld(&bar[XB_XCNT(j)]); sum += c; cnt += (c > 0u) ? 1u : 0u; mine = (j == x) ? c : mine; }
    if (sum == G) break;
    __builtin_amdgcn_s_sleep(1);
    if ((++sp & 255u) == 0u) { if (xb_ld(&bar[XB_TMO])) break; if (sp > XB_SPIN_CAP) { atomicAdd(&bar[XB_TMO], 1u); break; } }
  }
  nloc = mine > 0u ? mine : 1u; nx = cnt > 0u ? cnt : 1u;
}
DI void xcd_barrier(const XcdBarrier& b) {
  asm volatile("s_waitcnt vmcnt(0)" ::: "memory");
  __syncthreads();
  if (threadIdx.x == 0) {
    unsigned* bar = b.bar;
    __builtin_amdgcn_s_waitcnt(0);
    unsigned nloc = b.st[0], nx = b.st[1];
    if (nloc == 0u) { xcd_barrier_complete(bar, b.x, nloc, nx); b.st[0] = nloc; b.st[1] = nx; }
    const unsigned old = xb_add(&bar[XB_XSUB(b.x)], 1u);
    const unsigned gen = old / nloc;
    if (old + 1u == (gen + 1u) * nloc) {
      __builtin_amdgcn_fence(__ATOMIC_RELEASE, "agent");
      asm volatile("s_waitcnt vmcnt(0)" ::: "memory");
      const unsigned og = xb_add(&bar[XB_TOP], 1u);
      const unsigned tg = og / nx;
      if (og + 1u == (tg + 1u) * nx) xb_add(&bar[XB_TOPGEN], 1u);
      else XB_SPIN(xb_ld(&bar[XB_TOPGEN]) == tg, bar);
      __builtin_amdgcn_fence(__ATOMIC_ACQUIRE, "agent");
      xb_add(&bar[XB_XGEN(b.x)], 1u);
      asm volatile("s_waitcnt vmcnt(0)" ::: "memory");
    } else {
      XB_SPIN(xb_ld(&bar[XB_XGEN(b.x)]) == gen, bar);
      __builtin_amdgcn_fence(__ATOMIC_ACQUIRE, "agent");
      asm volatile("s_waitcnt vmcnt(0)" ::: "memory");
    }
  }
  __syncthreads();
}

#define KDEF(name, body)                                                       \
  __global__ void __launch_bounds__(512) name(Params p, int L) {            \
    __shared__ __attribute__((aligned(16))) char smem[SMEM_BYTES];             \
    body;                                                                      \
  }
#if !MEGA
KDEF(k_prologue, phase_prologue(p, smem))
KDEF(k_gemm1, phase_gemm1(p, L, smem))
KDEF(k_mix, phase_mix(p, L, smem))
KDEF(k_mla, phase_mla(p, smem))
KDEF(k_onorm, phase_onorm(p))
KDEF(k_gemm_o, phase_gemm_o(p, L, smem))
KDEF(k_gemm_pq, phase_gemm_pq(p, L, smem))
KDEF(k_scores, phase_gemm_scores(p, L, smem))
KDEF(k_select, phase_select(p, L, smem))
KDEF(k_gather, phase_gather(p, L, L == 1))
#else
#ifndef PROBE_MASK
#define PROBE_MASK 0
#endif
#define RUN(bit, call)                         \
  call;                                        \
  if (PROBE_MASK & (bit)) {                    \
    grid.sync();                               \
    call;                                      \
  }
__global__ void __launch_bounds__(512) mega_coop(Params p) {
  __shared__ __attribute__((aligned(16))) char smem[SMEM_BYTES];
  __shared__ uint4 xb_words;
  cg::grid_group grid = cg::this_grid();
  if (threadIdx.x == 0) xb_words = make_uint4(0u, 0u, 0u, 0u);
  __syncthreads();
  const XcdBarrier xb = xcd_barrier_post((unsigned*)(p.ws + WS_NEED), (volatile LAS unsigned*)&xb_words);
#define GSYNC xcd_barrier(xb)
  RUN(256, phase_prologue(p, smem))
  if (p.ws == nullptr) grid.sync();
  GSYNC;
#pragma unroll 1
  for (int L = 0; L < 2; ++L) {
    phase_gemm1(p, L, smem);
    GSYNC;
    phase_mix(p, L, smem);
    GSYNC;
    phase_mla(p, smem);
    GSYNC;
    phase_gemm_o(p, L, smem);
    GSYNC;
    phase_gemm_pq(p, L, smem);
    GSYNC;
    phase_select(p, L, smem);
    GSYNC;
    phase_gather(p, L, L == 1);
    if (L == 0) GSYNC;
  }
}
#endif

extern "C" void kernel_launch(void* const* d_in, const int* in_sizes, int n_in, void* d_out, int out_size, void* d_ws,
                              size_t ws_size, hipStream_t stream) {
  Params p{};
  p.x = (const float*)d_in[0]; p.ln1 = (const float*)d_in[1]; p.w_in = (const float*)d_in[2]; p.a_sink = (const float*)d_in[3];
  p.b_rel = (const float*)d_in[4]; p.cqn = (const float*)d_in[5]; p.ckvn = (const float*)d_in[6]; p.wuq = (const float*)d_in[7];
  p.wukv = (const float*)d_in[8]; p.onorm = (const float*)d_in[9]; p.wo = (const float*)d_in[10]; p.ln2 = (const float*)d_in[11];
  p.pwq = (const float*)d_in[12]; p.pkeys = (const float*)d_in[13]; p.pu = (const float*)d_in[14]; p.pv = (const float*)d_in[15];
  p.fnorm = (const float*)d_in[16];
  p.out = (float*)d_out;
  p.ws = (char*)d_ws;
  if (WS_NEED + XCD_BAR_WORDS * sizeof(unsigned) > ws_size) { fprintf(stderr, "kernel_launch: workspace too small (%zu > %zu)\n", (size_t)WS_NEED, ws_size); return; }

#if MEGA
  static int grid_blocks = 0;
  if (!grid_blocks) {
    int dev = 0, cus = 0, per_cu = 0;
    hipGetDevice(&dev);
    hipDeviceGetAttribute(&cus, hipDeviceAttributeMultiprocessorCount, dev);
    hipOccupancyMaxActiveBlocksPerMultiprocessor(&per_cu, mega_coop, NTHR, 0);
    if (per_cu > 1) per_cu = 1;
    if (per_cu < 1) per_cu = 1;
    grid_blocks = (cus * per_cu) & ~7;
  }
  (void)hipMemsetAsync(p.ws + WS_NEED, 0, XCD_BAR_WORDS * sizeof(unsigned), stream);
  void* args[] = {&p};
  hipError_t e = hipLaunchCooperativeKernel((void*)mega_coop, dim3(grid_blocks), dim3(NTHR), args, 0, stream);
  if (e != hipSuccess) fprintf(stderr, "cooperative launch failed: %s (grid %d)\n", hipGetErrorString(e), grid_blocks);
#else
  const dim3 g(256), b(NTHR);
  k_prologue<<<g, b, 0, stream>>>(p, 0);
  for (int L = 0; L < 2; ++L) {
    k_gemm1<<<g, b, 0, stream>>>(p, L);
    k_mix<<<g, b, 0, stream>>>(p, L);
    k_mla<<<g, b, 0, stream>>>(p, L);
    k_gemm_o<<<g, b, 0, stream>>>(p, L);
    k_gemm_pq<<<g, b, 0, stream>>>(p, L);
    k_select<<<g, b, 0, stream>>>(p, L);
    k_gather<<<g, b, 0, stream>>>(p, L);
  }
#endif
}
```

```cpp
#include <hip/hip_runtime.h>
#include <hip/hip_cooperative_groups.h>
#include <cstdio>
namespace cg = cooperative_groups;

#ifndef MEGA
#define MEGA 1
#endif

#define DI __device__ __forceinline__
typedef unsigned short u16;
typedef unsigned int u32;
using bf16x8 = __attribute__((ext_vector_type(8))) short;
using f32x16 = __attribute__((ext_vector_type(16))) float;
typedef __bf16 bf16x2_t __attribute__((ext_vector_type(2)));
typedef float float2_t __attribute__((ext_vector_type(2)));
typedef unsigned int u32x4 __attribute__((ext_vector_type(4)));
typedef unsigned int u32x2 __attribute__((ext_vector_type(2)));

constexpr int T = 16384, SEQ = 4096, DM = 2048, HLD = 4096;
constexpr int NTHR = 512, NWAVE = 8;
constexpr int NEXP = 16384;
constexpr float EPS = 1e-6f;
constexpr float LOG2E = 1.4426950408889634f;
constexpr float QSCALE_AB = 0.08838834764831845f * LOG2E;
constexpr float QSCALE_C = 0.07216878364870323f * LOG2E;
constexpr float U_SCALE = 90.5f, V_SCALE = 8.f;
constexpr int LDT = 72;
constexpr int GEMM_STAGE = 512 * LDT;
constexpr int GEMM_SROW_OFF = 2 * GEMM_STAGE * 2;
constexpr int SMEM_BYTES = 256 * 132 * 4 + 256 * 16 * 4;

#define MFMA32(a, b, c) __builtin_amdgcn_mfma_f32_32x32x16_bf16((a), (b), (c), 0, 0, 0)

constexpr size_t al256(size_t x) { return (x + 255) & ~(size_t)255; }
constexpr size_t OFF_wt_in = 0;
constexpr size_t OFF_wt_o = OFF_wt_in + al256((size_t)2 * HLD * 2048 * 2);
constexpr size_t OFF_wt_pq = OFF_wt_o + al256((size_t)2 * 2048 * 2048 * 2);
constexpr size_t OFF_wt_uq = OFF_wt_pq + al256((size_t)2 * 1024 * 2048 * 2);
constexpr size_t OFF_wt_ukv = OFF_wt_uq + al256((size_t)2 * 768 * 512 * 2);
constexpr size_t OFF_keys_b = OFF_wt_ukv + al256((size_t)2 * 1024 * 256 * 2);
constexpr size_t OFF_ub = OFF_keys_b + al256((size_t)2 * 256 * 128 * 2);
constexpr size_t OFF_vb = OFF_ub + al256((size_t)2 * NEXP * 1024);
constexpr size_t OFF_ropeC = OFF_vb + al256((size_t)2 * NEXP * 1024);
constexpr size_t OFF_ropeS = OFF_ropeC + al256((size_t)SEQ * 32 * 4);
constexpr size_t OFF_xres = OFF_ropeS + al256((size_t)SEQ * 32 * 4);
constexpr size_t OFF_xb = OFF_xres + al256((size_t)T * 2048 * 4);
constexpr size_t OFF_h = OFF_xb + al256((size_t)T * 2048 * 2);
constexpr size_t OFF_vtA = OFF_h + al256((size_t)T * HLD * 2);
constexpr size_t OFF_vtB = OFF_vtA + al256((size_t)T * 256 * 2);
constexpr size_t OFF_kmla = OFF_vtB + al256((size_t)T * 512 * 2);
constexpr size_t OFF_vtC = OFF_kmla + al256((size_t)T * 4 * 192 * 2);
constexpr size_t OFF_qmla = OFF_vtC + al256((size_t)T * 512 * 2);
constexpr size_t OFF_o = OFF_qmla + al256((size_t)T * 4 * 192 * 2);
constexpr size_t OFF_on = OFF_o + al256((size_t)T * 2048 * 2);
constexpr size_t OFF_ssqh = OFF_on + al256((size_t)T * 2048 * 2);
constexpr size_t OFF_END1 = OFF_ssqh + al256((size_t)T * 16 * 4);
constexpr size_t OFF_pq = OFF_h;
constexpr size_t OFF_scores = OFF_pq + al256((size_t)T * 1024 * 2);
constexpr size_t OFF_idx = OFF_scores + al256((size_t)T * 8 * 256 * 4);
constexpr size_t OFF_g = OFF_idx + al256((size_t)T * 128 * 4);
constexpr size_t OFF_END2 = OFF_g + al256((size_t)T * 128 * 4);
constexpr size_t WS_NEED = OFF_END1 > OFF_END2 ? OFF_END1 : OFF_END2;

struct Params {
  const float *x, *ln1, *w_in, *a_sink, *b_rel, *cqn, *ckvn, *wuq, *wukv, *onorm, *wo, *ln2, *pwq, *pkeys, *pu, *pv, *fnorm;
  float* out;
  char* ws;
  DI u16* wt_in() const { return (u16*)(ws + OFF_wt_in); }
  DI u16* wt_o() const { return (u16*)(ws + OFF_wt_o); }
  DI u16* wt_pq() const { return (u16*)(ws + OFF_wt_pq); }
  DI u16* wt_uq() const { return (u16*)(ws + OFF_wt_uq); }
  DI u16* wt_ukv() const { return (u16*)(ws + OFF_wt_ukv); }
  DI u16* keys_b() const { return (u16*)(ws + OFF_keys_b); }
  DI unsigned char* ub() const { return (unsigned char*)(ws + OFF_ub); }
  DI unsigned char* vb() const { return (unsigned char*)(ws + OFF_vb); }
  DI float* ropeC() const { return (float*)(ws + OFF_ropeC); }
  DI float* ropeS() const { return (float*)(ws + OFF_ropeS); }
  DI float* xres() const { return (float*)(ws + OFF_xres); }
  DI u16* xb() const { return (u16*)(ws + OFF_xb); }
  DI u16* h() const { return (u16*)(ws + OFF_h); }
  DI u16* vtA() const { return (u16*)(ws + OFF_vtA); }
  DI u16* vtB() const { return (u16*)(ws + OFF_vtB); }
  DI u16* kmla() const { return (u16*)(ws + OFF_kmla); }
  DI u16* vtC() const { return (u16*)(ws + OFF_vtC); }
  DI u16* qmla() const { return (u16*)(ws + OFF_qmla); }
  DI u16* o() const { return (u16*)(ws + OFF_o); }
  DI u16* on() const { return (u16*)(ws + OFF_on); }
  DI float* ssqh() const { return (float*)(ws + OFF_ssqh); }
  DI u16* pq() const { return (u16*)(ws + OFF_pq); }
  DI float* scores() const { return (float*)(ws + OFF_scores); }
  DI int* idx() const { return (int*)(ws + OFF_idx); }
  DI float* g() const { return (float*)(ws + OFF_g); }
};

DI int otid() { int t = threadIdx.x; asm volatile("" : "+v"(t)); return t; }
DI int obid() { int b = blockIdx.x; asm volatile("" : "+s"(b)); return b; }
DI u16 f2bf(float x) {
  u32 u = __float_as_uint(x);
  u += 0x7fffu + ((u >> 16) & 1u);
  return (u16)(u >> 16);
}
DI u32 pack2bf(float a, float b) {
  float2_t f = {a, b};
  bf16x2_t r = __builtin_convertvector(f, bf16x2_t);
  return __builtin_bit_cast(u32, r);
}
DI float bf_lo(u32 w) { return __uint_as_float(w << 16); }
DI float bf_hi(u32 w) { return __uint_as_float(w & 0xffff0000u); }
DI int crow(int r, int h) { return (r & 3) + 8 * (r >> 2) + 4 * h; }
DI float wave_sum(float v) {
#pragma unroll
  for (int o = 32; o >= 1; o >>= 1) v += __shfl_xor(v, o);
  return v;
}
DI float ssq8(u32x4 w) {
  float s = 0.f, a;
  a = bf_lo(w.x); s += a * a; a = bf_hi(w.x); s += a * a;
  a = bf_lo(w.y); s += a * a; a = bf_hi(w.y); s += a * a;
  a = bf_lo(w.z); s += a * a; a = bf_hi(w.z); s += a * a;
  a = bf_lo(w.w); s += a * a; a = bf_hi(w.w); s += a * a;
  return s;
}
DI bool gemm_tile_map(int it, int MT, int NT, int& mt, int& nt) {
  const int b = obid(), x = b & 7, nb = gridDim.x >> 3;
  const int li = it * nb + (b >> 3);
  const int nrn = (NT + 7) >> 3, nrect = (MT >> 3) * nrn;
  const int q = x + 8 * (li >> 6);
  if (q >= nrect) { mt = -1; nt = 0; return false; }
  const int in = li & 63;
  mt = (q / nrn) * 8 + (in >> 3);
  nt = (q % nrn) * 8 + (in & 7);
  return nt < NT;
}

constexpr int GM = 256, GN = 256;
DI u32x4 scale8(u32x4 w, float sc) {
  w.x = pack2bf(bf_lo(w.x) * sc, bf_hi(w.x) * sc);
  w.y = pack2bf(bf_lo(w.y) * sc, bf_hi(w.y) * sc);
  w.z = pack2bf(bf_lo(w.z) * sc, bf_hi(w.z) * sc);
  w.w = pack2bf(bf_lo(w.w) * sc, bf_hi(w.w) * sc);
  return w;
}
template <bool ROWNORM, bool CONV = false, bool ASCALE = false>
DI void gemm_mainloop(const u16* __restrict__ Ag, int lda, const u16* __restrict__ Bg, int ldb, int K, char* smem,
                      f32x16 (&acc)[4][2], const float4* __restrict__ csrc = nullptr, u16* __restrict__ cdst = nullptr,
                      float cscale = 1.f) {
  u16* sbase = (u16*)smem;
  float* sRow = (float*)(smem + GEMM_SROW_OFF);
  const int tid = otid(), lane = tid & 63, wid = tid >> 6;
  const int wm = wid >> 2, wn = wid & 3, hh = lane >> 5, l31 = lane & 31;
  const int lr = tid >> 3, lc = (tid & 7) * 8;
#pragma unroll
  for (int i = 0; i < 4; ++i)
#pragma unroll
    for (int j = 0; j < 2; ++j)
#pragma unroll
      for (int r = 0; r < 16; ++r) acc[i][j][r] = 0.f;
  u32x4 ra[4], rb[4];
  float ssq[4] = {0.f, 0.f, 0.f, 0.f};
  const u16* ap = Ag + (size_t)lr * lda + lc;
  const u16* bp = Bg + (size_t)lr * ldb + lc;
#pragma unroll
  for (int i = 0; i < 4; ++i) {
    ra[i] = *(const u32x4*)(ap + (size_t)(64 * i) * lda);
    rb[i] = *(const u32x4*)(bp + (size_t)(64 * i) * ldb);
  }
  __syncthreads();
#pragma unroll
  for (int i = 0; i < 4; ++i) {
    if (ASCALE) ra[i] = scale8(ra[i], sRow[(lr + 64 * i) * 4 + 0]);
    *(u32x4*)(sbase + (lr + 64 * i) * LDT + lc) = ra[i];
    *(u32x4*)(sbase + (256 + lr + 64 * i) * LDT + lc) = rb[i];
    if (ROWNORM) ssq[i] += ssq8(ra[i]);
  }
  __syncthreads();
  const int nk = K >> 6;
#pragma unroll 1
  for (int kt = 0; kt < nk; ++kt) {
    const int cur = kt & 1;
    const bool more = (kt + 1 < nk);
    const int kn = more ? kt + 1 : kt;
    float4 cv;
    if (CONV) cv = csrc[(size_t)kt * NTHR + tid];
#pragma unroll
    for (int i = 0; i < 4; ++i) {
      ra[i] = *(const u32x4*)(ap + (size_t)(64 * i) * lda + kn * 64);
      rb[i] = *(const u32x4*)(bp + (size_t)(64 * i) * ldb + kn * 64);
    }
    const u16* a_s = sbase + cur * GEMM_STAGE + (wm * 128 + l31) * LDT + hh * 8;
    const u16* b_s = sbase + cur * GEMM_STAGE + (256 + wn * 64 + l31) * LDT + hh * 8;
#pragma unroll
    for (int ks = 0; ks < 4; ++ks) {
      const bf16x8 b0 = *(const bf16x8*)(b_s + ks * 16);
      const bf16x8 b1 = *(const bf16x8*)(b_s + 32 * LDT + ks * 16);
      bf16x8 a0[4];
#pragma unroll
      for (int i = 0; i < 4; ++i) a0[i] = *(const bf16x8*)(a_s + i * 32 * LDT + ks * 16);
      __builtin_amdgcn_s_setprio(1);
#pragma unroll
      for (int i = 0; i < 4; ++i) {
        acc[i][0] = MFMA32(a0[i], b0, acc[i][0]);
        acc[i][1] = MFMA32(a0[i], b1, acc[i][1]);
      }
      __builtin_amdgcn_s_setprio(0);
    }
    {
      u16* w = sbase + (cur ^ 1) * GEMM_STAGE;
      const int g = (kn < 16) ? 0 : (kn < 24 ? 1 : 2);
#pragma unroll
      for (int i = 0; i < 4; ++i) {
        if (ASCALE) ra[i] = scale8(ra[i], sRow[(lr + 64 * i) * 4 + g]);
        *(u32x4*)(w + (lr + 64 * i) * LDT + lc) = ra[i];
        *(u32x4*)(w + (256 + lr + 64 * i) * LDT + lc) = rb[i];
        if (ROWNORM) ssq[i] += more ? ssq8(ra[i]) : 0.f;
      }
    }
    if (CONV) {
      u32 w4 = 0;
      w4 = __builtin_amdgcn_cvt_scalef32_pk_fp4_f32(w4, cv.x * cscale, cv.y * cscale, 1.0f, 0);
      w4 = __builtin_amdgcn_cvt_scalef32_pk_fp4_f32(w4, cv.z * cscale, cv.w * cscale, 1.0f, 1);
      cdst[(size_t)kt * NTHR + tid] = (u16)w4;
    }
    __syncthreads();
  }
  if (ROWNORM) {
#pragma unroll
    for (int i = 0; i < 4; ++i) {
      float s = ssq[i];
      s += __shfl_xor(s, 1);
      s += __shfl_xor(s, 2);
      s += __shfl_xor(s, 4);
      if ((tid & 7) == 0) sRow[lr + 64 * i] = rsqrtf(s / (float)K + EPS);
    }
    __syncthreads();
  }
}

DI void conv_transpose_all(const Params& p, char* smem) {
  const int lane = otid() & 63, wid = otid() >> 6;
  float* s = (float*)smem + wid * (64 * 65);
  constexpr int T0 = 32 * 61, T1 = T0 + 32 * 32, T2 = T1 + 32 * 16, T3 = T2 + 8 * 12, T4 = T3 + 4 * 16;
  for (int f = obid() * NWAVE + wid; f < 2 * T4; f += gridDim.x * NWAVE) {
    const int L = f / T4, r = f % T4;
    const float* W; const float* g; u16* Wt; int K, N, tile;
    if (r < T0)      { W = p.w_in + (size_t)L * 2048 * 3904; g = p.ln1 + L * 2048;   Wt = p.wt_in() + (size_t)L * HLD * 2048;   K = 2048; N = 3904; tile = r; }
    else if (r < T1) { W = p.wo + (size_t)L * 2048 * 2048;   g = p.onorm + L * 2048; Wt = p.wt_o() + (size_t)L * 2048 * 2048;   K = 2048; N = 2048; tile = r - T0; }
    else if (r < T2) { W = p.pwq + (size_t)L * 2048 * 1024;  g = p.ln2 + L * 2048;   Wt = p.wt_pq() + (size_t)L * 1024 * 2048;  K = 2048; N = 1024; tile = r - T1; }
    else if (r < T3) { W = p.wuq + (size_t)L * 512 * 768;    g = p.cqn + L * 512;    Wt = p.wt_uq() + (size_t)L * 768 * 512;    K = 512;  N = 768;  tile = r - T2; }
    else             { W = p.wukv + (size_t)L * 256 * 1024;  g = p.ckvn + L * 256;   Wt = p.wt_ukv() + (size_t)L * 1024 * 256;  K = 256;  N = 1024; tile = r - T3; }
    const int ntn = N / 64;
    const int k0 = (tile / ntn) * 64, n0 = (tile % ntn) * 64;
#pragma unroll 8
    for (int kk = 0; kk < 64; ++kk) s[kk * 65 + lane] = W[(size_t)(k0 + kk) * N + n0 + lane] * g[k0 + kk];
    __builtin_amdgcn_fence(__ATOMIC_RELEASE, "wavefront");
    __builtin_amdgcn_wave_barrier();
    __builtin_amdgcn_fence(__ATOMIC_ACQUIRE, "wavefront");
#pragma unroll 8
    for (int nn = 0; nn < 64; ++nn) Wt[(size_t)(n0 + nn) * K + k0 + lane] = f2bf(s[lane * 65 + nn]);
    __builtin_amdgcn_fence(__ATOMIC_RELEASE, "wavefront");
    __builtin_amdgcn_wave_barrier();
    __builtin_amdgcn_fence(__ATOMIC_ACQUIRE, "wavefront");
  }
}
DI void conv_flat(const float* __restrict__ src, u16* __restrict__ dst, size_t n4) {
  for (size_t i = (size_t)obid() * NTHR + otid(); i < n4; i += (size_t)gridDim.x * NTHR) {
    float4 v = ((const float4*)src)[i];
    u32x2 w = {pack2bf(v.x, v.y), pack2bf(v.z, v.w)};
    ((u32x2*)dst)[i] = w;
  }
}
DI void conv_fp4(const float* __restrict__ src, unsigned char* __restrict__ dst, size_t n8, float sc) {
  for (size_t i = (size_t)obid() * NTHR + otid(); i < n8; i += (size_t)gridDim.x * NTHR) {
    const float4 a = ((const float4*)src)[i * 2 + 0], b = ((const float4*)src)[i * 2 + 1];
    u32 w = 0;
    w = __builtin_amdgcn_cvt_scalef32_pk_fp4_f32(w, a.x * sc, a.y * sc, 1.0f, 0);
    w = __builtin_amdgcn_cvt_scalef32_pk_fp4_f32(w, a.z * sc, a.w * sc, 1.0f, 1);
    w = __builtin_amdgcn_cvt_scalef32_pk_fp4_f32(w, b.x * sc, b.y * sc, 1.0f, 2);
    w = __builtin_amdgcn_cvt_scalef32_pk_fp4_f32(w, b.z * sc, b.w * sc, 1.0f, 3);
    ((u32*)dst)[i] = w;
  }
}
DI void phase_prologue(const Params& p, char* smem) {
  __syncthreads();
  conv_transpose_all(p, smem);
  for (int L = 0; L < 2; ++L) {
    u16* pad = p.wt_in() + (size_t)L * HLD * 2048 + (size_t)3904 * 2048;
    for (int i = obid() * NTHR + otid(); i < 192 * 2048 / 8; i += gridDim.x * NTHR) ((u32x4*)pad)[i] = u32x4{0, 0, 0, 0};
  }
  for (int i = obid() * NTHR + otid(); i < 2 * 256 * 128; i += gridDim.x * NTHR) {
    const int L = i >> 15, n = (i >> 7) & 255, k = i & 127;
    const int c = n >> 7, kin = k - 64 * c;
    const float v = (kin >= 0 && kin < 64) ? p.pkeys[((size_t)(L * 2 + c) * 128 + (n & 127)) * 64 + kin] : 0.f;
    p.keys_b()[i] = f2bf(v);
  }
  conv_flat(p.x, p.xb(), (size_t)T * 2048 / 4);
  for (int i = obid() * NTHR + otid(); i < SEQ * 32; i += gridDim.x * NTHR) {
    const int pos = i >> 5, f = i & 31;
    const float inv = powf(10000.0f, -(float)f / 32.0f);
    const float ang = (float)pos * inv;
    p.ropeC()[i] = cosf(ang);
    p.ropeS()[i] = sinf(ang);
  }
}

#define EPI_IDS                                                                                     \
  const int etid = otid();                                                                          \
  const int lane = etid & 63, wid = etid >> 6, wm = wid >> 2, wn = wid & 3, hh = lane >> 5, l31 = lane & 31;

constexpr int EPI_TS = 264;
#define EPI_LDS_WRITE(SCALE_EXPR)                                                             \
  {                                                                                           \
    u16* sT_ = (u16*)smem;                                                                    \
    _Pragma("unroll") for (int i = 0; i < 4; ++i)                                             \
      _Pragma("unroll") for (int j = 0; j < 2; ++j)                                           \
        _Pragma("unroll") for (int r = 0; r < 16; ++r) {                                      \
          const int rl = wm * 128 + i * 32 + crow(r, hh);                                     \
          sT_[rl * EPI_TS + wn * 64 + j * 32 + l31] = f2bf(acc[i][j][r] * (SCALE_EXPR));      \
        }                                                                                     \
    __syncthreads();                                                                          \
  }

DI void phase_gemm1(const Params& p, int L, char* smem) {
  const u16* Wt = p.wt_in() + (size_t)L * HLD * 2048;
  const float* sRow = (const float*)(smem + GEMM_SROW_OFF);
  for (int it = 0;; ++it) {
    int mt, nt;
    if (!gemm_tile_map(it, 64, 16, mt, nt)) { if (mt < 0) break; continue; }
    f32x16 acc[4][2];
    const int tile_id = mt * 16 + nt;
    const bool isv = tile_id >= 512;
    const float4* csrc = (const float4*)((isv ? p.pv : p.pu) + (size_t)L * NEXP * 2048) + (size_t)(tile_id & 511) * 32 * NTHR;
    u16* cdst = (u16*)((isv ? p.vb() : p.ub()) + (size_t)L * NEXP * 1024) + (size_t)(tile_id & 511) * 32 * NTHR;
    gemm_mainloop<true, true>(p.xb() + (size_t)mt * GM * 2048, 2048, Wt + (size_t)nt * GN * 2048, 2048, 2048, smem, acc, csrc, cdst,
                              isv ? V_SCALE : U_SCALE);
    EPI_IDS
    const int nt128 = nt * 2 + (wn >> 1), wn1 = wn & 1;
    const int m0 = mt * GM, b = m0 >> 12, s0 = m0 & 4095;
    const bool plain = (nt != 5) && (nt != 10) && (nt != 11) && (nt != 15);
    if (plain) {
      const float sc = (nt < 4 || nt == 6 || nt == 7) ? QSCALE_AB : 1.f;
      EPI_LDS_WRITE(sRow[rl] * sc)
      const u16* sT = (const u16*)smem;
#pragma unroll 4
      for (int it = 0; it < 16; ++it) {
        const int c = etid + NTHR * it, row = c >> 5, cc = c & 31;
        *(u32x4*)(p.h() + (size_t)(m0 + row) * HLD + nt * GN + cc * 8) = *(const u32x4*)(sT + row * EPI_TS + cc * 8);
      }
    } else {
    if (nt128 >= 30) {
      if (nt128 == 30 && wn1 == 0) {
#pragma unroll
        for (int i = 0; i < 4; ++i)
#pragma unroll
          for (int r = 0; r < 16; ++r) {
            const int rl = wm * 128 + i * 32 + crow(r, hh);
            const float rs = sRow[rl];
            const float x1 = acc[i][0][r] * rs, x2 = acc[i][1][r] * rs;
            const int pos = s0 + rl;
            const float c = p.ropeC()[pos * 32 + l31], sn = p.ropeS()[pos * 32 + l31];
            const u16 o1 = f2bf(x1 * c - x2 * sn), o2 = f2bf(x1 * sn + x2 * c);
#pragma unroll
            for (int hd = 0; hd < 4; ++hd) {
              u16* kr = p.kmla() + ((size_t)(b * 4 + hd) * 4096 + pos) * 192 + 128;
              kr[l31] = o1;
              kr[32 + l31] = o2;
            }
            if ((r & 3) == 3) __builtin_amdgcn_sched_barrier(0);
          }
      }
    } else if (nt128 == 10 || nt128 == 11 || (nt128 >= 20 && nt128 < 24)) {
      u16* vt;
      int nh, hd;
      if (nt128 < 12) { vt = p.vtA(); nh = 2; hd = nt128 - 10; } else { vt = p.vtB(); nh = 4; hd = nt128 - 20; }
#pragma unroll
      for (int i = 0; i < 4; ++i)
#pragma unroll
        for (int j = 0; j < 2; ++j)
#pragma unroll
          for (int g4 = 0; g4 < 4; ++g4) {
            const int rl0 = wm * 128 + i * 32 + 8 * g4 + 4 * hh;
            const int d = wn1 * 64 + j * 32 + l31;
            const float v0 = acc[i][j][4 * g4 + 0] * sRow[rl0 + 0], v1 = acc[i][j][4 * g4 + 1] * sRow[rl0 + 1];
            const float v2 = acc[i][j][4 * g4 + 2] * sRow[rl0 + 2], v3 = acc[i][j][4 * g4 + 3] * sRow[rl0 + 3];
            u32x2 w = {pack2bf(v0, v1), pack2bf(v2, v3)};
            *(u32x2*)(vt + ((size_t)(b * nh + hd) * 128 + d) * 4096 + s0 + rl0) = w;
          }
    } else {
      const float sc = (nt128 < 8 || (nt128 >= 12 && nt128 < 16)) ? QSCALE_AB : 1.f;
#pragma unroll
      for (int i = 0; i < 4; ++i)
#pragma unroll
        for (int j = 0; j < 2; ++j)
#pragma unroll
          for (int r = 0; r < 16; ++r) {
            const int rl = wm * 128 + i * 32 + crow(r, hh);
            p.h()[(size_t)(m0 + rl) * HLD + nt128 * 128 + wn1 * 64 + j * 32 + l31] = f2bf(acc[i][j][r] * sRow[rl] * sc);
          }
    }
    }
  }
}

DI void tile_upq(const Params& p, int L, int tile, char* smem) {
  const float* sRow = (const float*)(smem + GEMM_SROW_OFF);
  const int mt = tile / 3, nt = tile % 3;
  f32x16 acc[4][2];
  gemm_mainloop<true>(p.h() + (size_t)mt * GM * HLD + 3072, HLD, p.wt_uq() + (size_t)L * 768 * 512 + (size_t)nt * GN * 512, 512, 512,
                      smem, acc);
  EPI_IDS
  const int m0 = mt * GM, b = m0 >> 12, s0 = m0 & 4095;
  const int nb64 = nt * 4 + wn;
  const int head = nb64 / 3, part = nb64 % 3;
#pragma unroll
  for (int i = 0; i < 4; ++i)
#pragma unroll
    for (int j = 0; j < 2; ++j)
#pragma unroll
      for (int r = 0; r < 16; ++r) {
        const int rl = wm * 128 + i * 32 + crow(r, hh);
        const int pos = s0 + rl;
        p.qmla()[((size_t)(b * 4 + head) * 4096 + pos) * 192 + part * 64 + j * 32 + l31] = f2bf(acc[i][j][r] * sRow[rl] * QSCALE_C);
      }
}

DI void tile_upkv(const Params& p, int L, int tile, char* smem) {
  const float* sRow = (const float*)(smem + GEMM_SROW_OFF);
  const int mt = tile >> 2, nt = tile & 3;
  f32x16 acc[4][2];
  gemm_mainloop<true>(p.h() + (size_t)mt * GM * HLD + 3584, HLD, p.wt_ukv() + (size_t)L * 1024 * 256 + (size_t)nt * GN * 256, 256, 256,
                      smem, acc);
  EPI_IDS
  const int nt128 = nt * 2 + (wn >> 1), wn1 = wn & 1;
  const int m0 = mt * GM, b = m0 >> 12, s0 = m0 & 4095;
  const int head = nt128 >> 1;
  if (nt128 & 1) {
#pragma unroll
    for (int i = 0; i < 4; ++i)
#pragma unroll
      for (int j = 0; j < 2; ++j)
#pragma unroll
        for (int g4 = 0; g4 < 4; ++g4) {
          const int rl0 = wm * 128 + i * 32 + 8 * g4 + 4 * hh;
          const int d = wn1 * 64 + j * 32 + l31;
          const float v0 = acc[i][j][4 * g4 + 0] * sRow[rl0 + 0], v1 = acc[i][j][4 * g4 + 1] * sRow[rl0 + 1];
          const float v2 = acc[i][j][4 * g4 + 2] * sRow[rl0 + 2], v3 = acc[i][j][4 * g4 + 3] * sRow[rl0 + 3];
          u32x2 w = {pack2bf(v0, v1), pack2bf(v2, v3)};
          *(u32x2*)(p.vtC() + ((size_t)(b * 4 + head) * 128 + d) * 4096 + s0 + rl0) = w;
        }
  } else {
#pragma unroll
    for (int i = 0; i < 4; ++i)
#pragma unroll
      for (int j = 0; j < 2; ++j)
#pragma unroll
        for (int r = 0; r < 16; ++r) {
          const int rl = wm * 128 + i * 32 + crow(r, hh);
          const int pos = s0 + rl;
          p.kmla()[((size_t)(b * 4 + head) * 4096 + pos) * 192 + wn1 * 64 + j * 32 + l31] = f2bf(acc[i][j][r] * sRow[rl]);
        }
  }
}

DI void phase_gemm_o(const Params& p, int L, char* smem) {
  const u16* Wt = p.wt_o() + (size_t)L * 2048 * 2048;
  for (int it = 0;; ++it) {
    int mt, nt;
    if (!gemm_tile_map(it, 64, 8, mt, nt)) { if (mt < 0) break; continue; }
    f32x16 acc[4][2];
    {
      float* sRow = (float*)(smem + GEMM_SROW_OFF);
      const int t = otid();
      __syncthreads();
      if (t < 256) {
        const float4* sp = (const float4*)(p.ssqh() + (size_t)(mt * GM + t) * 16);
        const float4 a0 = sp[0], a1 = sp[1], b0 = sp[2], c0 = sp[3];
        sRow[t * 4 + 0] = rsqrtf((a0.x + a0.y + a0.z + a0.w + a1.x + a1.y + a1.z + a1.w) * (1.f / 1024.f) + EPS);
        sRow[t * 4 + 1] = rsqrtf((b0.x + b0.y + b0.z + b0.w) * (1.f / 512.f) + EPS);
        sRow[t * 4 + 2] = rsqrtf((c0.x + c0.y + c0.z + c0.w) * (1.f / 512.f) + EPS);
      }
    }
    gemm_mainloop<false, false, true>(p.o() + (size_t)mt * GM * 2048, 2048, Wt + (size_t)nt * GN * 2048, 2048, 2048, smem, acc);
    EPI_IDS
    EPI_LDS_WRITE(1.f)
    {
      const u16* sT = (const u16*)smem;
#pragma unroll 4
      for (int it = 0; it < 16; ++it) {
        const int c = etid + NTHR * it, row = c >> 5, cc = c & 31;
        u16* xp = p.xb() + (size_t)(mt * GM + row) * 2048 + nt * GN + cc * 8;
        const u32x4 d = *(const u32x4*)(sT + row * EPI_TS + cc * 8);
        u32x4 x = *(const u32x4*)xp;
        x.x = pack2bf(bf_lo(x.x) + bf_lo(d.x), bf_hi(x.x) + bf_hi(d.x));
        x.y = pack2bf(bf_lo(x.y) + bf_lo(d.y), bf_hi(x.y) + bf_hi(d.y));
        x.z = pack2bf(bf_lo(x.z) + bf_lo(d.z), bf_hi(x.z) + bf_hi(d.z));
        x.w = pack2bf(bf_lo(x.w) + bf_lo(d.w), bf_hi(x.w) + bf_hi(d.w));
        *(u32x4*)xp = x;
      }
    }
  }
}

DI void phase_gemm_pq(const Params& p, int L, char* smem) {
  const u16* Wt = p.wt_pq() + (size_t)L * 1024 * 2048;
  const float* sRow = (const float*)(smem + GEMM_SROW_OFF);
  for (int tile = obid(); tile < 64 * 4; tile += gridDim.x) {
    const int mt = tile >> 2, nt = tile & 3;
    f32x16 acc[4][2];
    gemm_mainloop<true>(p.xb() + (size_t)mt * GM * 2048, 2048, Wt + (size_t)nt * GN * 2048, 2048, 2048, smem, acc);
    EPI_IDS
    EPI_LDS_WRITE(sRow[rl])
    {
      const u16* sT = (const u16*)smem;
#pragma unroll 4
      for (int it = 0; it < 16; ++it) {
        const int c = etid + NTHR * it, row = c >> 5, cc = c & 31;
        *(u32x4*)(p.pq() + (size_t)(mt * GM + row) * 1024 + nt * GN + cc * 8) = *(const u32x4*)(sT + row * EPI_TS + cc * 8);
      }
    }
  }
}

DI void phase_gemm_scores(const Params& p, int L, char* smem) {
  for (int mt = obid(); mt < 512; mt += gridDim.x) {
    f32x16 acc[4][2];
    gemm_mainloop<false>(p.pq() + (size_t)mt * GM * 128, 128, p.keys_b() + (size_t)L * 256 * 128, 128, 128, smem, acc);
    EPI_IDS
#pragma unroll
    for (int i = 0; i < 4; ++i)
#pragma unroll
      for (int j = 0; j < 2; ++j)
#pragma unroll
        for (int r = 0; r < 16; ++r) {
          const int rl = wm * 128 + i * 32 + crow(r, hh);
          p.scores()[(size_t)(mt * GM + rl) * 256 + wn * 64 + j * 32 + l31] = acc[i][j][r];
        }
  }
}

template <int DQK, int MODE>
DI void attn_block(char* smem, const u16* __restrict__ Q, int ldq, const u16* __restrict__ Kb, int ldk,
                   const u16* __restrict__ Vt, int t0, int t1, int qpos0, float slope2, float sink2,
                   const float* __restrict__ biasTbl, u16* __restrict__ Oout, float* __restrict__ ssq_out,
                   const float* __restrict__ ropeCS = nullptr) {
  constexpr int LDK = DQK + 8;
  constexpr int NCH = DQK / 8;
  constexpr int KCH = NCH / 8;
  constexpr int NKS = DQK / 16;
  constexpr int STG = 64 * LDK + 128 * 68;
  u16* sbase = (u16*)smem;
  float* sBias = (float*)(sbase + 2 * STG);
  const int tid = otid(), lane = tid & 63, wid = tid >> 6, hh = lane >> 5, l31 = lane & 31;

  __syncthreads();
  if (MODE == 1) {
    for (int i = tid; i < 465; i += NTHR) sBias[i] = biasTbl[i] * LOG2E;
  }
  bf16x8 qf[NKS];
  {
    const u16* qrow = Q + (size_t)(wid * 32 + l31) * ldq + hh * 8;
#pragma unroll
    for (int ks = 0; ks < NKS; ++ks) qf[ks] = *(const bf16x8*)(qrow + ks * 16);
  }
  if (MODE == 2) {
    const int pos = qpos0 + wid * 32 + l31;
#pragma unroll
    for (int k2 = 0; k2 < 2; ++k2) {
      const float* cp = ropeCS + (size_t)pos * 32 + k2 * 16 + 8 * hh;
      const float* sp = ropeCS + (size_t)SEQ * 32 + (size_t)pos * 32 + k2 * 16 + 8 * hh;
#pragma unroll
      for (int j = 0; j < 8; ++j) {
        const float c = cp[j], sn = sp[j];
        const float x1 = __uint_as_float(((u32)(u16)qf[NKS - 4 + k2][j]) << 16);
        const float x2 = __uint_as_float(((u32)(u16)qf[NKS - 2 + k2][j]) << 16);
        qf[NKS - 4 + k2][j] = (short)f2bf(x1 * c - x2 * sn);
        qf[NKS - 2 + k2][j] = (short)f2bf(x1 * sn + x2 * c);
      }
    }
  }
  constexpr float SM_THR = 6.f;
  float m_run = (MODE == 0) ? sink2 : 0.f;
  float l_run = (MODE == 0 && hh == 0) ? 1.f : 0.f;
  bool first = true;
  f32x16 oacc[4];
#pragma unroll
  for (int d = 0; d < 4; ++d)
#pragma unroll
    for (int r = 0; r < 16; ++r) oacc[d][r] = 0.f;

  const int widu = __builtin_amdgcn_readfirstlane(wid);
  const int qw0 = qpos0 + widu * 32;
  const int qpos = qw0 + l31;
  const int rq = (qpos0 >> 6) + (widu >> 1);
  const int rsq = min(max(rq - 4, 0), 56);
  const int cq = (wid & 1) * 32 + l31;
  const int cs = min(max(cq - 8, 0), 48);

  u32x4 rk[KCH], rv[2];
#define ATTN_LOAD_TILE(TT)                                                              \
  {                                                                                     \
    _Pragma("unroll") for (int i = 0; i < KCH; ++i) {                                   \
      const int c = tid + NTHR * i;                                                     \
      const int rr = c / NCH, cc = c % NCH;                                             \
      rk[i] = *(const u32x4*)(Kb + (size_t)((TT) * 64 + rr) * ldk + cc * 8);            \
    }                                                                                   \
    _Pragma("unroll") for (int i = 0; i < 2; ++i) {                                     \
      const int c = tid + NTHR * i;                                                     \
      const int d = c >> 3, part = c & 7;                                               \
      rv[i] = *(const u32x4*)(Vt + (size_t)d * 4096 + (TT) * 64 + part * 8);            \
    }                                                                                   \
  }
#define ATTN_STORE_TILE(STAGE)                                                          \
  {                                                                                     \
    u16* sKw = sbase + (STAGE) * STG;                                                   \
    u16* sVw = sKw + 64 * LDK;                                                          \
    _Pragma("unroll") for (int i = 0; i < KCH; ++i) {                                   \
      const int c = tid + NTHR * i;                                                     \
      const int rr = c / NCH, cc = c % NCH;                                             \
      *(u32x4*)(sKw + rr * LDK + cc * 8) = rk[i];                                       \
    }                                                                                   \
    _Pragma("unroll") for (int i = 0; i < 2; ++i) {                                     \
      const int c = tid + NTHR * i;                                                     \
      const int d = c >> 3, part = c & 7;                                               \
      *(u32x2*)(sVw + d * 68 + part * 8) = u32x2{rv[i].x, rv[i].y};                     \
      *(u32x2*)(sVw + d * 68 + part * 8 + 4) = u32x2{rv[i].z, rv[i].w};                 \
    }                                                                                   \
  }
  ATTN_LOAD_TILE(t0)
  ATTN_STORE_TILE(0)
  __syncthreads();
#pragma unroll 1
  for (int t = t0; t < t1; ++t) {
    const int cur = (t - t0) & 1;
    {
      const int tn = (t + 1 < t1) ? t + 1 : t;
      ATTN_LOAD_TILE(tn)
    }
    const u16* sK = sbase + cur * STG;
    const u16* sV = sK + 64 * LDK;
    bool relevant = true;
    if (MODE == 0) relevant = (t * 64 <= qw0 + 31 + 128) && (t * 64 + 63 >= qw0 - 128);
    if (MODE == 1) relevant = (t >= rsq) && (t < rsq + 8);
    if (relevant) {
      f32x16 sacc[2];
#pragma unroll
      for (int tt = 0; tt < 2; ++tt) {
#pragma unroll
        for (int r = 0; r < 16; ++r) sacc[tt][r] = -m_run;
        const u16* kp = sK + (tt * 32 + l31) * LDK + hh * 8;
#pragma unroll
        for (int ks = 0; ks < NKS; ++ks) {
          bf16x8 kf = *(const bf16x8*)(kp + ks * 16);
          sacc[tt] = MFMA32(kf, qf[ks], sacc[tt]);
        }
      }
      float mx = -INFINITY;
      const int drow = min(max(t - rq + 7, 0), 14) * 31;
#pragma unroll
      for (int tt = 0; tt < 2; ++tt)
#pragma unroll
        for (int r = 0; r < 16; ++r) {
          float sv = sacc[tt][r];
          const int kl = tt * 32 + crow(r, hh);
          if (MODE == 0) {
            const int kpos = t * 64 + kl;
            int dist = qpos - kpos;
            dist = dist < 0 ? -dist : dist;
            sv = (dist <= 128) ? (sv - slope2 * (float)dist) : -INFINITY;
          } else if (MODE == 1) {
            const bool ok = ((unsigned)(kl - cs) < 16u);
            const int dc = min(max(kl - cq + 15, 0), 30);
            sv = ok ? (sv + sBias[drow + dc]) : -INFINITY;
          }
          sacc[tt][r] = sv;
          mx = fmaxf(mx, sv);
        }
      mx = fmaxf(mx, __shfl_xor(mx, 32));
      if (__builtin_amdgcn_ballot_w64(first || (mx > SM_THR)) != 0ull) {
        float delta = fmaxf(mx, 0.f);
        if (first && MODE != 0) delta = (mx > -INFINITY) ? mx : 0.f;
        m_run += delta;
        const float alpha = __builtin_amdgcn_exp2f(-delta);
        l_run *= alpha;
#pragma unroll
        for (int d = 0; d < 4; ++d)
#pragma unroll
          for (int r = 0; r < 16; ++r) oacc[d][r] *= alpha;
#pragma unroll
        for (int tt = 0; tt < 2; ++tt)
#pragma unroll
          for (int r = 0; r < 16; ++r) sacc[tt][r] -= delta;
        first = false;
      }
      float ps = 0.f;
#pragma unroll
      for (int tt = 0; tt < 2; ++tt) {
#pragma unroll
        for (int r = 0; r < 16; ++r) {
          const float pv = __builtin_amdgcn_exp2f(sacc[tt][r]);
          sacc[tt][r] = pv;
          ps += pv;
        }
#pragma unroll
        for (int s2 = 0; s2 < 2; ++s2) {
          u32x4 w;
          w.x = pack2bf(sacc[tt][8 * s2 + 0], sacc[tt][8 * s2 + 1]);
          w.y = pack2bf(sacc[tt][8 * s2 + 2], sacc[tt][8 * s2 + 3]);
          w.z = pack2bf(sacc[tt][8 * s2 + 4], sacc[tt][8 * s2 + 5]);
          w.w = pack2bf(sacc[tt][8 * s2 + 6], sacc[tt][8 * s2 + 7]);
          const bf16x8 pf = __builtin_bit_cast(bf16x8, w);
#pragma unroll
          for (int dt = 0; dt < 4; ++dt) {
            const u16* vp = sV + (dt * 32 + l31) * 68 + 4 * hh;
            const u32x2 lo = *(const u32x2*)(vp + tt * 32 + s2 * 16);
            const u32x2 hi = *(const u32x2*)(vp + tt * 32 + s2 * 16 + 8);
            u32x4 wv = {lo.x, lo.y, hi.x, hi.y};
            oacc[dt] = MFMA32(__builtin_bit_cast(bf16x8, wv), pf, oacc[dt]);
          }
        }
      }
      l_run += ps;
    }
    ATTN_STORE_TILE(cur ^ 1)
    __syncthreads();
  }
  const float lt = l_run + __shfl_xor(l_run, 32);
  const float inv = 1.f / lt;
  float sq = 0.f;
  u16* orow = Oout + (size_t)(wid * 32 + l31) * 2048;
#pragma unroll
  for (int dt = 0; dt < 4; ++dt)
#pragma unroll
    for (int g4 = 0; g4 < 4; ++g4) {
      const float v0 = oacc[dt][4 * g4 + 0] * inv, v1 = oacc[dt][4 * g4 + 1] * inv;
      const float v2 = oacc[dt][4 * g4 + 2] * inv, v3 = oacc[dt][4 * g4 + 3] * inv;
      sq += v0 * v0 + v1 * v1 + v2 * v2 + v3 * v3;
      u32x2 w = {pack2bf(v0, v1), pack2bf(v2, v3)};
      *(u32x2*)(orow + dt * 32 + 8 * g4 + 4 * hh) = w;
    }
  sq += __shfl_xor(sq, 32);
  if (hh == 0) ssq_out[(size_t)(wid * 32 + l31) * 16] = sq;
}

DI void phase_mix(const Params& p, int L, char* smem) {
  for (int w = obid(); w < 256; w += gridDim.x) {
    const int b = w >> 6, rem = w & 63, rg = rem >> 2, hb = rem & 3;
    const int r0 = rg * 4;
    const int t0 = min(max(r0 - 4, 0), 56), t1 = min(max(r0 - 1, 0), 56) + 8;
    const size_t tok0 = (size_t)b * 4096 + r0 * 64;
    attn_block<128, 1>(smem, p.h() + tok0 * HLD + 1536 + hb * 128, HLD, p.h() + (size_t)b * 4096 * HLD + 2048 + hb * 128, HLD,
                       p.vtB() + (size_t)(b * 4 + hb) * 128 * 4096, t0, t1, r0 * 64, 0.f, 0.f,
                       p.b_rel + (size_t)L * 4 * 465 + hb * 465, p.o() + tok0 * 2048 + 1024 + hb * 128, p.ssqh() + tok0 * 16 + 8 + hb);
  }
  for (int ww = obid(); ww < 512; ww += gridDim.x) {
    const int b = ww >> 7, rem = ww & 127, sb = rem >> 3, hq = rem & 7;
    const int t0 = max(0, 4 * sb - 2), t1 = min(64, 4 * sb + 6);
    const size_t tok0 = (size_t)b * 4096 + sb * 256;
    const float slope2 = exp2f(-(float)(hq + 1)) * LOG2E;
    const float sink2 = p.a_sink[L * 8 + hq] * LOG2E;
    attn_block<128, 0>(smem, p.h() + tok0 * HLD + hq * 128, HLD, p.h() + (size_t)b * 4096 * HLD + 1024 + (hq >> 2) * 128, HLD,
                       p.vtA() + (size_t)(b * 2 + (hq >> 2)) * 128 * 4096, t0, t1, sb * 256, slope2, sink2, nullptr,
                       p.o() + tok0 * 2048 + hq * 128, p.ssqh() + tok0 * 16 + hq);
  }
  for (int w = (obid() + 64) % gridDim.x; w < 192; w += gridDim.x) tile_upq(p, L, w, smem);
  for (int w = obid(); w < 256; w += gridDim.x) tile_upkv(p, L, w, smem);
}

DI void phase_mla(const Params& p, char* smem) {
  const int nbx = gridDim.x >> 3;
  for (int li = obid() >> 3; li < 32; li += nbx) {
    const int pair = (obid() & 7) * 2 + (li >> 4), nq = li & 15;
    const int b = pair >> 2, hc = pair & 3;
    const size_t tok0 = (size_t)b * 4096 + nq * 256;
    attn_block<192, 2>(smem, p.qmla() + ((size_t)(b * 4 + hc) * 4096 + nq * 256) * 192, 192, p.kmla() + (size_t)(b * 4 + hc) * 4096 * 192, 192,
                       p.vtC() + (size_t)(b * 4 + hc) * 128 * 4096, 0, 64, nq * 256, 0.f, 0.f, nullptr,
                       p.o() + tok0 * 2048 + 1536 + hc * 128, p.ssqh() + tok0 * 16 + 12 + hc, p.ropeC());
  }
}

DI void phase_onorm(const Params& p) {
  const int lane = otid() & 63, wid = otid() >> 6;
  for (int row = obid() * NWAVE + wid; row < T; row += gridDim.x * NWAVE) {
    const float4* sp = (const float4*)(p.ssqh() + (size_t)row * 16);
    const float4 a0 = sp[0], a1 = sp[1], b0 = sp[2], c0 = sp[3];
    const float rA = rsqrtf((a0.x + a0.y + a0.z + a0.w + a1.x + a1.y + a1.z + a1.w) * (1.f / 1024.f) + EPS);
    const float rB = rsqrtf((b0.x + b0.y + b0.z + b0.w) * (1.f / 512.f) + EPS);
    const float rC = rsqrtf((c0.x + c0.y + c0.z + c0.w) * (1.f / 512.f) + EPS);
#pragma unroll
    for (int j = 0; j < 4; ++j) {
      const float sc = (j < 2) ? rA : (j == 2 ? rB : rC);
      const size_t off = (size_t)row * 2048 + j * 512 + lane * 8;
      u32x4 w = *(const u32x4*)(p.o() + off);
      w.x = pack2bf(bf_lo(w.x) * sc, bf_hi(w.x) * sc);
      w.y = pack2bf(bf_lo(w.y) * sc, bf_hi(w.y) * sc);
      w.z = pack2bf(bf_lo(w.z) * sc, bf_hi(w.z) * sc);
      w.w = pack2bf(bf_lo(w.w) * sc, bf_hi(w.w) * sc);
      *(u32x4*)(p.on() + off) = w;
    }
  }
}

DI u32 ordkey(float s) {
  const u32 u = __float_as_uint(s);
  return u ^ ((u >> 31) ? 0xFFFFFFFFu : 0x80000000u);
}
DI float unord(u32 k) {
  const u32 u = (k & 0x80000000u) ? (k ^ 0x80000000u) : ~k;
  return __uint_as_float(u);
}
DI void insert16(u32 (&Ls)[16], u32 key) {
#pragma unroll
  for (int q = 0; q < 16; ++q) {
    const u32 hi = max(Ls[q], key);
    key = min(Ls[q], key);
    Ls[q] = hi;
  }
}

DI void phase_select(const Params& p, int L, char* smem) {
  float* sS = (float*)smem;
  u32* sTop = (u32*)(smem + 256 * 132 * 4);
  const int tid = otid(), lane = tid & 63, wid = tid >> 6, hh = lane >> 5, l31 = lane & 31;
  const int rt = wid >> 1, c = wid & 1;
  const u16* kb = p.keys_b() + (size_t)L * 256 * 128;
  for (int it = obid(); it < 1024; it += gridDim.x) {
    f32x16 sc[4];
    {
      const u16* qrow = p.pq() + ((size_t)it * 128 + rt * 32 + l31) * 128 + c * 64 + hh * 8;
      bf16x8 qa[4];
#pragma unroll
      for (int ks = 0; ks < 4; ++ks) qa[ks] = *(const bf16x8*)(qrow + ks * 16);
#pragma unroll
      for (int ct = 0; ct < 4; ++ct) {
#pragma unroll
        for (int r = 0; r < 16; ++r) sc[ct][r] = 0.f;
        const u16* krow = kb + (size_t)(c * 128 + ct * 32 + l31) * 128 + c * 64 + hh * 8;
#pragma unroll
        for (int ks = 0; ks < 4; ++ks) {
          const bf16x8 kf = *(const bf16x8*)(krow + ks * 16);
          sc[ct] = MFMA32(qa[ks], kf, sc[ct]);
        }
      }
    }
    __syncthreads();
#pragma unroll
    for (int ct = 0; ct < 4; ++ct)
#pragma unroll
      for (int r = 0; r < 16; ++r) sS[((rt * 32 + crow(r, hh)) * 2 + c) * 132 + ct * 32 + l31] = sc[ct][r];
    __syncthreads();
    {
      const int combo = tid >> 1, half = tid & 1;
      u32 Ls[16];
#pragma unroll
      for (int q = 0; q < 16; ++q) Ls[q] = 0u;
      const float* sp = sS + combo * 132 + half * 64;
      for (int n4 = 0; n4 < 16; ++n4) {
        const int n4r = (n4 + half * 8) & 15;
        const float4 v = *(const float4*)(sp + n4r * 4);
        const int nb = half * 64 + n4r * 4;
        insert16(Ls, (ordkey(v.x) & ~0x7Fu) | (u32)(127 - (nb + 0)));
        insert16(Ls, (ordkey(v.y) & ~0x7Fu) | (u32)(127 - (nb + 1)));
        insert16(Ls, (ordkey(v.z) & ~0x7Fu) | (u32)(127 - (nb + 2)));
        insert16(Ls, (ordkey(v.w) & ~0x7Fu) | (u32)(127 - (nb + 3)));
      }
      u32 Ms[16];
#pragma unroll
      for (int q = 0; q < 16; ++q) {
        const u32 other = (u32)__shfl_xor((int)Ls[15 - q], 1);
        Ms[q] = max(Ls[q], other);
      }
#pragma unroll
      for (int span = 8; span >= 1; span >>= 1)
#pragma unroll
        for (int q = 0; q < 16; ++q)
          if ((q & span) == 0) {
            const u32 hi = max(Ms[q], Ms[q + span]), lo = min(Ms[q], Ms[q + span]);
            Ms[q] = hi;
            Ms[q + span] = lo;
          }
      if (half == 0) {
#pragma unroll
        for (int q = 0; q < 16; ++q) sTop[combo * 16 + q] = Ms[q];
      }
    }
    __syncthreads();
    if (tid < 128) {
      const u32* t0 = sTop + (tid * 2) * 16;
      const u32* t1 = sTop + (tid * 2 + 1) * 16;
      float s0[16], s1[16];
#pragma unroll
      for (int q = 0; q < 16; ++q) {
        s0[q] = unord(t0[q] & ~0x7Fu);
        s1[q] = unord(t1[q] & ~0x7Fu);
      }
      u32 M[16];
#pragma unroll
      for (int q = 0; q < 16; ++q) M[q] = 0u;
#pragma unroll
      for (int i = 0; i < 16; ++i)
#pragma unroll
        for (int j = 0; j < 16; ++j)
          if ((i + 1) * (j + 1) <= 16) {
            const float sm = s0[i] + s1[j];
            insert16(M, (ordkey(sm) & ~0xFFu) | (u32)(255 - (i * 16 + j)));
          }
      const float mxv = unord(M[0] & ~0xFFu);
      float e[16], sum = 0.f;
#pragma unroll
      for (int q = 0; q < 16; ++q) {
        e[q] = __expf(unord(M[q] & ~0xFFu) - mxv);
        sum += e[q];
      }
      const float inv = 1.f / sum;
      const size_t row = (size_t)it * 128 + tid;
#pragma unroll
      for (int q = 0; q < 16; ++q) {
        const int ij = 255 - (int)(M[q] & 0xFFu);
        const int n0 = 127 - (int)(t0[ij >> 4] & 0x7Fu);
        const int n1 = 127 - (int)(t1[ij & 15] & 0x7Fu);
        p.idx()[row * 16 + q] = n0 * 128 + n1;
        p.g()[row * 16 + q] = e[q] * inv;
      }
    }
  }
}

DI float dot32(u32x4 w, const float2_t* xn2) {
  float2_t s = {0.f, 0.f};
#pragma unroll
  for (int c = 0; c < 4; ++c) {
    s = __builtin_elementwise_fma(__builtin_amdgcn_cvt_scalef32_pk_f32_fp4(w[c], 1.0f, 0), xn2[4 * c + 0], s);
    s = __builtin_elementwise_fma(__builtin_amdgcn_cvt_scalef32_pk_f32_fp4(w[c], 1.0f, 1), xn2[4 * c + 1], s);
    s = __builtin_elementwise_fma(__builtin_amdgcn_cvt_scalef32_pk_f32_fp4(w[c], 1.0f, 2), xn2[4 * c + 2], s);
    s = __builtin_elementwise_fma(__builtin_amdgcn_cvt_scalef32_pk_f32_fp4(w[c], 1.0f, 3), xn2[4 * c + 3], s);
  }
  return s.x + s.y;
}
DI void axpy32(u32x4 w, float a, float2_t* y2) {
  const float2_t a2 = {a, a};
#pragma unroll
  for (int c = 0; c < 4; ++c) {
    y2[4 * c + 0] = __builtin_elementwise_fma(__builtin_amdgcn_cvt_scalef32_pk_f32_fp4(w[c], 1.0f, 0), a2, y2[4 * c + 0]);
    y2[4 * c + 1] = __builtin_elementwise_fma(__builtin_amdgcn_cvt_scalef32_pk_f32_fp4(w[c], 1.0f, 1), a2, y2[4 * c + 1]);
    y2[4 * c + 2] = __builtin_elementwise_fma(__builtin_amdgcn_cvt_scalef32_pk_f32_fp4(w[c], 1.0f, 2), a2, y2[4 * c + 2]);
    y2[4 * c + 3] = __builtin_elementwise_fma(__builtin_amdgcn_cvt_scalef32_pk_f32_fp4(w[c], 1.0f, 3), a2, y2[4 * c + 3]);
  }
}
DI float gelu_tanh(float a) {
  const float u = 0.7978845608028654f * (a + 0.044715f * a * a * a);
  return 0.5f * a * (1.f + tanhf(u));
}

DI void phase_gather(const Params& p, int L, bool last) {
  const int wid = otid() >> 6;
  const unsigned char* U = p.ub() + (size_t)L * NEXP * 1024;
  const unsigned char* V = p.vb() + (size_t)L * NEXP * 1024;
  const float* ln2 = p.ln2 + L * 2048;
  int ni0 = 0, ni1 = 0;
  float ng0 = 0.f, ng1 = 0.f;
  {
    const int t0 = obid() * NWAVE + wid, l0 = otid() & 63;
    if (t0 < T) {
      ni0 = p.idx()[(size_t)t0 * 128 + l0]; ni1 = p.idx()[(size_t)t0 * 128 + 64 + l0];
      ng0 = p.g()[(size_t)t0 * 128 + l0];   ng1 = p.g()[(size_t)t0 * 128 + 64 + l0];
    }
  }
  for (int t = obid() * NWAVE + wid; t < T; t += gridDim.x * NWAVE) {
    const int lane = otid() & 63;
    const u16* xr = p.xb() + (size_t)t * 2048;
    float2_t xn2[16];
    float ss = 0.f;
    u32x4 xkeep[4];
#pragma unroll
    for (int c8 = 0; c8 < 4; ++c8) {
      const u32x4 a = *(const u32x4*)(xr + lane * 32 + c8 * 8);
      xkeep[c8] = a;
      xn2[c8 * 4 + 0] = float2_t{bf_lo(a.x), bf_hi(a.x)};
      xn2[c8 * 4 + 1] = float2_t{bf_lo(a.y), bf_hi(a.y)};
      xn2[c8 * 4 + 2] = float2_t{bf_lo(a.z), bf_hi(a.z)};
      xn2[c8 * 4 + 3] = float2_t{bf_lo(a.w), bf_hi(a.w)};
    }
#pragma unroll
    for (int e = 0; e < 16; ++e) ss += xn2[e].x * xn2[e].x + xn2[e].y * xn2[e].y;
    ss = wave_sum(ss);
    const float rstd = rsqrtf(ss * (1.f / 2048.f) + EPS) * (1.f / U_SCALE);
#pragma unroll
    for (int c4 = 0; c4 < 8; ++c4) {
      const float4 a = *(const float4*)(ln2 + lane * 32 + c4 * 4);
      xn2[c4 * 2 + 0] *= float2_t{rstd * a.x, rstd * a.y};
      xn2[c4 * 2 + 1] *= float2_t{rstd * a.z, rstd * a.w};
    }
    const int i0 = ni0, i1 = ni1;
    const float g0 = ng0, g1 = ng1;
    float a0 = 0.f, a1 = 0.f;
#pragma unroll
    for (int half = 0; half < 2; ++half) {
      const int iv = half ? i1 : i0;
      float av = 0.f;
#pragma unroll 1
      for (int k0 = 0; k0 < 64; k0 += 16) {
        u32x4 w[16];
#pragma unroll
        for (int q = 0; q < 16; ++q) {
          const int row = __builtin_amdgcn_readlane(iv, k0 + q);
          w[q] = *(const u32x4*)(U + (size_t)row * 1024 + lane * 16);
        }
        float d[16];
#pragma unroll
        for (int q = 0; q < 16; ++q) {
          __builtin_amdgcn_sched_barrier(0);
          if (q > 0) asm volatile("" : "+v"(w[q]), "+v"(d[q - 1]));
          d[q] = dot32(w[q], xn2);
        }
        __builtin_amdgcn_sched_barrier(0);
        {
          const bool b5 = (lane & 32) != 0, b4 = (lane & 16) != 0, b3 = (lane & 8) != 0, b2 = (lane & 4) != 0;
          float e8[8], e4[4], e2[2], e1;
#pragma unroll
          for (int j = 0; j < 8; ++j) {
            const float snd = b5 ? d[j] : d[j + 8];
            const float kep = b5 ? d[j + 8] : d[j];
            e8[j] = kep + __shfl_xor(snd, 32);
          }
#pragma unroll
          for (int j = 0; j < 4; ++j) {
            const float snd = b4 ? e8[j] : e8[j + 4];
            const float kep = b4 ? e8[j + 4] : e8[j];
            e4[j] = kep + __shfl_xor(snd, 16);
          }
#pragma unroll
          for (int j = 0; j < 2; ++j) {
            const float snd = b3 ? e4[j] : e4[j + 2];
            const float kep = b3 ? e4[j + 2] : e4[j];
            e2[j] = kep + __shfl_xor(snd, 8);
          }
          {
            const float snd = b2 ? e2[0] : e2[1];
            const float kep = b2 ? e2[1] : e2[0];
            e1 = kep + __shfl_xor(snd, 4);
          }
          e1 += __shfl_xor(e1, 2);
          e1 += __shfl_xor(e1, 1);
          const float got = __shfl(e1, ((lane - k0) & 15) * 4);
          if (lane >= k0 && lane < k0 + 16) av = got;
        }
      }
      if (half) a1 = av; else a0 = av;
    }
    const float hs0 = gelu_tanh(a0) * g0 * (1.f / V_SCALE), hs1 = gelu_tanh(a1) * g1 * (1.f / V_SCALE);
    {
      const int tn = t + gridDim.x * NWAVE;
      if (tn < T) {
        ni0 = p.idx()[(size_t)tn * 128 + lane]; ni1 = p.idx()[(size_t)tn * 128 + 64 + lane];
        ng0 = p.g()[(size_t)tn * 128 + lane];   ng1 = p.g()[(size_t)tn * 128 + 64 + lane];
      }
    }
    float2_t y2[16];
#pragma unroll
    for (int e = 0; e < 16; ++e) y2[e] = float2_t{0.f, 0.f};
#pragma unroll
    for (int half = 0; half < 2; ++half) {
      const int iv = half ? i1 : i0;
      const int hv = __float_as_int(half ? hs1 : hs0);
#pragma unroll 1
      for (int k0 = 0; k0 < 64; k0 += 8) {
        u32x4 w[8];
        float wq[8];
#pragma unroll
        for (int q = 0; q < 8; ++q) {
          const int row = __builtin_amdgcn_readlane(iv, k0 + q);
          wq[q] = __int_as_float(__builtin_amdgcn_readlane(hv, k0 + q));
          w[q] = *(const u32x4*)(V + (size_t)row * 1024 + lane * 16);
        }
#pragma unroll
        for (int q = 0; q < 8; ++q) {
          __builtin_amdgcn_sched_barrier(0);
          asm volatile("" : "+v"(w[q]), "+v"(y2[0]), "+v"(y2[8]));
          axpy32(w[q], wq[q], y2);
        }
        __builtin_amdgcn_sched_barrier(0);
      }
    }
    int t2 = t;
    asm volatile("" : "+v"(t2));
    const int lane2 = otid() & 63;
#pragma unroll
    for (int c8 = 0; c8 < 4; ++c8) {
      const u32x4 a = xkeep[c8];
      y2[c8 * 4 + 0] += float2_t{bf_lo(a.x), bf_hi(a.x)};
      y2[c8 * 4 + 1] += float2_t{bf_lo(a.y), bf_hi(a.y)};
      y2[c8 * 4 + 2] += float2_t{bf_lo(a.z), bf_hi(a.z)};
      y2[c8 * 4 + 3] += float2_t{bf_lo(a.w), bf_hi(a.w)};
    }
    if (!last) {
#pragma unroll
      for (int c8 = 0; c8 < 4; ++c8) {
        const float2_t* yy = y2 + c8 * 4;
        u32x4 w = {pack2bf(yy[0].x, yy[0].y), pack2bf(yy[1].x, yy[1].y), pack2bf(yy[2].x, yy[2].y), pack2bf(yy[3].x, yy[3].y)};
        *(u32x4*)(p.xb() + (size_t)t2 * 2048 + lane2 * 32 + c8 * 8) = w;
      }
    } else {
      float ss2 = 0.f;
#pragma unroll
      for (int e = 0; e < 16; ++e) ss2 += y2[e].x * y2[e].x + y2[e].y * y2[e].y;
      ss2 = wave_sum(ss2);
      const float r2 = rsqrtf(ss2 * (1.f / 2048.f) + EPS);
      float* orow = p.out + (size_t)t2 * 2048;
#pragma unroll
      for (int c4 = 0; c4 < 8; ++c4) {
        const float4 a = *(const float4*)(p.fnorm + lane2 * 32 + c4 * 4);
        *(float4*)(orow + lane2 * 32 + c4 * 4) =
            float4{y2[c4 * 2].x * r2 * a.x, y2[c4 * 2].y * r2 * a.y, y2[c4 * 2 + 1].x * r2 * a.z, y2[c4 * 2 + 1].y * r2 * a.w};
      }
    }
  }
}


#define XB_TMO      128
#define XB_XCNT(j)  (256  + 64 * (j))
#define XB_XSUB(j)  (1280 + 64 * (j))
#define XB_XGEN(j)  (2304 + 64 * (j))
#define XB_TOP      3328
#define XB_TOPGEN   3392
#define XCD_BAR_WORDS 3456
#define XB_SPIN_CAP (1u << 18)
#define LAS __attribute__((address_space(3)))
DI unsigned xb_ld(unsigned* p) { return __hip_atomic_load(p, __ATOMIC_RELAXED, __HIP_MEMORY_SCOPE_AGENT); }
DI unsigned xb_add(unsigned* p, unsigned v) { return __hip_atomic_fetch_add(p, v, __ATOMIC_RELAXED, __HIP_MEMORY_SCOPE_AGENT); }
DI unsigned xb_xcc_id() { return (unsigned)__builtin_amdgcn_s_getreg((3 << 11) | 20) & 0xFu; }
#define XB_SPIN(cond, bar) do { unsigned _sp = 0; while (cond) { __builtin_amdgcn_s_sleep(1); \
    if ((++_sp & 255u) == 0u) { if (xb_ld(&(bar)[XB_TMO])) break; if (_sp > XB_SPIN_CAP) { atomicAdd(&(bar)[XB_TMO], 1u); break; } } } } while (0)
struct XcdBarrier { unsigned* bar; unsigned x; volatile LAS unsigned* st; };
DI XcdBarrier xcd_barrier_post(unsigned* bar, volatile LAS unsigned* st) {
  XcdBarrier b; b.bar = bar; b.x = xb_xcc_id(); b.st = st;
  if (threadIdx.x == 0) (void)xb_add(&bar[XB_XCNT(b.x)], 1u);
  return b;
}
DI void xcd_barrier_complete(unsigned* bar, unsigned x, unsigned& nloc, unsigned& nx) {
  const unsigned G = gridDim.x * gridDim.y * gridDim.z;
  unsigned sum, cnt, mine, sp = 0u;
  for (;;) {
    sum = 0u; cnt = 0u; mine = 0u;
#pragma unroll
    for (unsigned j = 0; j < 16; ++j) { const unsigned c = xb_ld(&bar[XB_XCNT(j)]); sum += c; cnt += (c > 0u) ? 1u : 0u; mine = (j == x) ? c : mine; }
    if (sum == G) break;
    __builtin_amdgcn_s_sleep(1);
    if ((++sp & 255u) == 0u) { if (xb_ld(&bar[XB_TMO])) break; if (sp > XB_SPIN_CAP) { atomicAdd(&bar[XB_TMO], 1u); break; } }
  }
  nloc = mine > 0u ? mine : 1u; nx = cnt > 0u ? cnt : 1u;
}
DI void xcd_barrier(const XcdBarrier& b) {
  asm volatile("s_waitcnt vmcnt(0)" ::: "memory");
  __syncthreads();
  if (threadIdx.x == 0) {
    unsigned* bar = b.bar;
    __builtin_amdgcn_s_waitcnt(0);
    unsigned nloc = b.st[0], nx = b.st[1];
    if (nloc == 0u) { xcd_barrier_complete(bar, b.x, nloc, nx); b.st[0] = nloc; b.st[1] = nx; }
    const unsigned old = xb_add(&bar[XB_XSUB(b.x)], 1u);
    const unsigned gen = old / nloc;
    if (old + 1u == (gen + 1u) * nloc) {
      __builtin_amdgcn_fence(__ATOMIC_RELEASE, "agent");
      asm volatile("s_waitcnt vmcnt(0)" ::: "memory");
      const unsigned og = xb_add(&bar[XB_TOP], 1u);
      const unsigned tg = og / nx;
      if (og + 1u == (tg + 1u) * nx) xb_add(&bar[XB_TOPGEN], 1u);
      else XB_SPIN(xb_ld(&bar[XB_TOPGEN]) == tg, bar);
      __builtin_amdgcn_fence(__ATOMIC_ACQUIRE, "agent");
      xb_add(&bar[XB_XGEN(b.x)], 1u);
      asm volatile("s_waitcnt vmcnt(0)" ::: "memory");
    } else {
      XB_SPIN(xb_ld(&bar[XB_XGEN(b.x)]) == gen, bar);
      __builtin_amdgcn_fence(__ATOMIC_ACQUIRE, "agent");
      asm volatile("s_waitcnt vmcnt(0)" ::: "memory");
    }
  }
  __syncthreads();
}

#define KDEF(name, body)                                                       \
  __global__ void __launch_bounds__(512) name(Params p, int L) {            \
    __shared__ __attribute__((aligned(16))) char smem[SMEM_BYTES];             \
    body;                                                                      \
  }
#if !MEGA
KDEF(k_prologue, phase_prologue(p, smem))
KDEF(k_gemm1, phase_gemm1(p, L, smem))
KDEF(k_mix, phase_mix(p, L, smem))
KDEF(k_mla, phase_mla(p, smem))
KDEF(k_onorm, phase_onorm(p))
KDEF(k_gemm_o, phase_gemm_o(p, L, smem))
KDEF(k_gemm_pq, phase_gemm_pq(p, L, smem))
KDEF(k_scores, phase_gemm_scores(p, L, smem))
KDEF(k_select, phase_select(p, L, smem))
KDEF(k_gather, phase_gather(p, L, L == 1))
#else
#ifndef PROBE_MASK
#define PROBE_MASK 0
#endif
#define RUN(bit, call)                         \
  call;                                        \
  if (PROBE_MASK & (bit)) {                    \
    grid.sync();                               \
    call;                                      \
  }
__global__ void __launch_bounds__(512) mega_coop(Params p) {
  __shared__ __attribute__((aligned(16))) char smem[SMEM_BYTES];
  __shared__ uint4 xb_words;
  cg::grid_group grid = cg::this_grid();
  if (threadIdx.x == 0) xb_words = make_uint4(0u, 0u, 0u, 0u);
  __syncthreads();
  const XcdBarrier xb = xcd_barrier_post((unsigned*)(p.ws + WS_NEED), (volatile LAS unsigned*)&xb_words);
#define GSYNC xcd_barrier(xb)
  RUN(256, phase_prologue(p, smem))
  if (p.ws == nullptr) grid.sync();
  GSYNC;
#pragma unroll 1
  for (int L = 0; L < 2; ++L) {
    phase_gemm1(p, L, smem);
    GSYNC;
    phase_mix(p, L, smem);
    GSYNC;
    phase_mla(p, smem);
    GSYNC;
    phase_gemm_o(p, L, smem);
    GSYNC;
    phase_gemm_pq(p, L, smem);
    GSYNC;
    phase_select(p, L, smem);
    GSYNC;
    phase_gather(p, L, L == 1);
    if (L == 0) GSYNC;
  }
}
#endif

extern "C" void kernel_launch(void* const* d_in, const int* in_sizes, int n_in, void* d_out, int out_size, void* d_ws,
                              size_t ws_size, hipStream_t stream) {
  Params p{};
  p.x = (const float*)d_in[0]; p.ln1 = (const float*)d_in[1]; p.w_in = (const float*)d_in[2]; p.a_sink = (const float*)d_in[3];
  p.b_rel = (const float*)d_in[4]; p.cqn = (const float*)d_in[5]; p.ckvn = (const float*)d_in[6]; p.wuq = (const float*)d_in[7];
  p.wukv = (const float*)d_in[8]; p.onorm = (const float*)d_in[9]; p.wo = (const float*)d_in[10]; p.ln2 = (const float*)d_in[11];
  p.pwq = (const float*)d_in[12]; p.pkeys = (const float*)d_in[13]; p.pu = (const float*)d_in[14]; p.pv = (const float*)d_in[15];
  p.fnorm = (const float*)d_in[16];
  p.out = (float*)d_out;
  p.ws = (char*)d_ws;
  if (WS_NEED + XCD_BAR_WORDS * sizeof(unsigned) > ws_size) { fprintf(stderr, "kernel_launch: workspace too small (%zu > %zu)\n", (size_t)WS_NEED, ws_size); return; }

#if MEGA
  static int grid_blocks = 0;
  if (!grid_blocks) {
    int dev = 0, cus = 0, per_cu = 0;
    hipGetDevice(&dev);
    hipDeviceGetAttribute(&cus, hipDeviceAttributeMultiprocessorCount, dev);
    hipOccupancyMaxActiveBlocksPerMultiprocessor(&per_cu, mega_coop, NTHR, 0);
    if (per_cu > 1) per_cu = 1;
    if (per_cu < 1) per_cu = 1;
    grid_blocks = (cus * per_cu) & ~7;
  }
  (void)hipMemsetAsync(p.ws + WS_NEED, 0, XCD_BAR_WORDS * sizeof(unsigned), stream);
  void* args[] = {&p};
  hipError_t e = hipLaunchCooperativeKernel((void*)mega_coop, dim3(grid_blocks), dim3(NTHR), args, 0, stream);
  if (e != hipSuccess) fprintf(stderr, "cooperative launch failed: %s (grid %d)\n", hipGetErrorString(e), grid_blocks);
#else
  const dim3 g(256), b(NTHR);
  k_prologue<<<g, b, 0, stream>>>(p, 0);
  for (int L = 0; L < 2; ++L) {
    k_gemm1<<<g, b, 0, stream>>>(p, L);
    k_mix<<<g, b, 0, stream>>>(p, L);
    k_mla<<<g, b, 0, stream>>>(p, L);
    k_gemm_o<<<g, b, 0, stream>>>(p, L);
    k_gemm_pq<<<g, b, 0, stream>>>(p, L);
    k_select<<<g, b, 0, stream>>>(p, L);
    k_gather<<<g, b, 0, stream>>>(p, L);
  }
#endif
}
```

```cpp
#include <hip/hip_runtime.h>
#include <hip/hip_cooperative_groups.h>
#include <cstdio>
namespace cg = cooperative_groups;

#ifndef MEGA
#define MEGA 1
#endif

#define DI __device__ __forceinline__
typedef unsigned short u16;
typedef unsigned int u32;
using bf16x8 = __attribute__((ext_vector_type(8))) short;
using f32x16 = __attribute__((ext_vector_type(16))) float;
typedef __bf16 bf16x2_t __attribute__((ext_vector_type(2)));
typedef float float2_t __attribute__((ext_vector_type(2)));
typedef unsigned int u32x4 __attribute__((ext_vector_type(4)));
typedef unsigned int u32x2 __attribute__((ext_vector_type(2)));

constexpr int T = 16384, SEQ = 4096, DM = 2048, HLD = 4096;
constexpr int NTHR = 512, NWAVE = 8;
constexpr int NEXP = 16384;
constexpr float EPS = 1e-6f;
constexpr float LOG2E = 1.4426950408889634f;
constexpr float QSCALE_AB = 0.08838834764831845f * LOG2E;
constexpr float QSCALE_C = 0.07216878364870323f * LOG2E;
constexpr float U_SCALE = 90.5f, V_SCALE = 8.f;
constexpr int LDT = 72;
constexpr int GEMM_STAGE = 512 * LDT;
constexpr int GEMM_SROW_OFF = 2 * GEMM_STAGE * 2;
constexpr int SMEM_BYTES = 256 * 132 * 4 + 256 * 16 * 4;

#define MFMA32(a, b, c) __builtin_amdgcn_mfma_f32_32x32x16_bf16((a), (b), (c), 0, 0, 0)

constexpr size_t al256(size_t x) { return (x + 255) & ~(size_t)255; }
constexpr size_t OFF_wt_in = 0;
constexpr size_t OFF_wt_o = OFF_wt_in + al256((size_t)2 * HLD * 2048 * 2);
constexpr size_t OFF_wt_pq = OFF_wt_o + al256((size_t)2 * 2048 * 2048 * 2);
constexpr size_t OFF_wt_uq = OFF_wt_pq + al256((size_t)2 * 1024 * 2048 * 2);
constexpr size_t OFF_wt_ukv = OFF_wt_uq + al256((size_t)2 * 768 * 512 * 2);
constexpr size_t OFF_keys_b = OFF_wt_ukv + al256((size_t)2 * 1024 * 256 * 2);
constexpr size_t OFF_ub = OFF_keys_b + al256((size_t)2 * 256 * 128 * 2);
constexpr size_t OFF_vb = OFF_ub + al256((size_t)2 * NEXP * 1024);
constexpr size_t OFF_ropeC = OFF_vb + al256((size_t)2 * NEXP * 1024);
constexpr size_t OFF_ropeS = OFF_ropeC + al256((size_t)SEQ * 32 * 4);
constexpr size_t OFF_xres = OFF_ropeS + al256((size_t)SEQ * 32 * 4);
constexpr size_t OFF_xb = OFF_xres + al256((size_t)T * 2048 * 4);
constexpr size_t OFF_h = OFF_xb + al256((size_t)T * 2048 * 2);
constexpr size_t OFF_vtA = OFF_h + al256((size_t)T * HLD * 2);
constexpr size_t OFF_vtB = OFF_vtA + al256((size_t)T * 256 * 2);
constexpr size_t OFF_kmla = OFF_vtB + al256((size_t)T * 512 * 2);
constexpr size_t OFF_vtC = OFF_kmla + al256((size_t)T * 4 * 192 * 2);
constexpr size_t OFF_qmla = OFF_vtC + al256((size_t)T * 512 * 2);
constexpr size_t OFF_o = OFF_qmla + al256((size_t)T * 4 * 192 * 2);
constexpr size_t OFF_on = OFF_o + al256((size_t)T * 2048 * 2);
constexpr size_t OFF_ssqh = OFF_on + al256((size_t)T * 2048 * 2);
constexpr size_t OFF_END1 = OFF_ssqh + al256((size_t)T * 16 * 4);
constexpr size_t OFF_pq = OFF_h;
constexpr size_t OFF_scores = OFF_pq + al256((size_t)T * 1024 * 2);
constexpr size_t OFF_idx = OFF_scores + al256((size_t)T * 8 * 256 * 4);
constexpr size_t OFF_g = OFF_idx + al256((size_t)T * 128 * 4);
constexpr size_t OFF_END2 = OFF_g + al256((size_t)T * 128 * 4);
constexpr size_t WS_NEED = OFF_END1 > OFF_END2 ? OFF_END1 : OFF_END2;

struct Params {
  const float *x, *ln1, *w_in, *a_sink, *b_rel, *cqn, *ckvn, *wuq, *wukv, *onorm, *wo, *ln2, *pwq, *pkeys, *pu, *pv, *fnorm;
  float* out;
  char* ws;
  DI u16* wt_in() const { return (u16*)(ws + OFF_wt_in); }
  DI u16* wt_o() const { return (u16*)(ws + OFF_wt_o); }
  DI u16* wt_pq() const { return (u16*)(ws + OFF_wt_pq); }
  DI u16* wt_uq() const { return (u16*)(ws + OFF_wt_uq); }
  DI u16* wt_ukv() const { return (u16*)(ws + OFF_wt_ukv); }
  DI u16* keys_b() const { return (u16*)(ws + OFF_keys_b); }
  DI unsigned char* ub() const { return (unsigned char*)(ws + OFF_ub); }
  DI unsigned char* vb() const { return (unsigned char*)(ws + OFF_vb); }
  DI float* ropeC() const { return (float*)(ws + OFF_ropeC); }
  DI float* ropeS() const { return (float*)(ws + OFF_ropeS); }
  DI float* xres() const { return (float*)(ws + OFF_xres); }
  DI u16* xb() const { return (u16*)(ws + OFF_xb); }
  DI u16* h() const { return (u16*)(ws + OFF_h); }
  DI u16* vtA() const { return (u16*)(ws + OFF_vtA); }
  DI u16* vtB() const { return (u16*)(ws + OFF_vtB); }
  DI u16* kmla() const { return (u16*)(ws + OFF_kmla); }
  DI u16* vtC() const { return (u16*)(ws + OFF_vtC); }
  DI u16* qmla() const { return (u16*)(ws + OFF_qmla); }
  DI u16* o() const { return (u16*)(ws + OFF_o); }
  DI u16* on() const { return (u16*)(ws + OFF_on); }
  DI float* ssqh() const { return (float*)(ws + OFF_ssqh); }
  DI u16* pq() const { return (u16*)(ws + OFF_pq); }
  DI float* scores() const { return (float*)(ws + OFF_scores); }
  DI int* idx() const { return (int*)(ws + OFF_idx); }
  DI float* g() const { return (float*)(ws + OFF_g); }
};

DI int otid() { int t = threadIdx.x; asm volatile("" : "+v"(t)); return t; }
DI int obid() { int b = blockIdx.x; asm volatile("" : "+s"(b)); return b; }
DI u16 f2bf(float x) {
  u32 u = __float_as_uint(x);
  u += 0x7fffu + ((u >> 16) & 1u);
  return (u16)(u >> 16);
}
DI u32 pack2bf(float a, float b) {
  float2_t f = {a, b};
  bf16x2_t r = __builtin_convertvector(f, bf16x2_t);
  return __builtin_bit_cast(u32, r);
}
DI float bf_lo(u32 w) { return __uint_as_float(w << 16); }
DI float bf_hi(u32 w) { return __uint_as_float(w & 0xffff0000u); }
DI int crow(int r, int h) { return (r & 3) + 8 * (r >> 2) + 4 * h; }
DI float wave_sum(float v) {
#pragma unroll
  for (int o = 32; o >= 1; o >>= 1) v += __shfl_xor(v, o);
  return v;
}
DI float ssq8(u32x4 w) {
  float s = 0.f, a;
  a = bf_lo(w.x); s += a * a; a = bf_hi(w.x); s += a * a;
  a = bf_lo(w.y); s += a * a; a = bf_hi(w.y); s += a * a;
  a = bf_lo(w.z); s += a * a; a = bf_hi(w.z); s += a * a;
  a = bf_lo(w.w); s += a * a; a = bf_hi(w.w); s += a * a;
  return s;
}
DI bool gemm_tile_map(int it, int MT, int NT, int& mt, int& nt) {
  const int b = obid(), x = b & 7, nb = gridDim.x >> 3;
  const int li = it * nb + (b >> 3);
  const int nrn = (NT + 7) >> 3, nrect = (MT >> 3) * nrn;
  const int q = x + 8 * (li >> 6);
  if (q >= nrect) { mt = -1; nt = 0; return false; }
  const int in = li & 63;
  mt = (q / nrn) * 8 + (in >> 3);
  nt = (q % nrn) * 8 + (in & 7);
  return nt < NT;
}

constexpr int GM = 256, GN = 256;
DI u32x4 scale8(u32x4 w, float sc) {
  w.x = pack2bf(bf_lo(w.x) * sc, bf_hi(w.x) * sc);
  w.y = pack2bf(bf_lo(w.y) * sc, bf_hi(w.y) * sc);
  w.z = pack2bf(bf_lo(w.z) * sc, bf_hi(w.z) * sc);
  w.w = pack2bf(bf_lo(w.w) * sc, bf_hi(w.w) * sc);
  return w;
}
template <bool ROWNORM, bool CONV = false, bool ASCALE = false>
DI void gemm_mainloop(const u16* __restrict__ Ag, int lda, const u16* __restrict__ Bg, int ldb, int K, char* smem,
                      f32x16 (&acc)[4][2], const float4* __restrict__ csrc = nullptr, u16* __restrict__ cdst = nullptr,
                      float cscale = 1.f) {
  u16* sbase = (u16*)smem;
  float* sRow = (float*)(smem + GEMM_SROW_OFF);
  const int tid = otid(), lane = tid & 63, wid = tid >> 6;
  const int wm = wid >> 2, wn = wid & 3, hh = lane >> 5, l31 = lane & 31;
  const int lr = tid >> 3, lc = (tid & 7) * 8;
#pragma unroll
  for (int i = 0; i < 4; ++i)
#pragma unroll
    for (int j = 0; j < 2; ++j)
#pragma unroll
      for (int r = 0; r < 16; ++r) acc[i][j][r] = 0.f;
  u32x4 ra[4], rb[4];
  float ssq[4] = {0.f, 0.f, 0.f, 0.f};
  const u16* ap = Ag + (size_t)lr * lda + lc;
  const u16* bp = Bg + (size_t)lr * ldb + lc;
#pragma unroll
  for (int i = 0; i < 4; ++i) {
    ra[i] = *(const u32x4*)(ap + (size_t)(64 * i) * lda);
    rb[i] = *(const u32x4*)(bp + (size_t)(64 * i) * ldb);
  }
  __syncthreads();
#pragma unroll
  for (int i = 0; i < 4; ++i) {
    if (ASCALE) ra[i] = scale8(ra[i], sRow[(lr + 64 * i) * 4 + 0]);
    *(u32x4*)(sbase + (lr + 64 * i) * LDT + lc) = ra[i];
    *(u32x4*)(sbase + (256 + lr + 64 * i) * LDT + lc) = rb[i];
    if (ROWNORM) ssq[i] += ssq8(ra[i]);
  }
  __syncthreads();
  const int nk = K >> 6;
#pragma unroll 1
  for (int kt = 0; kt < nk; ++kt) {
    const int cur = kt & 1;
    const bool more = (kt + 1 < nk);
    const int kn = more ? kt + 1 : kt;
    float4 cv;
    if (CONV) cv = csrc[(size_t)kt * NTHR + tid];
#pragma unroll
    for (int i = 0; i < 4; ++i) {
      ra[i] = *(const u32x4*)(ap + (size_t)(64 * i) * lda + kn * 64);
      rb[i] = *(const u32x4*)(bp + (size_t)(64 * i) * ldb + kn * 64);
    }
    const u16* a_s = sbase + cur * GEMM_STAGE + (wm * 128 + l31) * LDT + hh * 8;
    const u16* b_s = sbase + cur * GEMM_STAGE + (256 + wn * 64 + l31) * LDT + hh * 8;
#pragma unroll
    for (int ks = 0; ks < 4; ++ks) {
      const bf16x8 b0 = *(const bf16x8*)(b_s + ks * 16);
      const bf16x8 b1 = *(const bf16x8*)(b_s + 32 * LDT + ks * 16);
      bf16x8 a0[4];
#pragma unroll
      for (int i = 0; i < 4; ++i) a0[i] = *(const bf16x8*)(a_s + i * 32 * LDT + ks * 16);
      __builtin_amdgcn_s_setprio(1);
#pragma unroll
      for (int i = 0; i < 4; ++i) {
        acc[i][0] = MFMA32(a0[i], b0, acc[i][0]);
        acc[i][1] = MFMA32(a0[i], b1, acc[i][1]);
      }
      __builtin_amdgcn_s_setprio(0);
    }
    {
      u16* w = sbase + (cur ^ 1) * GEMM_STAGE;
      const int g = (kn < 16) ? 0 : (kn < 24 ? 1 : 2);
#pragma unroll
      for (int i = 0; i < 4; ++i) {
        if (ASCALE) ra[i] = scale8(ra[i], sRow[(lr + 64 * i) * 4 + g]);
        *(u32x4*)(w + (lr + 64 * i) * LDT + lc) = ra[i];
        *(u32x4*)(w + (256 + lr + 64 * i) * LDT + lc) = rb[i];
        if (ROWNORM) ssq[i] += more ? ssq8(ra[i]) : 0.f;
      }
    }
    if (CONV) {
      u32 w4 = 0;
      w4 = __builtin_amdgcn_cvt_scalef32_pk_fp4_f32(w4, cv.x * cscale, cv.y * cscale, 1.0f, 0);
      w4 = __builtin_amdgcn_cvt_scalef32_pk_fp4_f32(w4, cv.z * cscale, cv.w * cscale, 1.0f, 1);
      cdst[(size_t)kt * NTHR + tid] = (u16)w4;
    }
    __syncthreads();
  }
  if (ROWNORM) {
#pragma unroll
    for (int i = 0; i < 4; ++i) {
      float s = ssq[i];
      s += __shfl_xor(s, 1);
      s += __shfl_xor(s, 2);
      s += __shfl_xor(s, 4);
      if ((tid & 7) == 0) sRow[lr + 64 * i] = rsqrtf(s / (float)K + EPS);
    }
    __syncthreads();
  }
}

DI void conv_transpose_all(const Params& p, char* smem) {
  const int lane = otid() & 63, wid = otid() >> 6;
  float* s = (float*)smem + wid * (64 * 65);
  constexpr int T0 = 32 * 61, T1 = T0 + 32 * 32, T2 = T1 + 32 * 16, T3 = T2 + 8 * 12, T4 = T3 + 4 * 16;
  for (int f = obid() * NWAVE + wid; f < 2 * T4; f += gridDim.x * NWAVE) {
    const int L = f / T4, r = f % T4;
    const float* W; const float* g; u16* Wt; int K, N, tile;
    if (r < T0)      { W = p.w_in + (size_t)L * 2048 * 3904; g = p.ln1 + L * 2048;   Wt = p.wt_in() + (size_t)L * HLD * 2048;   K = 2048; N = 3904; tile = r; }
    else if (r < T1) { W = p.wo + (size_t)L * 2048 * 2048;   g = p.onorm + L * 2048; Wt = p.wt_o() + (size_t)L * 2048 * 2048;   K = 2048; N = 2048; tile = r - T0; }
    else if (r < T2) { W = p.pwq + (size_t)L * 2048 * 1024;  g = p.ln2 + L * 2048;   Wt = p.wt_pq() + (size_t)L * 1024 * 2048;  K = 2048; N = 1024; tile = r - T1; }
    else if (r < T3) { W = p.wuq + (size_t)L * 512 * 768;    g = p.cqn + L * 512;    Wt = p.wt_uq() + (size_t)L * 768 * 512;    K = 512;  N = 768;  tile = r - T2; }
    else             { W = p.wukv + (size_t)L * 256 * 1024;  g = p.ckvn + L * 256;   Wt = p.wt_ukv() + (size_t)L * 1024 * 256;  K = 256;  N = 1024; tile = r - T3; }
    const int ntn = N / 64;
    const int k0 = (tile / ntn) * 64, n0 = (tile % ntn) * 64;
#pragma unroll 8
    for (int kk = 0; kk < 64; ++kk) s[kk * 65 + lane] = W[(size_t)(k0 + kk) * N + n0 + lane] * g[k0 + kk];
    __builtin_amdgcn_fence(__ATOMIC_RELEASE, "wavefront");
    __builtin_amdgcn_wave_barrier();
    __builtin_amdgcn_fence(__ATOMIC_ACQUIRE, "wavefront");
#pragma unroll 8
    for (int nn = 0; nn < 64; ++nn) Wt[(size_t)(n0 + nn) * K + k0 + lane] = f2bf(s[lane * 65 + nn]);
    __builtin_amdgcn_fence(__ATOMIC_RELEASE, "wavefront");
    __builtin_amdgcn_wave_barrier();
    __builtin_amdgcn_fence(__ATOMIC_ACQUIRE, "wavefront");
  }
}
DI void conv_flat(const float* __restrict__ src, u16* __restrict__ dst, size_t n4) {
  for (size_t i = (size_t)obid() * NTHR + otid(); i < n4; i += (size_t)gridDim.x * NTHR) {
    float4 v = ((const float4*)src)[i];
    u32x2 w = {pack2bf(v.x, v.y), pack2bf(v.z, v.w)};
    ((u32x2*)dst)[i] = w;
  }
}
DI void conv_fp4(const float* __restrict__ src, unsigned char* __restrict__ dst, size_t n8, float sc) {
  for (size_t i = (size_t)obid() * NTHR + otid(); i < n8; i += (size_t)gridDim.x * NTHR) {
    const float4 a = ((const float4*)src)[i * 2 + 0], b = ((const float4*)src)[i * 2 + 1];
    u32 w = 0;
    w = __builtin_amdgcn_cvt_scalef32_pk_fp4_f32(w, a.x * sc, a.y * sc, 1.0f, 0);
    w = __builtin_amdgcn_cvt_scalef32_pk_fp4_f32(w, a.z * sc, a.w * sc, 1.0f, 1);
    w = __builtin_amdgcn_cvt_scalef32_pk_fp4_f32(w, b.x * sc, b.y * sc, 1.0f, 2);
    w = __builtin_amdgcn_cvt_scalef32_pk_fp4_f32(w, b.z * sc, b.w * sc, 1.0f, 3);
    ((u32*)dst)[i] = w;
  }
}
DI void phase_prologue(const Params& p, char* smem) {
  __syncthreads();
  conv_transpose_all(p, smem);
  for (int L = 0; L < 2; ++L) {
    u16* pad = p.wt_in() + (size_t)L * HLD * 2048 + (size_t)3904 * 2048;
    for (int i = obid() * NTHR + otid(); i < 192 * 2048 / 8; i += gridDim.x * NTHR) ((u32x4*)pad)[i] = u32x4{0, 0, 0, 0};
  }
  for (int i = obid() * NTHR + otid(); i < 2 * 256 * 128; i += gridDim.x * NTHR) {
    const int L = i >> 15, n = (i >> 7) & 255, k = i & 127;
    const int c = n >> 7, kin = k - 64 * c;
    const float v = (kin >= 0 && kin < 64) ? p.pkeys[((size_t)(L * 2 + c) * 128 + (n & 127)) * 64 + kin] : 0.f;
    p.keys_b()[i] = f2bf(v);
  }
  conv_flat(p.x, p.xb(), (size_t)T * 2048 / 4);
  for (int i = obid() * NTHR + otid(); i < SEQ * 32; i += gridDim.x * NTHR) {
    const int pos = i >> 5, f = i & 31;
    const float inv = powf(10000.0f, -(float)f / 32.0f);
    const float ang = (float)pos * inv;
    p.ropeC()[i] = cosf(ang);
    p.ropeS()[i] = sinf(ang);
  }
}

#define EPI_IDS                                                                                     \
  const int etid = otid();                                                                          \
  const int lane = etid & 63, wid = etid >> 6, wm = wid >> 2, wn = wid & 3, hh = lane >> 5, l31 = lane & 31;

constexpr int EPI_TS = 264;
#define EPI_LDS_WRITE(SCALE_EXPR)                                                             \
  {                                                                                           \
    u16* sT_ = (u16*)smem;                                                                    \
    _Pragma("unroll") for (int i = 0; i < 4; ++i)                                             \
      _Pragma("unroll") for (int j = 0; j < 2; ++j)                                           \
        _Pragma("unroll") for (int r = 0; r < 16; ++r) {                                      \
          const int rl = wm * 128 + i * 32 + crow(r, hh);                                     \
          sT_[rl * EPI_TS + wn * 64 + j * 32 + l31] = f2bf(acc[i][j][r] * (SCALE_EXPR));      \
        }                                                                                     \
    __syncthreads();                                                                          \
  }

DI void phase_gemm1(const Params& p, int L, char* smem) {
  const u16* Wt = p.wt_in() + (size_t)L * HLD * 2048;
  const float* sRow = (const float*)(smem + GEMM_SROW_OFF);
  for (int it = 0;; ++it) {
    int mt, nt;
    if (!gemm_tile_map(it, 64, 16, mt, nt)) { if (mt < 0) break; continue; }
    f32x16 acc[4][2];
    const int tile_id = mt * 16 + nt;
    const bool isv = tile_id >= 512;
    const float4* csrc = (const float4*)((isv ? p.pv : p.pu) + (size_t)L * NEXP * 2048) + (size_t)(tile_id & 511) * 32 * NTHR;
    u16* cdst = (u16*)((isv ? p.vb() : p.ub()) + (size_t)L * NEXP * 1024) + (size_t)(tile_id & 511) * 32 * NTHR;
    gemm_mainloop<true, true>(p.xb() + (size_t)mt * GM * 2048, 2048, Wt + (size_t)nt * GN * 2048, 2048, 2048, smem, acc, csrc, cdst,
                              isv ? V_SCALE : U_SCALE);
    EPI_IDS
    const int nt128 = nt * 2 + (wn >> 1), wn1 = wn & 1;
    const int m0 = mt * GM, b = m0 >> 12, s0 = m0 & 4095;
    const bool plain = (nt != 5) && (nt != 10) && (nt != 11) && (nt != 15);
    if (plain) {
      const float sc = (nt < 4 || nt == 6 || nt == 7) ? QSCALE_AB : 1.f;
      EPI_LDS_WRITE(sRow[rl] * sc)
      const u16* sT = (const u16*)smem;
#pragma unroll 4
      for (int it = 0; it < 16; ++it) {
        const int c = etid + NTHR * it, row = c >> 5, cc = c & 31;
        *(u32x4*)(p.h() + (size_t)(m0 + row) * HLD + nt * GN + cc * 8) = *(const u32x4*)(sT + row * EPI_TS + cc * 8);
      }
    } else {
    if (nt128 >= 30) {
      if (nt128 == 30 && wn1 == 0) {
#pragma unroll
        for (int i = 0; i < 4; ++i)
#pragma unroll
          for (int r = 0; r < 16; ++r) {
            const int rl = wm * 128 + i * 32 + crow(r, hh);
            const float rs = sRow[rl];
            const float x1 = acc[i][0][r] * rs, x2 = acc[i][1][r] * rs;
            const int pos = s0 + rl;
            const float c = p.ropeC()[pos * 32 + l31], sn = p.ropeS()[pos * 32 + l31];
            const u16 o1 = f2bf(x1 * c - x2 * sn), o2 = f2bf(x1 * sn + x2 * c);
#pragma unroll
            for (int hd = 0; hd < 4; ++hd) {
              u16* kr = p.kmla() + ((size_t)(b * 4 + hd) * 4096 + pos) * 192 + 128;
              kr[l31] = o1;
              kr[32 + l31] = o2;
            }
            if ((r & 3) == 3) __builtin_amdgcn_sched_barrier(0);
          }
      }
    } else if (nt128 == 10 || nt128 == 11 || (nt128 >= 20 && nt128 < 24)) {
      u16* vt;
      int nh, hd;
      if (nt128 < 12) { vt = p.vtA(); nh = 2; hd = nt128 - 10; } else { vt = p.vtB(); nh = 4; hd = nt128 - 20; }
#pragma unroll
      for (int i = 0; i < 4; ++i)
#pragma unroll
        for (int j = 0; j < 2; ++j)
#pragma unroll
          for (int g4 = 0; g4 < 4; ++g4) {
            const int rl0 = wm * 128 + i * 32 + 8 * g4 + 4 * hh;
            const int d = wn1 * 64 + j * 32 + l31;
            const float v0 = acc[i][j][4 * g4 + 0] * sRow[rl0 + 0], v1 = acc[i][j][4 * g4 + 1] * sRow[rl0 + 1];
            const float v2 = acc[i][j][4 * g4 + 2] * sRow[rl0 + 2], v3 = acc[i][j][4 * g4 + 3] * sRow[rl0 + 3];
            u32x2 w = {pack2bf(v0, v1), pack2bf(v2, v3)};
            *(u32x2*)(vt + ((size_t)(b * nh + hd) * 128 + d) * 4096 + s0 + rl0) = w;
          }
    } else {
      const float sc = (nt128 < 8 || (nt128 >= 12 && nt128 < 16)) ? QSCALE_AB : 1.f;
#pragma unroll
      for (int i = 0; i < 4; ++i)
#pragma unroll
        for (int j = 0; j < 2; ++j)
#pragma unroll
          for (int r = 0; r < 16; ++r) {
            const int rl = wm * 128 + i * 32 + crow(r, hh);
            p.h()[(size_t)(m0 + rl) * HLD + nt128 * 128 + wn1 * 64 + j * 32 + l31] = f2bf(acc[i][j][r] * sRow[rl] * sc);
          }
    }
    }
  }
}

DI void tile_upq(const Params& p, int L, int tile, char* smem) {
  const float* sRow = (const float*)(smem + GEMM_SROW_OFF);
  const int mt = tile / 3, nt = tile % 3;
  f32x16 acc[4][2];
  gemm_mainloop<true>(p.h() + (size_t)mt * GM * HLD + 3072, HLD, p.wt_uq() + (size_t)L * 768 * 512 + (size_t)nt * GN * 512, 512, 512,
                      smem, acc);
  EPI_IDS
  const int m0 = mt * GM, b = m0 >> 12, s0 = m0 & 4095;
  EPI_LDS_WRITE(sRow[rl] * QSCALE_C)
  {
    const u16* sT = (const u16*)smem;
#pragma unroll 4
    for (int it = 0; it < 16; ++it) {
      const int c = etid + NTHR * it, row = c >> 5, cc = c & 31;
      const int nb64 = nt * 4 + (cc >> 3);
      const int head = nb64 / 3, part = nb64 % 3;
      *(u32x4*)(p.qmla() + ((size_t)(b * 4 + head) * 4096 + s0 + row) * 192 + part * 64 + (cc & 7) * 8) = *(const u32x4*)(sT + row * EPI_TS + cc * 8);
    }
  }
}

DI void tile_upkv(const Params& p, int L, int tile, char* smem) {
  const float* sRow = (const float*)(smem + GEMM_SROW_OFF);
  const int mt = tile >> 2, nt = tile & 3;
  f32x16 acc[4][2];
  gemm_mainloop<true>(p.h() + (size_t)mt * GM * HLD + 3584, HLD, p.wt_ukv() + (size_t)L * 1024 * 256 + (size_t)nt * GN * 256, 256, 256,
                      smem, acc);
  EPI_IDS
  const int nt128 = nt * 2 + (wn >> 1), wn1 = wn & 1;
  const int m0 = mt * GM, b = m0 >> 12, s0 = m0 & 4095;
  const int head = nt128 >> 1;
  EPI_LDS_WRITE(sRow[rl])
  {
    const u16* sT = (const u16*)smem;
#pragma unroll 4
    for (int it = 0; it < 8; ++it) {
      const int c = etid + NTHR * it, row = c >> 4, cc = c & 15;
      *(u32x4*)(p.kmla() + ((size_t)(b * 4 + nt) * 4096 + s0 + row) * 192 + cc * 8) = *(const u32x4*)(sT + row * EPI_TS + cc * 8);
    }
  }
  if (nt128 & 1) {
#pragma unroll
    for (int i = 0; i < 4; ++i)
#pragma unroll
      for (int j = 0; j < 2; ++j)
#pragma unroll
        for (int g4 = 0; g4 < 4; ++g4) {
          const int rl0 = wm * 128 + i * 32 + 8 * g4 + 4 * hh;
          const int d = wn1 * 64 + j * 32 + l31;
          const float v0 = acc[i][j][4 * g4 + 0] * sRow[rl0 + 0], v1 = acc[i][j][4 * g4 + 1] * sRow[rl0 + 1];
          const float v2 = acc[i][j][4 * g4 + 2] * sRow[rl0 + 2], v3 = acc[i][j][4 * g4 + 3] * sRow[rl0 + 3];
          u32x2 w = {pack2bf(v0, v1), pack2bf(v2, v3)};
          *(u32x2*)(p.vtC() + ((size_t)(b * 4 + head) * 128 + d) * 4096 + s0 + rl0) = w;
        }
  }
}

DI void phase_gemm_o(const Params& p, int L, char* smem) {
  const u16* Wt = p.wt_o() + (size_t)L * 2048 * 2048;
  for (int it = 0;; ++it) {
    int mt, nt;
    if (!gemm_tile_map(it, 64, 8, mt, nt)) { if (mt < 0) break; continue; }
    f32x16 acc[4][2];
    {
      float* sRow = (float*)(smem + GEMM_SROW_OFF);
      const int t = otid();
      __syncthreads();
      if (t < 256) {
        const float4* sp = (const float4*)(p.ssqh() + (size_t)(mt * GM + t) * 16);
        const float4 a0 = sp[0], a1 = sp[1], b0 = sp[2], c0 = sp[3];
        sRow[t * 4 + 0] = rsqrtf((a0.x + a0.y + a0.z + a0.w + a1.x + a1.y + a1.z + a1.w) * (1.f / 1024.f) + EPS);
        sRow[t * 4 + 1] = rsqrtf((b0.x + b0.y + b0.z + b0.w) * (1.f / 512.f) + EPS);
        sRow[t * 4 + 2] = rsqrtf((c0.x + c0.y + c0.z + c0.w) * (1.f / 512.f) + EPS);
      }
    }
    gemm_mainloop<false, false, true>(p.o() + (size_t)mt * GM * 2048, 2048, Wt + (size_t)nt * GN * 2048, 2048, 2048, smem, acc);
    EPI_IDS
    EPI_LDS_WRITE(1.f)
    {
      const u16* sT = (const u16*)smem;
#pragma unroll 4
      for (int it = 0; it < 16; ++it) {
        const int c = etid + NTHR * it, row = c >> 5, cc = c & 31;
        u16* xp = p.xb() + (size_t)(mt * GM + row) * 2048 + nt * GN + cc * 8;
        const u32x4 d = *(const u32x4*)(sT + row * EPI_TS + cc * 8);
        u32x4 x = *(const u32x4*)xp;
        x.x = pack2bf(bf_lo(x.x) + bf_lo(d.x), bf_hi(x.x) + bf_hi(d.x));
        x.y = pack2bf(bf_lo(x.y) + bf_lo(d.y), bf_hi(x.y) + bf_hi(d.y));
        x.z = pack2bf(bf_lo(x.z) + bf_lo(d.z), bf_hi(x.z) + bf_hi(d.z));
        x.w = pack2bf(bf_lo(x.w) + bf_lo(d.w), bf_hi(x.w) + bf_hi(d.w));
        *(u32x4*)xp = x;
      }
    }
  }
}

DI void phase_gemm_pq(const Params& p, int L, char* smem) {
  const u16* Wt = p.wt_pq() + (size_t)L * 1024 * 2048;
  const float* sRow = (const float*)(smem + GEMM_SROW_OFF);
  for (int tile = obid(); tile < 64 * 4; tile += gridDim.x) {
    const int mt = tile >> 2, nt = tile & 3;
    f32x16 acc[4][2];
    gemm_mainloop<true>(p.xb() + (size_t)mt * GM * 2048, 2048, Wt + (size_t)nt * GN * 2048, 2048, 2048, smem, acc);
    EPI_IDS
    EPI_LDS_WRITE(sRow[rl])
    {
      const u16* sT = (const u16*)smem;
#pragma unroll 4
      for (int it = 0; it < 16; ++it) {
        const int c = etid + NTHR * it, row = c >> 5, cc = c & 31;
        *(u32x4*)(p.pq() + (size_t)(mt * GM + row) * 1024 + nt * GN + cc * 8) = *(const u32x4*)(sT + row * EPI_TS + cc * 8);
      }
    }
  }
}

DI void phase_gemm_scores(const Params& p, int L, char* smem) {
  for (int mt = obid(); mt < 512; mt += gridDim.x) {
    f32x16 acc[4][2];
    gemm_mainloop<false>(p.pq() + (size_t)mt * GM * 128, 128, p.keys_b() + (size_t)L * 256 * 128, 128, 128, smem, acc);
    EPI_IDS
#pragma unroll
    for (int i = 0; i < 4; ++i)
#pragma unroll
      for (int j = 0; j < 2; ++j)
#pragma unroll
        for (int r = 0; r < 16; ++r) {
          const int rl = wm * 128 + i * 32 + crow(r, hh);
          p.scores()[(size_t)(mt * GM + rl) * 256 + wn * 64 + j * 32 + l31] = acc[i][j][r];
        }
  }
}

template <int DQK, int MODE>
DI void attn_block(char* smem, const u16* __restrict__ Q, int ldq, const u16* __restrict__ Kb, int ldk,
                   const u16* __restrict__ Vt, int t0, int t1, int qpos0, float slope2, float sink2,
                   const float* __restrict__ biasTbl, u16* __restrict__ Oout, float* __restrict__ ssq_out,
                   const float* __restrict__ ropeCS = nullptr) {
  constexpr int LDK = DQK + 8;
  constexpr int NCH = DQK / 8;
  constexpr int KCH = NCH / 8;
  constexpr int NKS = DQK / 16;
  constexpr int STG = 64 * LDK + 128 * 68;
  u16* sbase = (u16*)smem;
  float* sBias = (float*)(sbase + 2 * STG);
  const int tid = otid(), lane = tid & 63, wid = tid >> 6, hh = lane >> 5, l31 = lane & 31;

  __syncthreads();
  if (MODE == 1) {
    for (int i = tid; i < 465; i += NTHR) sBias[i] = biasTbl[i] * LOG2E;
  }
  bf16x8 qf[NKS];
  {
    const u16* qrow = Q + (size_t)(wid * 32 + l31) * ldq + hh * 8;
#pragma unroll
    for (int ks = 0; ks < NKS; ++ks) qf[ks] = *(const bf16x8*)(qrow + ks * 16);
  }
  if (MODE == 2) {
    const int pos = qpos0 + wid * 32 + l31;
#pragma unroll
    for (int k2 = 0; k2 < 2; ++k2) {
      const float* cp = ropeCS + (size_t)pos * 32 + k2 * 16 + 8 * hh;
      const float* sp = ropeCS + (size_t)SEQ * 32 + (size_t)pos * 32 + k2 * 16 + 8 * hh;
#pragma unroll
      for (int j = 0; j < 8; ++j) {
        const float c = cp[j], sn = sp[j];
        const float x1 = __uint_as_float(((u32)(u16)qf[NKS - 4 + k2][j]) << 16);
        const float x2 = __uint_as_float(((u32)(u16)qf[NKS - 2 + k2][j]) << 16);
        qf[NKS - 4 + k2][j] = (short)f2bf(x1 * c - x2 * sn);
        qf[NKS - 2 + k2][j] = (short)f2bf(x1 * sn + x2 * c);
      }
    }
  }
  constexpr float SM_THR = 6.f;
  float m_run = (MODE == 0) ? sink2 : 0.f;
  float l_run = (MODE == 0 && hh == 0) ? 1.f : 0.f;
  bool first = true;
  f32x16 oacc[4];
#pragma unroll
  for (int d = 0; d < 4; ++d)
#pragma unroll
    for (int r = 0; r < 16; ++r) oacc[d][r] = 0.f;

  const int widu = __builtin_amdgcn_readfirstlane(wid);
  const int qw0 = qpos0 + widu * 32;
  const int qpos = qw0 + l31;
  const int rq = (qpos0 >> 6) + (widu >> 1);
  const int rsq = min(max(rq - 4, 0), 56);
  const int cq = (wid & 1) * 32 + l31;
  const int cs = min(max(cq - 8, 0), 48);

  u32x4 rk[KCH], rv[2];
#define ATTN_LOAD_TILE(TT)                                                              \
  {                                                                                     \
    _Pragma("unroll") for (int i = 0; i < KCH; ++i) {                                   \
      const int c = tid + NTHR * i;                                                     \
      const int rr = c / NCH, cc = c % NCH;                                             \
      rk[i] = *(const u32x4*)(Kb + (size_t)((TT) * 64 + rr) * ldk + cc * 8);            \
    }                                                                                   \
    _Pragma("unroll") for (int i = 0; i < 2; ++i) {                                     \
      const int c = tid + NTHR * i;                                                     \
      const int d = c >> 3, part = c & 7;                                               \
      rv[i] = *(const u32x4*)(Vt + (size_t)d * 4096 + (TT) * 64 + part * 8);            \
    }                                                                                   \
  }
#define ATTN_STORE_TILE(STAGE)                                                          \
  {                                                                                     \
    u16* sKw = sbase + (STAGE) * STG;                                                   \
    u16* sVw = sKw + 64 * LDK;                                                          \
    _Pragma("unroll") for (int i = 0; i < KCH; ++i) {                                   \
      const int c = tid + NTHR * i;                                                     \
      const int rr = c / NCH, cc = c % NCH;                                             \
      *(u32x4*)(sKw + rr * LDK + cc * 8) = rk[i];                                       \
    }                                                                                   \
    _Pragma("unroll") for (int i = 0; i < 2; ++i) {                                     \
      const int c = tid + NTHR * i;                                                     \
      const int d = c >> 3, part = c & 7;                                               \
      *(u32x2*)(sVw + d * 68 + part * 8) = u32x2{rv[i].x, rv[i].y};                     \
      *(u32x2*)(sVw + d * 68 + part * 8 + 4) = u32x2{rv[i].z, rv[i].w};                 \
    }                                                                                   \
  }
  ATTN_LOAD_TILE(t0)
  ATTN_STORE_TILE(0)
  __syncthreads();
#pragma unroll 1
  for (int t = t0; t < t1; ++t) {
    const int cur = (t - t0) & 1;
    {
      const int tn = (t + 1 < t1) ? t + 1 : t;
      ATTN_LOAD_TILE(tn)
    }
    const u16* sK = sbase + cur * STG;
    const u16* sV = sK + 64 * LDK;
    bool relevant = true;
    if (MODE == 0) relevant = (t * 64 <= qw0 + 31 + 128) && (t * 64 + 63 >= qw0 - 128);
    if (MODE == 1) relevant = (t >= rsq) && (t < rsq + 8);
    if (relevant) {
      f32x16 sacc[2];
#pragma unroll
      for (int tt = 0; tt < 2; ++tt) {
#pragma unroll
        for (int r = 0; r < 16; ++r) sacc[tt][r] = -m_run;
        const u16* kp = sK + (tt * 32 + l31) * LDK + hh * 8;
#pragma unroll
        for (int ks = 0; ks < NKS; ++ks) {
          bf16x8 kf = *(const bf16x8*)(kp + ks * 16);
          sacc[tt] = MFMA32(kf, qf[ks], sacc[tt]);
        }
      }
      float mx = -INFINITY;
      const int drow = min(max(t - rq + 7, 0), 14) * 31;
#pragma unroll
      for (int tt = 0; tt < 2; ++tt)
#pragma unroll
        for (int r = 0; r < 16; ++r) {
          float sv = sacc[tt][r];
          const int kl = tt * 32 + crow(r, hh);
          if (MODE == 0) {
            const int kpos = t * 64 + kl;
            int dist = qpos - kpos;
            dist = dist < 0 ? -dist : dist;
            sv = (dist <= 128) ? (sv - slope2 * (float)dist) : -INFINITY;
          } else if (MODE == 1) {
            const bool ok = ((unsigned)(kl - cs) < 16u);
            const int dc = min(max(kl - cq + 15, 0), 30);
            sv = ok ? (sv + sBias[drow + dc]) : -INFINITY;
          }
          sacc[tt][r] = sv;
          mx = fmaxf(mx, sv);
        }
      mx = fmaxf(mx, __shfl_xor(mx, 32));
      if (__builtin_amdgcn_ballot_w64(first || (mx > SM_THR)) != 0ull) {
        float delta = fmaxf(mx, 0.f);
        if (first && MODE != 0) delta = (mx > -INFINITY) ? mx : 0.f;
        m_run += delta;
        const float alpha = __builtin_amdgcn_exp2f(-delta);
        l_run *= alpha;
#pragma unroll
        for (int d = 0; d < 4; ++d)
#pragma unroll
          for (int r = 0; r < 16; ++r) oacc[d][r] *= alpha;
#pragma unroll
        for (int tt = 0; tt < 2; ++tt)
#pragma unroll
          for (int r = 0; r < 16; ++r) sacc[tt][r] -= delta;
        first = false;
      }
      float ps = 0.f;
#pragma unroll
      for (int tt = 0; tt < 2; ++tt) {
#pragma unroll
        for (int r = 0; r < 16; ++r) {
          const float pv = __builtin_amdgcn_exp2f(sacc[tt][r]);
          sacc[tt][r] = pv;
          ps += pv;
        }
#pragma unroll
        for (int s2 = 0; s2 < 2; ++s2) {
          u32x4 w;
          w.x = pack2bf(sacc[tt][8 * s2 + 0], sacc[tt][8 * s2 + 1]);
          w.y = pack2bf(sacc[tt][8 * s2 + 2], sacc[tt][8 * s2 + 3]);
          w.z = pack2bf(sacc[tt][8 * s2 + 4], sacc[tt][8 * s2 + 5]);
          w.w = pack2bf(sacc[tt][8 * s2 + 6], sacc[tt][8 * s2 + 7]);
          const bf16x8 pf = __builtin_bit_cast(bf16x8, w);
#pragma unroll
          for (int dt = 0; dt < 4; ++dt) {
            const u16* vp = sV + (dt * 32 + l31) * 68 + 4 * hh;
            const u32x2 lo = *(const u32x2*)(vp + tt * 32 + s2 * 16);
            const u32x2 hi = *(const u32x2*)(vp + tt * 32 + s2 * 16 + 8);
            u32x4 wv = {lo.x, lo.y, hi.x, hi.y};
            oacc[dt] = MFMA32(__builtin_bit_cast(bf16x8, wv), pf, oacc[dt]);
          }
        }
      }
      l_run += ps;
    }
    ATTN_STORE_TILE(cur ^ 1)
    __syncthreads();
  }
  const float lt = l_run + __shfl_xor(l_run, 32);
  const float inv = 1.f / lt;
  float sq = 0.f;
  u16* orow = Oout + (size_t)(wid * 32 + l31) * 2048;
#pragma unroll
  for (int dt = 0; dt < 4; ++dt)
#pragma unroll
    for (int g4 = 0; g4 < 4; ++g4) {
      const float v0 = oacc[dt][4 * g4 + 0] * inv, v1 = oacc[dt][4 * g4 + 1] * inv;
      const float v2 = oacc[dt][4 * g4 + 2] * inv, v3 = oacc[dt][4 * g4 + 3] * inv;
      sq += v0 * v0 + v1 * v1 + v2 * v2 + v3 * v3;
      u32x2 w = {pack2bf(v0, v1), pack2bf(v2, v3)};
      *(u32x2*)(orow + dt * 32 + 8 * g4 + 4 * hh) = w;
    }
  sq += __shfl_xor(sq, 32);
  if (hh == 0) ssq_out[(size_t)(wid * 32 + l31) * 16] = sq;
}

DI void phase_mix(const Params& p, int L, char* smem) {
  for (int w = obid(); w < 256; w += gridDim.x) {
    const int b = w >> 6, rem = w & 63, rg = rem >> 2, hb = rem & 3;
    const int r0 = rg * 4;
    const int t0 = min(max(r0 - 4, 0), 56), t1 = min(max(r0 - 1, 0), 56) + 8;
    const size_t tok0 = (size_t)b * 4096 + r0 * 64;
    attn_block<128, 1>(smem, p.h() + tok0 * HLD + 1536 + hb * 128, HLD, p.h() + (size_t)b * 4096 * HLD + 2048 + hb * 128, HLD,
                       p.vtB() + (size_t)(b * 4 + hb) * 128 * 4096, t0, t1, r0 * 64, 0.f, 0.f,
                       p.b_rel + (size_t)L * 4 * 465 + hb * 465, p.o() + tok0 * 2048 + 1024 + hb * 128, p.ssqh() + tok0 * 16 + 8 + hb);
  }
  for (int ww = obid(); ww < 512; ww += gridDim.x) {
    const int b = ww >> 7, rem = ww & 127, sb = rem >> 3, hq = rem & 7;
    const int t0 = max(0, 4 * sb - 2), t1 = min(64, 4 * sb + 6);
    const size_t tok0 = (size_t)b * 4096 + sb * 256;
    const float slope2 = exp2f(-(float)(hq + 1)) * LOG2E;
    const float sink2 = p.a_sink[L * 8 + hq] * LOG2E;
    attn_block<128, 0>(smem, p.h() + tok0 * HLD + hq * 128, HLD, p.h() + (size_t)b * 4096 * HLD + 1024 + (hq >> 2) * 128, HLD,
                       p.vtA() + (size_t)(b * 2 + (hq >> 2)) * 128 * 4096, t0, t1, sb * 256, slope2, sink2, nullptr,
                       p.o() + tok0 * 2048 + hq * 128, p.ssqh() + tok0 * 16 + hq);
  }
  for (int w = (obid() + 64) % gridDim.x; w < 192; w += gridDim.x) tile_upq(p, L, w, smem);
  for (int w = obid(); w < 256; w += gridDim.x) tile_upkv(p, L, w, smem);
}

DI void phase_mla(const Params& p, char* smem) {
  const int nbx = gridDim.x >> 3;
  for (int li = obid() >> 3; li < 32; li += nbx) {
    const int pair = (obid() & 7) * 2 + (li >> 4), nq = li & 15;
    const int b = pair >> 2, hc = pair & 3;
    const size_t tok0 = (size_t)b * 4096 + nq * 256;
    attn_block<192, 2>(smem, p.qmla() + ((size_t)(b * 4 + hc) * 4096 + nq * 256) * 192, 192, p.kmla() + (size_t)(b * 4 + hc) * 4096 * 192, 192,
                       p.vtC() + (size_t)(b * 4 + hc) * 128 * 4096, 0, 64, nq * 256, 0.f, 0.f, nullptr,
                       p.o() + tok0 * 2048 + 1536 + hc * 128, p.ssqh() + tok0 * 16 + 12 + hc, p.ropeC());
  }
}

DI void phase_onorm(const Params& p) {
  const int lane = otid() & 63, wid = otid() >> 6;
  for (int row = obid() * NWAVE + wid; row < T; row += gridDim.x * NWAVE) {
    const float4* sp = (const float4*)(p.ssqh() + (size_t)row * 16);
    const float4 a0 = sp[0], a1 = sp[1], b0 = sp[2], c0 = sp[3];
    const float rA = rsqrtf((a0.x + a0.y + a0.z + a0.w + a1.x + a1.y + a1.z + a1.w) * (1.f / 1024.f) + EPS);
    const float rB = rsqrtf((b0.x + b0.y + b0.z + b0.w) * (1.f / 512.f) + EPS);
    const float rC = rsqrtf((c0.x + c0.y + c0.z + c0.w) * (1.f / 512.f) + EPS);
#pragma unroll
    for (int j = 0; j < 4; ++j) {
      const float sc = (j < 2) ? rA : (j == 2 ? rB : rC);
      const size_t off = (size_t)row * 2048 + j * 512 + lane * 8;
      u32x4 w = *(const u32x4*)(p.o() + off);
      w.x = pack2bf(bf_lo(w.x) * sc, bf_hi(w.x) * sc);
      w.y = pack2bf(bf_lo(w.y) * sc, bf_hi(w.y) * sc);
      w.z = pack2bf(bf_lo(w.z) * sc, bf_hi(w.z) * sc);
      w.w = pack2bf(bf_lo(w.w) * sc, bf_hi(w.w) * sc);
      *(u32x4*)(p.on() + off) = w;
    }
  }
}

DI u32 ordkey(float s) {
  const u32 u = __float_as_uint(s);
  return u ^ ((u >> 31) ? 0xFFFFFFFFu : 0x80000000u);
}
DI float unord(u32 k) {
  const u32 u = (k & 0x80000000u) ? (k ^ 0x80000000u) : ~k;
  return __uint_as_float(u);
}
DI void insert16(u32 (&Ls)[16], u32 key) {
#pragma unroll
  for (int q = 0; q < 16; ++q) {
    const u32 hi = max(Ls[q], key);
    key = min(Ls[q], key);
    Ls[q] = hi;
  }
}

DI void phase_select(const Params& p, int L, char* smem) {
  float* sS = (float*)smem;
  u32* sTop = (u32*)(smem + 256 * 132 * 4);
  const int tid = otid(), lane = tid & 63, wid = tid >> 6, hh = lane >> 5, l31 = lane & 31;
  const int rt = wid >> 1, c = wid & 1;
  const u16* kb = p.keys_b() + (size_t)L * 256 * 128;
  for (int it = obid(); it < 1024; it += gridDim.x) {
    f32x16 sc[4];
    {
      const u16* qrow = p.pq() + ((size_t)it * 128 + rt * 32 + l31) * 128 + c * 64 + hh * 8;
      bf16x8 qa[4];
#pragma unroll
      for (int ks = 0; ks < 4; ++ks) qa[ks] = *(const bf16x8*)(qrow + ks * 16);
#pragma unroll
      for (int ct = 0; ct < 4; ++ct) {
#pragma unroll
        for (int r = 0; r < 16; ++r) sc[ct][r] = 0.f;
        const u16* krow = kb + (size_t)(c * 128 + ct * 32 + l31) * 128 + c * 64 + hh * 8;
#pragma unroll
        for (int ks = 0; ks < 4; ++ks) {
          const bf16x8 kf = *(const bf16x8*)(krow + ks * 16);
          sc[ct] = MFMA32(qa[ks], kf, sc[ct]);
        }
      }
    }
    __syncthreads();
#pragma unroll
    for (int ct = 0; ct < 4; ++ct)
#pragma unroll
      for (int r = 0; r < 16; ++r) sS[((rt * 32 + crow(r, hh)) * 2 + c) * 132 + ct * 32 + l31] = sc[ct][r];
    __syncthreads();
    {
      const int combo = tid >> 1, half = tid & 1;
      u32 Ls[16];
#pragma unroll
      for (int q = 0; q < 16; ++q) Ls[q] = 0u;
      const float* sp = sS + combo * 132 + half * 64;
      for (int n4 = 0; n4 < 16; ++n4) {
        const int n4r = (n4 + half * 8) & 15;
        const float4 v = *(const float4*)(sp + n4r * 4);
        const int nb = half * 64 + n4r * 4;
        insert16(Ls, (ordkey(v.x) & ~0x7Fu) | (u32)(127 - (nb + 0)));
        insert16(Ls, (ordkey(v.y) & ~0x7Fu) | (u32)(127 - (nb + 1)));
        insert16(Ls, (ordkey(v.z) & ~0x7Fu) | (u32)(127 - (nb + 2)));
        insert16(Ls, (ordkey(v.w) & ~0x7Fu) | (u32)(127 - (nb + 3)));
      }
      u32 Ms[16];
#pragma unroll
      for (int q = 0; q < 16; ++q) {
        const u32 other = (u32)__shfl_xor((int)Ls[15 - q], 1);
        Ms[q] = max(Ls[q], other);
      }
#pragma unroll
      for (int span = 8; span >= 1; span >>= 1)
#pragma unroll
        for (int q = 0; q < 16; ++q)
          if ((q & span) == 0) {
            const u32 hi = max(Ms[q], Ms[q + span]), lo = min(Ms[q], Ms[q + span]);
            Ms[q] = hi;
            Ms[q + span] = lo;
          }
      if (half == 0) {
#pragma unroll
        for (int q = 0; q < 16; ++q) sTop[combo * 16 + q] = Ms[q];
      }
    }
    __syncthreads();
    if (tid < 128) {
      const u32* t0 = sTop + (tid * 2) * 16;
      const u32* t1 = sTop + (tid * 2 + 1) * 16;
      float s0[16], s1[16];
#pragma unroll
      for (int q = 0; q < 16; ++q) {
        s0[q] = unord(t0[q] & ~0x7Fu);
        s1[q] = unord(t1[q] & ~0x7Fu);
      }
      u32 M[16];
#pragma unroll
      for (int q = 0; q < 16; ++q) M[q] = 0u;
#pragma unroll
      for (int i = 0; i < 16; ++i)
#pragma unroll
        for (int j = 0; j < 16; ++j)
          if ((i + 1) * (j + 1) <= 16) {
            const float sm = s0[i] + s1[j];
            insert16(M, (ordkey(sm) & ~0xFFu) | (u32)(255 - (i * 16 + j)));
          }
      const float mxv = unord(M[0] & ~0xFFu);
      float e[16], sum = 0.f;
#pragma unroll
      for (int q = 0; q < 16; ++q) {
        e[q] = __expf(unord(M[q] & ~0xFFu) - mxv);
        sum += e[q];
      }
      const float inv = 1.f / sum;
      const size_t row = (size_t)it * 128 + tid;
#pragma unroll
      for (int q = 0; q < 16; ++q) {
        const int ij = 255 - (int)(M[q] & 0xFFu);
        const int n0 = 127 - (int)(t0[ij >> 4] & 0x7Fu);
        const int n1 = 127 - (int)(t1[ij & 15] & 0x7Fu);
        p.idx()[row * 16 + q] = n0 * 128 + n1;
        p.g()[row * 16 + q] = e[q] * inv;
      }
    }
  }
}

DI float dot32(u32x4 w, const float2_t* xn2) {
  float2_t s = {0.f, 0.f};
#pragma unroll
  for (int c = 0; c < 4; ++c) {
    s = __builtin_elementwise_fma(__builtin_amdgcn_cvt_scalef32_pk_f32_fp4(w[c], 1.0f, 0), xn2[4 * c + 0], s);
    s = __builtin_elementwise_fma(__builtin_amdgcn_cvt_scalef32_pk_f32_fp4(w[c], 1.0f, 1), xn2[4 * c + 1], s);
    s = __builtin_elementwise_fma(__builtin_amdgcn_cvt_scalef32_pk_f32_fp4(w[c], 1.0f, 2), xn2[4 * c + 2], s);
    s = __builtin_elementwise_fma(__builtin_amdgcn_cvt_scalef32_pk_f32_fp4(w[c], 1.0f, 3), xn2[4 * c + 3], s);
  }
  return s.x + s.y;
}
DI void axpy32(u32x4 w, float a, float2_t* y2) {
  const float2_t a2 = {a, a};
#pragma unroll
  for (int c = 0; c < 4; ++c) {
    y2[4 * c + 0] = __builtin_elementwise_fma(__builtin_amdgcn_cvt_scalef32_pk_f32_fp4(w[c], 1.0f, 0), a2, y2[4 * c + 0]);
    y2[4 * c + 1] = __builtin_elementwise_fma(__builtin_amdgcn_cvt_scalef32_pk_f32_fp4(w[c], 1.0f, 1), a2, y2[4 * c + 1]);
    y2[4 * c + 2] = __builtin_elementwise_fma(__builtin_amdgcn_cvt_scalef32_pk_f32_fp4(w[c], 1.0f, 2), a2, y2[4 * c + 2]);
    y2[4 * c + 3] = __builtin_elementwise_fma(__builtin_amdgcn_cvt_scalef32_pk_f32_fp4(w[c], 1.0f, 3), a2, y2[4 * c + 3]);
  }
}
DI float gelu_tanh(float a) {
  const float u = 0.7978845608028654f * (a + 0.044715f * a * a * a);
  return 0.5f * a * (1.f + tanhf(u));
}

DI void phase_gather(const Params& p, int L, bool last) {
  const int wid = otid() >> 6;
  const unsigned char* U = p.ub() + (size_t)L * NEXP * 1024;
  const unsigned char* V = p.vb() + (size_t)L * NEXP * 1024;
  const float* ln2 = p.ln2 + L * 2048;
  int ni0 = 0, ni1 = 0;
  float ng0 = 0.f, ng1 = 0.f;
  {
    const int t0 = obid() * NWAVE + wid, l0 = otid() & 63;
    if (t0 < T) {
      ni0 = p.idx()[(size_t)t0 * 128 + l0]; ni1 = p.idx()[(size_t)t0 * 128 + 64 + l0];
      ng0 = p.g()[(size_t)t0 * 128 + l0];   ng1 = p.g()[(size_t)t0 * 128 + 64 + l0];
    }
  }
  for (int t = obid() * NWAVE + wid; t < T; t += gridDim.x * NWAVE) {
    const int lane = otid() & 63;
    const u16* xr = p.xb() + (size_t)t * 2048;
    float2_t xn2[16];
    float ss = 0.f;
    u32x4 xkeep[4];
#pragma unroll
    for (int c8 = 0; c8 < 4; ++c8) {
      const u32x4 a = *(const u32x4*)(xr + lane * 32 + c8 * 8);
      xkeep[c8] = a;
      xn2[c8 * 4 + 0] = float2_t{bf_lo(a.x), bf_hi(a.x)};
      xn2[c8 * 4 + 1] = float2_t{bf_lo(a.y), bf_hi(a.y)};
      xn2[c8 * 4 + 2] = float2_t{bf_lo(a.z), bf_hi(a.z)};
      xn2[c8 * 4 + 3] = float2_t{bf_lo(a.w), bf_hi(a.w)};
    }
#pragma unroll
    for (int e = 0; e < 16; ++e) ss += xn2[e].x * xn2[e].x + xn2[e].y * xn2[e].y;
    ss = wave_sum(ss);
    const float rstd = rsqrtf(ss * (1.f / 2048.f) + EPS) * (1.f / U_SCALE);
#pragma unroll
    for (int c4 = 0; c4 < 8; ++c4) {
      const float4 a = *(const float4*)(ln2 + lane * 32 + c4 * 4);
      xn2[c4 * 2 + 0] *= float2_t{rstd * a.x, rstd * a.y};
      xn2[c4 * 2 + 1] *= float2_t{rstd * a.z, rstd * a.w};
    }
    const int i0 = ni0, i1 = ni1;
    const float g0 = ng0, g1 = ng1;
    float a0 = 0.f, a1 = 0.f;
#pragma unroll
    for (int half = 0; half < 2; ++half) {
      const int iv = half ? i1 : i0;
      float av = 0.f;
#pragma unroll 1
      for (int k0 = 0; k0 < 64; k0 += 16) {
        u32x4 w[16];
#pragma unroll
        for (int q = 0; q < 16; ++q) {
          const int row = __builtin_amdgcn_readlane(iv, k0 + q);
          w[q] = *(const u32x4*)(U + (size_t)row * 1024 + lane * 16);
        }
        float d[16];
#pragma unroll
        for (int q = 0; q < 16; ++q) {
          __builtin_amdgcn_sched_barrier(0);
          if (q > 0) asm volatile("" : "+v"(w[q]), "+v"(d[q - 1]));
          d[q] = dot32(w[q], xn2);
        }
        __builtin_amdgcn_sched_barrier(0);
        {
          const bool b5 = (lane & 32) != 0, b4 = (lane & 16) != 0, b3 = (lane & 8) != 0, b2 = (lane & 4) != 0;
          float e8[8], e4[4], e2[2], e1;
#pragma unroll
          for (int j = 0; j < 8; ++j) {
            const float snd = b5 ? d[j] : d[j + 8];
            const float kep = b5 ? d[j + 8] : d[j];
            e8[j] = kep + __shfl_xor(snd, 32);
          }
#pragma unroll
          for (int j = 0; j < 4; ++j) {
            const float snd = b4 ? e8[j] : e8[j + 4];
            const float kep = b4 ? e8[j + 4] : e8[j];
            e4[j] = kep + __shfl_xor(snd, 16);
          }
#pragma unroll
          for (int j = 0; j < 2; ++j) {
            const float snd = b3 ? e4[j] : e4[j + 2];
            const float kep = b3 ? e4[j + 2] : e4[j];
            e2[j] = kep + __shfl_xor(snd, 8);
          }
          {
            const float snd = b2 ? e2[0] : e2[1];
            const float kep = b2 ? e2[1] : e2[0];
            e1 = kep + __shfl_xor(snd, 4);
          }
          e1 += __shfl_xor(e1, 2);
          e1 += __shfl_xor(e1, 1);
          const float got = __shfl(e1, ((lane - k0) & 15) * 4);
          if (lane >= k0 && lane < k0 + 16) av = got;
        }
      }
      if (half) a1 = av; else a0 = av;
    }
    const float hs0 = gelu_tanh(a0) * g0 * (1.f / V_SCALE), hs1 = gelu_tanh(a1) * g1 * (1.f / V_SCALE);
    {
      const int tn = t + gridDim.x * NWAVE;
      if (tn < T) {
        ni0 = p.idx()[(size_t)tn * 128 + lane]; ni1 = p.idx()[(size_t)tn * 128 + 64 + lane];
        ng0 = p.g()[(size_t)tn * 128 + lane];   ng1 = p.g()[(size_t)tn * 128 + 64 + lane];
      }
    }
    float2_t y2[16];
#pragma unroll
    for (int e = 0; e < 16; ++e) y2[e] = float2_t{0.f, 0.f};
#pragma unroll
    for (int half = 0; half < 2; ++half) {
      const int iv = half ? i1 : i0;
      const int hv = __float_as_int(half ? hs1 : hs0);
#pragma unroll 1
      for (int k0 = 0; k0 < 64; k0 += 8) {
        u32x4 w[8];
        float wq[8];
#pragma unroll
        for (int q = 0; q < 8; ++q) {
          const int row = __builtin_amdgcn_readlane(iv, k0 + q);
          wq[q] = __int_as_float(__builtin_amdgcn_readlane(hv, k0 + q));
          w[q] = *(const u32x4*)(V + (size_t)row * 1024 + lane * 16);
        }
#pragma unroll
        for (int q = 0; q < 8; ++q) {
          __builtin_amdgcn_sched_barrier(0);
          asm volatile("" : "+v"(w[q]), "+v"(y2[0]), "+v"(y2[8]));
          axpy32(w[q], wq[q], y2);
        }
        __builtin_amdgcn_sched_barrier(0);
      }
    }
    int t2 = t;
    asm volatile("" : "+v"(t2));
    const int lane2 = otid() & 63;
#pragma unroll
    for (int c8 = 0; c8 < 4; ++c8) {
      const u32x4 a = xkeep[c8];
      y2[c8 * 4 + 0] += float2_t{bf_lo(a.x), bf_hi(a.x)};
      y2[c8 * 4 + 1] += float2_t{bf_lo(a.y), bf_hi(a.y)};
      y2[c8 * 4 + 2] += float2_t{bf_lo(a.z), bf_hi(a.z)};
      y2[c8 * 4 + 3] += float2_t{bf_lo(a.w), bf_hi(a.w)};
    }
    if (!last) {
#pragma unroll
      for (int c8 = 0; c8 < 4; ++c8) {
        const float2_t* yy = y2 + c8 * 4;
        u32x4 w = {pack2bf(yy[0].x, yy[0].y), pack2bf(yy[1].x, yy[1].y), pack2bf(yy[2].x, yy[2].y), pack2bf(yy[3].x, yy[3].y)};
        *(u32x4*)(p.xb() + (size_t)t2 * 2048 + lane2 * 32 + c8 * 8) = w;
      }
    } else {
      float ss2 = 0.f;
#pragma unroll
      for (int e = 0; e < 16; ++e) ss2 += y2[e].x * y2[e].x + y2[e].y * y2[e].y;
      ss2 = wave_sum(ss2);
      const float r2 = rsqrtf(ss2 * (1.f / 2048.f) + EPS);
      float* orow = p.out + (size_t)t2 * 2048;
#pragma unroll
      for (int c4 = 0; c4 < 8; ++c4) {
        const float4 a = *(const float4*)(p.fnorm + lane2 * 32 + c4 * 4);
        *(float4*)(orow + lane2 * 32 + c4 * 4) =
            float4{y2[c4 * 2].x * r2 * a.x, y2[c4 * 2].y * r2 * a.y, y2[c4 * 2 + 1].x * r2 * a.z, y2[c4 * 2 + 1].y * r2 * a.w};
      }
    }
  }
}


#define XB_TMO      128
#define XB_XCNT(j)  (256  + 64 * (j))
#define XB_XSUB(j)  (1280 + 64 * (j))
#define XB_XGEN(j)  (2304 + 64 * (j))
#define XB_TOP      3328
#define XB_TOPGEN   3392
#define XCD_BAR_WORDS 3456
#define XB_SPIN_CAP (1u << 18)
#define LAS __attribute__((address_space(3)))
DI unsigned xb_ld(unsigned* p) { return __hip_atomic_load(p, __ATOMIC_RELAXED, __HIP_MEMORY_SCOPE_AGENT); }
DI unsigned xb_add(unsigned* p, unsigned v) { return __hip_atomic_fetch_add(p, v, __ATOMIC_RELAXED, __HIP_MEMORY_SCOPE_AGENT); }
DI unsigned xb_xcc_id() { return (unsigned)__builtin_amdgcn_s_getreg((3 << 11) | 20) & 0xFu; }
#define XB_SPIN(cond, bar) do { unsigned _sp = 0; while (cond) { __builtin_amdgcn_s_sleep(1); \
    if ((++_sp & 255u) == 0u) { if (xb_ld(&(bar)[XB_TMO])) break; if (_sp > XB_SPIN_CAP) { atomicAdd(&(bar)[XB_TMO], 1u); break; } } } } while (0)
struct XcdBarrier { unsigned* bar; unsigned x; volatile LAS unsigned* st; };
DI XcdBarrier xcd_barrier_post(unsigned* bar, volatile LAS unsigned* st) {
  XcdBarrier b; b.bar = bar; b.x = xb_xcc_id(); b.st = st;
  if (threadIdx.x == 0) (void)xb_add(&bar[XB_XCNT(b.x)], 1u);
  return b;
}
DI void xcd_barrier_complete(unsigned* bar, unsigned x, unsigned& nloc, unsigned& nx) {
  const unsigned G = gridDim.x * gridDim.y * gridDim.z;
  unsigned sum, cnt, mine, sp = 0u;
  for (;;) {
    sum = 0u; cnt = 0u; mine = 0u;
#pragma unroll
    for (unsigned j = 0; j < 16; ++j) { const unsigned c = xb_ld(&bar[XB_XCNT(j)]); sum += c; cnt += (c > 0u) ? 1u : 0u; mine = (j == x) ? c : mine; }
    if (sum == G) break;
    __builtin_amdgcn_s_sleep(1);
    if ((++sp & 255u) == 0u) { if (xb_ld(&bar[XB_TMO])) break; if (sp > XB_SPIN_CAP) { atomicAdd(&bar[XB_TMO], 1u); break; } }
  }
  nloc = mine > 0u ? mine : 1u; nx = cnt > 0u ? cnt : 1u;
}
DI void xcd_barrier(const XcdBarrier& b) {
  asm volatile("s_waitcnt vmcnt(0)" ::: "memory");
  __syncthreads();
  if (threadIdx.x == 0) {
    unsigned* bar = b.bar;
    __builtin_amdgcn_s_waitcnt(0);
    unsigned nloc = b.st[0], nx = b.st[1];
    if (nloc == 0u) { xcd_barrier_complete(bar, b.x, nloc, nx); b.st[0] = nloc; b.st[1] = nx; }
    const unsigned old = xb_add(&bar[XB_XSUB(b.x)], 1u);
    const unsigned gen = old / nloc;
    if (old + 1u == (gen + 1u) * nloc) {
      __builtin_amdgcn_fence(__ATOMIC_RELEASE, "agent");
      asm volatile("s_waitcnt vmcnt(0)" ::: "memory");
      const unsigned og = xb_add(&bar[XB_TOP], 1u);
      const unsigned tg = og / nx;
      if (og + 1u == (tg + 1u) * nx) xb_add(&bar[XB_TOPGEN], 1u);
      else XB_SPIN(xb_ld(&bar[XB_TOPGEN]) == tg, bar);
      __builtin_amdgcn_fence(__ATOMIC_ACQUIRE, "agent");
      xb_add(&bar[XB_XGEN(b.x)], 1u);
      asm volatile("s_waitcnt vmcnt(0)" ::: "memory");
    } else {
      XB_SPIN(xb_ld(&bar[XB_XGEN(b.x)]) == gen, bar);
      __builtin_amdgcn_fence(__ATOMIC_ACQUIRE, "agent");
      asm volatile("s_waitcnt vmcnt(0)" ::: "memory");
    }
  }
  __syncthreads();
}

#define KDEF(name, body)                                                       \
  __global__ void __launch_bounds__(512) name(Params p, int L) {            \
    __shared__ __attribute__((aligned(16))) char smem[SMEM_BYTES];             \
    body;                                                                      \
  }
#if !MEGA
KDEF(k_prologue, phase_prologue(p, smem))
KDEF(k_gemm1, phase_gemm1(p, L, smem))
KDEF(k_mix, phase_mix(p, L, smem))
KDEF(k_mla, phase_mla(p, smem))
KDEF(k_onorm, phase_onorm(p))
KDEF(k_gemm_o, phase_gemm_o(p, L, smem))
KDEF(k_gemm_pq, phase_gemm_pq(p, L, smem))
KDEF(k_scores, phase_gemm_scores(p, L, smem))
KDEF(k_select, phase_select(p, L, smem))
KDEF(k_gather, phase_gather(p, L, L == 1))
#else
#ifndef PROBE_MASK
#define PROBE_MASK 0
#endif
#define RUN(bit, call)                         \
  call;                                        \
  if (PROBE_MASK & (bit)) {                    \
    grid.sync();                               \
    call;                                      \
  }
__global__ void __launch_bounds__(512) mega_coop(Params p) {
  __shared__ __attribute__((aligned(16))) char smem[SMEM_BYTES];
  __shared__ uint4 xb_words;
  cg::grid_group grid = cg::this_grid();
  if (threadIdx.x == 0) xb_words = make_uint4(0u, 0u, 0u, 0u);
  __syncthreads();
  const XcdBarrier xb = xcd_barrier_post((unsigned*)(p.ws + WS_NEED), (volatile LAS unsigned*)&xb_words);
#define GSYNC xcd_barrier(xb)
  RUN(256, phase_prologue(p, smem))
  if (p.ws == nullptr) grid.sync();
  GSYNC;
#pragma unroll 1
  for (int L = 0; L < 2; ++L) {
    phase_gemm1(p, L, smem);
    GSYNC;
    phase_mix(p, L, smem);
    GSYNC;
    phase_mla(p, smem);
    GSYNC;
    phase_gemm_o(p, L, smem);
    GSYNC;
    phase_gemm_pq(p, L, smem);
    GSYNC;
    phase_select(p, L, smem);
    GSYNC;
    phase_gather(p, L, L == 1);
    if (L == 0) GSYNC;
  }
}
#endif

extern "C" void kernel_launch(void* const* d_in, const int* in_sizes, int n_in, void* d_out, int out_size, void* d_ws,
                              size_t ws_size, hipStream_t stream) {
  Params p{};
  p.x = (const float*)d_in[0]; p.ln1 = (const float*)d_in[1]; p.w_in = (const float*)d_in[2]; p.a_sink = (const float*)d_in[3];
  p.b_rel = (const float*)d_in[4]; p.cqn = (const float*)d_in[5]; p.ckvn = (const float*)d_in[6]; p.wuq = (const float*)d_in[7];
  p.wukv = (const float*)d_in[8]; p.onorm = (const float*)d_in[9]; p.wo = (const float*)d_in[10]; p.ln2 = (const float*)d_in[11];
  p.pwq = (const float*)d_in[12]; p.pkeys = (const float*)d_in[13]; p.pu = (const float*)d_in[14]; p.pv = (const float*)d_in[15];
  p.fnorm = (const float*)d_in[16];
  p.out = (float*)d_out;
  p.ws = (char*)d_ws;
  if (WS_NEED + XCD_BAR_WORDS * sizeof(unsigned) > ws_size) { fprintf(stderr, "kernel_launch: workspace too small (%zu > %zu)\n", (size_t)WS_NEED, ws_size); return; }

#if MEGA
  static int grid_blocks = 0;
  if (!grid_blocks) {
    int dev = 0, cus = 0, per_cu = 0;
    hipGetDevice(&dev);
    hipDeviceGetAttribute(&cus, hipDeviceAttributeMultiprocessorCount, dev);
    hipOccupancyMaxActiveBlocksPerMultiprocessor(&per_cu, mega_coop, NTHR, 0);
    if (per_cu > 1) per_cu = 1;
    if (per_cu < 1) per_cu = 1;
    grid_blocks = (cus * per_cu) & ~7;
  }
  (void)hipMemsetAsync(p.ws + WS_NEED, 0, XCD_BAR_WORDS * sizeof(unsigned), stream);
  void* args[] = {&p};
  hipError_t e = hipLaunchCooperativeKernel((void*)mega_coop, dim3(grid_blocks), dim3(NTHR), args, 0, stream);
  if (e != hipSuccess) fprintf(stderr, "cooperative launch failed: %s (grid %d)\n", hipGetErrorString(e), grid_blocks);
#else
  const dim3 g(256), b(NTHR);
  k_prologue<<<g, b, 0, stream>>>(p, 0);
  for (int L = 0; L < 2; ++L) {
    k_gemm1<<<g, b, 0, stream>>>(p, L);
    k_mix<<<g, b, 0, stream>>>(p, L);
    k_mla<<<g, b, 0, stream>>>(p, L);
    k_gemm_o<<<g, b, 0, stream>>>(p, L);
    k_gemm_pq<<<g, b, 0, stream>>>(p, L);
    k_select<<<g, b, 0, stream>>>(p, L);
    k_gather<<<g, b, 0, stream>>>(p, L);
  }
#endif
}
```

```cpp
#include <hip/hip_runtime.h>
#include <hip/hip_cooperative_groups.h>
#include <cstdio>
namespace cg = cooperative_groups;

#ifndef MEGA
#define MEGA 1
#endif

#define DI __device__ __forceinline__
typedef unsigned short u16;
typedef unsigned int u32;
using bf16x8 = __attribute__((ext_vector_type(8))) short;
using f32x16 = __attribute__((ext_vector_type(16))) float;
typedef __bf16 bf16x2_t __attribute__((ext_vector_type(2)));
typedef float float2_t __attribute__((ext_vector_type(2)));
typedef unsigned int u32x4 __attribute__((ext_vector_type(4)));
typedef unsigned int u32x2 __attribute__((ext_vector_type(2)));

constexpr int T = 16384, SEQ = 4096, DM = 2048, HLD = 4096;
constexpr int NTHR = 512, NWAVE = 8;
constexpr int NEXP = 16384;
constexpr float EPS = 1e-6f;
constexpr float LOG2E = 1.4426950408889634f;
constexpr float QSCALE_AB = 0.08838834764831845f * LOG2E;
constexpr float QSCALE_C = 0.07216878364870323f * LOG2E;
constexpr float U_SCALE = 90.5f, V_SCALE = 8.f;
constexpr int LDT = 72;
constexpr int GEMM_STAGE = 512 * LDT;
constexpr int GEMM_SROW_OFF = 2 * GEMM_STAGE * 2;
constexpr int SMEM_BYTES = 256 * 132 * 4 + 256 * 16 * 4;

#define MFMA32(a, b, c) __builtin_amdgcn_mfma_f32_32x32x16_bf16((a), (b), (c), 0, 0, 0)

constexpr size_t al256(size_t x) { return (x + 255) & ~(size_t)255; }
constexpr size_t OFF_wt_in = 0;
constexpr size_t OFF_wt_o = OFF_wt_in + al256((size_t)2 * HLD * 2048 * 2);
constexpr size_t OFF_wt_pq = OFF_wt_o + al256((size_t)2 * 2048 * 2048 * 2);
constexpr size_t OFF_wt_uq = OFF_wt_pq + al256((size_t)2 * 1024 * 2048 * 2);
constexpr size_t OFF_wt_ukv = OFF_wt_uq + al256((size_t)2 * 768 * 512 * 2);
constexpr size_t OFF_keys_b = OFF_wt_ukv + al256((size_t)2 * 1024 * 256 * 2);
constexpr size_t OFF_ub = OFF_keys_b + al256((size_t)2 * 256 * 128 * 2);
constexpr size_t OFF_vb = OFF_ub + al256((size_t)2 * NEXP * 1024);
constexpr size_t OFF_ropeC = OFF_vb + al256((size_t)2 * NEXP * 1024);
constexpr size_t OFF_ropeS = OFF_ropeC + al256((size_t)SEQ * 32 * 4);
constexpr size_t OFF_xres = OFF_ropeS + al256((size_t)SEQ * 32 * 4);
constexpr size_t OFF_xb = OFF_xres + al256((size_t)T * 2048 * 4);
constexpr size_t OFF_h = OFF_xb + al256((size_t)T * 2048 * 2);
constexpr size_t OFF_vtA = OFF_h + al256((size_t)T * HLD * 2);
constexpr size_t OFF_vtB = OFF_vtA + al256((size_t)T * 256 * 2);
constexpr size_t OFF_kmla = OFF_vtB + al256((size_t)T * 512 * 2);
constexpr size_t OFF_vtC = OFF_kmla + al256((size_t)T * 4 * 192 * 2);
constexpr size_t OFF_qmla = OFF_vtC + al256((size_t)T * 512 * 2);
constexpr size_t OFF_o = OFF_qmla + al256((size_t)T * 4 * 192 * 2);
constexpr size_t OFF_on = OFF_o + al256((size_t)T * 2048 * 2);
constexpr size_t OFF_ssqh = OFF_on + al256((size_t)T * 2048 * 2);
constexpr size_t OFF_END1 = OFF_ssqh + al256((size_t)T * 16 * 4);
constexpr size_t OFF_pq = OFF_h;
constexpr size_t OFF_scores = OFF_pq + al256((size_t)T * 1024 * 2);
constexpr size_t OFF_idx = OFF_scores + al256((size_t)T * 8 * 256 * 4);
constexpr size_t OFF_g = OFF_idx + al256((size_t)T * 128 * 4);
constexpr size_t OFF_END2 = OFF_g + al256((size_t)T * 128 * 4);
constexpr size_t WS_NEED = OFF_END1 > OFF_END2 ? OFF_END1 : OFF_END2;

struct Params {
  const float *x, *ln1, *w_in, *a_sink, *b_rel, *cqn, *ckvn, *wuq, *wukv, *onorm, *wo, *ln2, *pwq, *pkeys, *pu, *pv, *fnorm;
  float* out;
  char* ws;
  DI u16* wt_in() const { return (u16*)(ws + OFF_wt_in); }
  DI u16* wt_o() const { return (u16*)(ws + OFF_wt_o); }
  DI u16* wt_pq() const { return (u16*)(ws + OFF_wt_pq); }
  DI u16* wt_uq() const { return (u16*)(ws + OFF_wt_uq); }
  DI u16* wt_ukv() const { return (u16*)(ws + OFF_wt_ukv); }
  DI u16* keys_b() const { return (u16*)(ws + OFF_keys_b); }
  DI unsigned char* ub() const { return (unsigned char*)(ws + OFF_ub); }
  DI unsigned char* vb() const { return (unsigned char*)(ws + OFF_vb); }
  DI float* ropeC() const { return (float*)(ws + OFF_ropeC); }
  DI float* ropeS() const { return (float*)(ws + OFF_ropeS); }
  DI float* xres() const { return (float*)(ws + OFF_xres); }
  DI u16* xb() const { return (u16*)(ws + OFF_xb); }
  DI u16* h() const { return (u16*)(ws + OFF_h); }
  DI u16* vtA() const { return (u16*)(ws + OFF_vtA); }
  DI u16* vtB() const { return (u16*)(ws + OFF_vtB); }
  DI u16* kmla() const { return (u16*)(ws + OFF_kmla); }
  DI u16* vtC() const { return (u16*)(ws + OFF_vtC); }
  DI u16* qmla() const { return (u16*)(ws + OFF_qmla); }
  DI u16* o() const { return (u16*)(ws + OFF_o); }
  DI u16* on() const { return (u16*)(ws + OFF_on); }
  DI float* ssqh() const { return (float*)(ws + OFF_ssqh); }
  DI u16* pq() const { return (u16*)(ws + OFF_pq); }
  DI float* scores() const { return (float*)(ws + OFF_scores); }
  DI int* idx() const { return (int*)(ws + OFF_idx); }
  DI float* g() const { return (float*)(ws + OFF_g); }
};

DI int otid() { int t = threadIdx.x; asm volatile("" : "+v"(t)); return t; }
DI int obid() { int b = blockIdx.x; asm volatile("" : "+s"(b)); return b; }
DI u16 f2bf(float x) {
  u32 u = __float_as_uint(x);
  u += 0x7fffu + ((u >> 16) & 1u);
  return (u16)(u >> 16);
}
DI u32 pack2bf(float a, float b) {
  float2_t f = {a, b};
  bf16x2_t r = __builtin_convertvector(f, bf16x2_t);
  return __builtin_bit_cast(u32, r);
}
DI float bf_lo(u32 w) { return __uint_as_float(w << 16); }
DI float bf_hi(u32 w) { return __uint_as_float(w & 0xffff0000u); }
DI int crow(int r, int h) { return (r & 3) + 8 * (r >> 2) + 4 * h; }
DI float wave_sum(float v) {
#pragma unroll
  for (int o = 32; o >= 1; o >>= 1) v += __shfl_xor(v, o);
  return v;
}
DI float ssq8(u32x4 w) {
  float s = 0.f, a;
  a = bf_lo(w.x); s += a * a; a = bf_hi(w.x); s += a * a;
  a = bf_lo(w.y); s += a * a; a = bf_hi(w.y); s += a * a;
  a = bf_lo(w.z); s += a * a; a = bf_hi(w.z); s += a * a;
  a = bf_lo(w.w); s += a * a; a = bf_hi(w.w); s += a * a;
  return s;
}
DI bool gemm_tile_map(int it, int MT, int NT, int& mt, int& nt) {
  const int b = obid(), x = b & 7, nb = gridDim.x >> 3;
  const int li = it * nb + (b >> 3);
  const int nrn = (NT + 7) >> 3, nrect = (MT >> 3) * nrn;
  const int q = x + 8 * (li >> 6);
  if (q >= nrect) { mt = -1; nt = 0; return false; }
  const int in = li & 63;
  mt = (q / nrn) * 8 + (in >> 3);
  nt = (q % nrn) * 8 + (in & 7);
  return nt < NT;
}

constexpr int GM = 256, GN = 256;
DI u32x4 scale8(u32x4 w, float sc) {
  w.x = pack2bf(bf_lo(w.x) * sc, bf_hi(w.x) * sc);
  w.y = pack2bf(bf_lo(w.y) * sc, bf_hi(w.y) * sc);
  w.z = pack2bf(bf_lo(w.z) * sc, bf_hi(w.z) * sc);
  w.w = pack2bf(bf_lo(w.w) * sc, bf_hi(w.w) * sc);
  return w;
}
template <bool ROWNORM, bool CONV = false, bool ASCALE = false>
DI void gemm_mainloop(const u16* __restrict__ Ag, int lda, const u16* __restrict__ Bg, int ldb, int K, char* smem,
                      f32x16 (&acc)[4][2], const float4* __restrict__ csrc = nullptr, u16* __restrict__ cdst = nullptr,
                      float cscale = 1.f) {
  u16* sbase = (u16*)smem;
  float* sRow = (float*)(smem + GEMM_SROW_OFF);
  const int tid = otid(), lane = tid & 63, wid = tid >> 6;
  const int wm = wid >> 2, wn = wid & 3, hh = lane >> 5, l31 = lane & 31;
  const int lr = tid >> 3, lc = (tid & 7) * 8;
#pragma unroll
  for (int i = 0; i < 4; ++i)
#pragma unroll
    for (int j = 0; j < 2; ++j)
#pragma unroll
      for (int r = 0; r < 16; ++r) acc[i][j][r] = 0.f;
  u32x4 ra[4], rb[4];
  float ssq[4] = {0.f, 0.f, 0.f, 0.f};
  const u16* ap = Ag + (size_t)lr * lda + lc;
  const u16* bp = Bg + (size_t)lr * ldb + lc;
#pragma unroll
  for (int i = 0; i < 4; ++i) {
    ra[i] = *(const u32x4*)(ap + (size_t)(64 * i) * lda);
    rb[i] = *(const u32x4*)(bp + (size_t)(64 * i) * ldb);
  }
  __syncthreads();
#pragma unroll
  for (int i = 0; i < 4; ++i) {
    if (ASCALE) ra[i] = scale8(ra[i], sRow[(lr + 64 * i) * 4 + 0]);
    *(u32x4*)(sbase + (lr + 64 * i) * LDT + lc) = ra[i];
    *(u32x4*)(sbase + (256 + lr + 64 * i) * LDT + lc) = rb[i];
    if (ROWNORM) ssq[i] += ssq8(ra[i]);
  }
  __syncthreads();
  const int nk = K >> 6;
#pragma unroll 1
  for (int kt = 0; kt < nk; ++kt) {
    const int cur = kt & 1;
    const bool more = (kt + 1 < nk);
    const int kn = more ? kt + 1 : kt;
    float4 cv;
    if (CONV) cv = csrc[(size_t)kt * NTHR + tid];
#pragma unroll
    for (int i = 0; i < 4; ++i) {
      ra[i] = *(const u32x4*)(ap + (size_t)(64 * i) * lda + kn * 64);
      rb[i] = *(const u32x4*)(bp + (size_t)(64 * i) * ldb + kn * 64);
    }
    const u16* a_s = sbase + cur * GEMM_STAGE + (wm * 128 + l31) * LDT + hh * 8;
    const u16* b_s = sbase + cur * GEMM_STAGE + (256 + wn * 64 + l31) * LDT + hh * 8;
#pragma unroll
    for (int ks = 0; ks < 4; ++ks) {
      const bf16x8 b0 = *(const bf16x8*)(b_s + ks * 16);
      const bf16x8 b1 = *(const bf16x8*)(b_s + 32 * LDT + ks * 16);
      bf16x8 a0[4];
#pragma unroll
      for (int i = 0; i < 4; ++i) a0[i] = *(const bf16x8*)(a_s + i * 32 * LDT + ks * 16);
      __builtin_amdgcn_s_setprio(1);
#pragma unroll
      for (int i = 0; i < 4; ++i) {
        acc[i][0] = MFMA32(a0[i], b0, acc[i][0]);
        acc[i][1] = MFMA32(a0[i], b1, acc[i][1]);
      }
      __builtin_amdgcn_s_setprio(0);
    }
    {
      u16* w = sbase + (cur ^ 1) * GEMM_STAGE;
      const int g = (kn < 16) ? 0 : (kn < 24 ? 1 : 2);
#pragma unroll
      for (int i = 0; i < 4; ++i) {
        if (ASCALE) ra[i] = scale8(ra[i], sRow[(lr + 64 * i) * 4 + g]);
        *(u32x4*)(w + (lr + 64 * i) * LDT + lc) = ra[i];
        *(u32x4*)(w + (256 + lr + 64 * i) * LDT + lc) = rb[i];
        if (ROWNORM) ssq[i] += more ? ssq8(ra[i]) : 0.f;
      }
    }
    if (CONV) {
      u32 w4 = 0;
      w4 = __builtin_amdgcn_cvt_scalef32_pk_fp4_f32(w4, cv.x * cscale, cv.y * cscale, 1.0f, 0);
      w4 = __builtin_amdgcn_cvt_scalef32_pk_fp4_f32(w4, cv.z * cscale, cv.w * cscale, 1.0f, 1);
      cdst[(size_t)kt * NTHR + tid] = (u16)w4;
    }
    __syncthreads();
  }
  if (ROWNORM) {
#pragma unroll
    for (int i = 0; i < 4; ++i) {
      float s = ssq[i];
      s += __shfl_xor(s, 1);
      s += __shfl_xor(s, 2);
      s += __shfl_xor(s, 4);
      if ((tid & 7) == 0) sRow[lr + 64 * i] = rsqrtf(s / (float)K + EPS);
    }
    __syncthreads();
  }
}

DI void conv_transpose_all(const Params& p, char* smem) {
  const int lane = otid() & 63, wid = otid() >> 6;
  float* s = (float*)smem + wid * (64 * 65);
  constexpr int T0 = 32 * 61, T1 = T0 + 32 * 32, T2 = T1 + 32 * 16, T3 = T2 + 8 * 12, T4 = T3 + 4 * 16;
  for (int f = obid() * NWAVE + wid; f < 2 * T4; f += gridDim.x * NWAVE) {
    const int L = f / T4, r = f % T4;
    const float* W; const float* g; u16* Wt; int K, N, tile;
    if (r < T0)      { W = p.w_in + (size_t)L * 2048 * 3904; g = p.ln1 + L * 2048;   Wt = p.wt_in() + (size_t)L * HLD * 2048;   K = 2048; N = 3904; tile = r; }
    else if (r < T1) { W = p.wo + (size_t)L * 2048 * 2048;   g = p.onorm + L * 2048; Wt = p.wt_o() + (size_t)L * 2048 * 2048;   K = 2048; N = 2048; tile = r - T0; }
    else if (r < T2) { W = p.pwq + (size_t)L * 2048 * 1024;  g = p.ln2 + L * 2048;   Wt = p.wt_pq() + (size_t)L * 1024 * 2048;  K = 2048; N = 1024; tile = r - T1; }
    else if (r < T3) { W = p.wuq + (size_t)L * 512 * 768;    g = p.cqn + L * 512;    Wt = p.wt_uq() + (size_t)L * 768 * 512;    K = 512;  N = 768;  tile = r - T2; }
    else             { W = p.wukv + (size_t)L * 256 * 1024;  g = p.ckvn + L * 256;   Wt = p.wt_ukv() + (size_t)L * 1024 * 256;  K = 256;  N = 1024; tile = r - T3; }
    const int ntn = N / 64;
    const int k0 = (tile / ntn) * 64, n0 = (tile % ntn) * 64;
#pragma unroll 8
    for (int kk = 0; kk < 64; ++kk) s[kk * 65 + lane] = W[(size_t)(k0 + kk) * N + n0 + lane] * g[k0 + kk];
    __builtin_amdgcn_fence(__ATOMIC_RELEASE, "wavefront");
    __builtin_amdgcn_wave_barrier();
    __builtin_amdgcn_fence(__ATOMIC_ACQUIRE, "wavefront");
#pragma unroll 8
    for (int nn = 0; nn < 64; ++nn) Wt[(size_t)(n0 + nn) * K + k0 + lane] = f2bf(s[lane * 65 + nn]);
    __builtin_amdgcn_fence(__ATOMIC_RELEASE, "wavefront");
    __builtin_amdgcn_wave_barrier();
    __builtin_amdgcn_fence(__ATOMIC_ACQUIRE, "wavefront");
  }
}
DI void conv_flat(const float* __restrict__ src, u16* __restrict__ dst, size_t n4) {
  for (size_t i = (size_t)obid() * NTHR + otid(); i < n4; i += (size_t)gridDim.x * NTHR) {
    float4 v = ((const float4*)src)[i];
    u32x2 w = {pack2bf(v.x, v.y), pack2bf(v.z, v.w)};
    ((u32x2*)dst)[i] = w;
  }
}
DI void conv_fp4(const float* __restrict__ src, unsigned char* __restrict__ dst, size_t n8, float sc) {
  for (size_t i = (size_t)obid() * NTHR + otid(); i < n8; i += (size_t)gridDim.x * NTHR) {
    const float4 a = ((const float4*)src)[i * 2 + 0], b = ((const float4*)src)[i * 2 + 1];
    u32 w = 0;
    w = __builtin_amdgcn_cvt_scalef32_pk_fp4_f32(w, a.x * sc, a.y * sc, 1.0f, 0);
    w = __builtin_amdgcn_cvt_scalef32_pk_fp4_f32(w, a.z * sc, a.w * sc, 1.0f, 1);
    w = __builtin_amdgcn_cvt_scalef32_pk_fp4_f32(w, b.x * sc, b.y * sc, 1.0f, 2);
    w = __builtin_amdgcn_cvt_scalef32_pk_fp4_f32(w, b.z * sc, b.w * sc, 1.0f, 3);
    ((u32*)dst)[i] = w;
  }
}
DI void phase_prologue(const Params& p, char* smem) {
  __syncthreads();
  conv_transpose_all(p, smem);
  for (int L = 0; L < 2; ++L) {
    u16* pad = p.wt_in() + (size_t)L * HLD * 2048 + (size_t)3904 * 2048;
    for (int i = obid() * NTHR + otid(); i < 192 * 2048 / 8; i += gridDim.x * NTHR) ((u32x4*)pad)[i] = u32x4{0, 0, 0, 0};
  }
  for (int i = obid() * NTHR + otid(); i < 2 * 256 * 128; i += gridDim.x * NTHR) {
    const int L = i >> 15, n = (i >> 7) & 255, k = i & 127;
    const int c = n >> 7, kin = k - 64 * c;
    const float v = (kin >= 0 && kin < 64) ? p.pkeys[((size_t)(L * 2 + c) * 128 + (n & 127)) * 64 + kin] : 0.f;
    p.keys_b()[i] = f2bf(v);
  }
  conv_flat(p.x, p.xb(), (size_t)T * 2048 / 4);
  for (int i = obid() * NTHR + otid(); i < SEQ * 32; i += gridDim.x * NTHR) {
    const int pos = i >> 5, f = i & 31;
    const float inv = powf(10000.0f, -(float)f / 32.0f);
    const float ang = (float)pos * inv;
    p.ropeC()[i] = cosf(ang);
    p.ropeS()[i] = sinf(ang);
  }
}

#define EPI_IDS                                                                                     \
  const int etid = otid();                                                                          \
  const int lane = etid & 63, wid = etid >> 6, wm = wid >> 2, wn = wid & 3, hh = lane >> 5, l31 = lane & 31;

constexpr int EPI_TS = 264;
#define EPI_LDS_WRITE(SCALE_EXPR)                                                             \
  {                                                                                           \
    u16* sT_ = (u16*)smem;                                                                    \
    _Pragma("unroll") for (int i = 0; i < 4; ++i)                                             \
      _Pragma("unroll") for (int j = 0; j < 2; ++j)                                           \
        _Pragma("unroll") for (int r = 0; r < 16; ++r) {                                      \
          const int rl = wm * 128 + i * 32 + crow(r, hh);                                     \
          sT_[rl * EPI_TS + wn * 64 + j * 32 + l31] = f2bf(acc[i][j][r] * (SCALE_EXPR));      \
        }                                                                                     \
    __syncthreads();                                                                          \
  }

DI void phase_gemm1(const Params& p, int L, char* smem) {
  const u16* Wt = p.wt_in() + (size_t)L * HLD * 2048;
  const float* sRow = (const float*)(smem + GEMM_SROW_OFF);
  for (int it = 0;; ++it) {
    int mt, nt;
    if (!gemm_tile_map(it, 64, 16, mt, nt)) { if (mt < 0) break; continue; }
    f32x16 acc[4][2];
    const int tile_id = mt * 16 + nt;
    const bool isv = tile_id >= 512;
    const float4* csrc = (const float4*)((isv ? p.pv : p.pu) + (size_t)L * NEXP * 2048) + (size_t)(tile_id & 511) * 32 * NTHR;
    u16* cdst = (u16*)((isv ? p.vb() : p.ub()) + (size_t)L * NEXP * 1024) + (size_t)(tile_id & 511) * 32 * NTHR;
    gemm_mainloop<true, true>(p.xb() + (size_t)mt * GM * 2048, 2048, Wt + (size_t)nt * GN * 2048, 2048, 2048, smem, acc, csrc, cdst,
                              isv ? V_SCALE : U_SCALE);
    EPI_IDS
    const int nt128 = nt * 2 + (wn >> 1), wn1 = wn & 1;
    const int m0 = mt * GM, b = m0 >> 12, s0 = m0 & 4095;
    const bool plain = (nt != 5) && (nt != 10) && (nt != 11) && (nt != 15);
    if (plain) {
      const float sc = (nt < 4 || nt == 6 || nt == 7) ? QSCALE_AB : 1.f;
      EPI_LDS_WRITE(sRow[rl] * sc)
      const u16* sT = (const u16*)smem;
#pragma unroll 4
      for (int it = 0; it < 16; ++it) {
        const int c = etid + NTHR * it, row = c >> 5, cc = c & 31;
        *(u32x4*)(p.h() + (size_t)(m0 + row) * HLD + nt * GN + cc * 8) = *(const u32x4*)(sT + row * EPI_TS + cc * 8);
      }
    } else {
    if (nt128 >= 30) {
      if (nt128 == 30 && wn1 == 0) {
#pragma unroll
        for (int i = 0; i < 4; ++i)
#pragma unroll
          for (int r = 0; r < 16; ++r) {
            const int rl = wm * 128 + i * 32 + crow(r, hh);
            const float rs = sRow[rl];
            const float x1 = acc[i][0][r] * rs, x2 = acc[i][1][r] * rs;
            const int pos = s0 + rl;
            const float c = p.ropeC()[pos * 32 + l31], sn = p.ropeS()[pos * 32 + l31];
            const u16 o1 = f2bf(x1 * c - x2 * sn), o2 = f2bf(x1 * sn + x2 * c);
            u16* sT_ = (u16*)smem;
            sT_[rl * EPI_TS + l31] = o1;
            sT_[rl * EPI_TS + 32 + l31] = o2;
            if ((r & 3) == 3) __builtin_amdgcn_sched_barrier(0);
          }
      }
    } else if (nt128 == 10 || nt128 == 11 || (nt128 >= 20 && nt128 < 24)) {
      u16* vt;
      int nh, hd;
      if (nt128 < 12) { vt = p.vtA(); nh = 2; hd = nt128 - 10; } else { vt = p.vtB(); nh = 4; hd = nt128 - 20; }
#pragma unroll
      for (int i = 0; i < 4; ++i)
#pragma unroll
        for (int j = 0; j < 2; ++j)
#pragma unroll
          for (int g4 = 0; g4 < 4; ++g4) {
            const int rl0 = wm * 128 + i * 32 + 8 * g4 + 4 * hh;
            const int d = wn1 * 64 + j * 32 + l31;
            const float v0 = acc[i][j][4 * g4 + 0] * sRow[rl0 + 0], v1 = acc[i][j][4 * g4 + 1] * sRow[rl0 + 1];
            const float v2 = acc[i][j][4 * g4 + 2] * sRow[rl0 + 2], v3 = acc[i][j][4 * g4 + 3] * sRow[rl0 + 3];
            u32x2 w = {pack2bf(v0, v1), pack2bf(v2, v3)};
            *(u32x2*)(vt + ((size_t)(b * nh + hd) * 128 + d) * 4096 + s0 + rl0) = w;
          }
    } else {
      const float sc = (nt128 < 8 || (nt128 >= 12 && nt128 < 16)) ? QSCALE_AB : 1.f;
#pragma unroll
      for (int i = 0; i < 4; ++i)
#pragma unroll
        for (int j = 0; j < 2; ++j)
#pragma unroll
          for (int r = 0; r < 16; ++r) {
            const int rl = wm * 128 + i * 32 + crow(r, hh);
            p.h()[(size_t)(m0 + rl) * HLD + nt128 * 128 + wn1 * 64 + j * 32 + l31] = f2bf(acc[i][j][r] * sRow[rl] * sc);
          }
    }
    if (nt == 15) {
      __syncthreads();
      const u16* sT = (const u16*)smem;
#pragma unroll 4
      for (int it = 0; it < 16; ++it) {
        const int c = etid + NTHR * it, hd = c >> 11, row = (c >> 3) & 255, cc = c & 7;
        *(u32x4*)(p.kmla() + ((size_t)(b * 4 + hd) * 4096 + s0 + row) * 192 + 128 + cc * 8) = *(const u32x4*)(sT + row * EPI_TS + cc * 8);
      }
    }
    }
  }
}

DI void tile_upq(const Params& p, int L, int tile, char* smem) {
  const float* sRow = (const float*)(smem + GEMM_SROW_OFF);
  const int mt = tile / 3, nt = tile % 3;
  f32x16 acc[4][2];
  gemm_mainloop<true>(p.h() + (size_t)mt * GM * HLD + 3072, HLD, p.wt_uq() + (size_t)L * 768 * 512 + (size_t)nt * GN * 512, 512, 512,
                      smem, acc);
  EPI_IDS
  const int m0 = mt * GM, b = m0 >> 12, s0 = m0 & 4095;
  EPI_LDS_WRITE(sRow[rl] * QSCALE_C)
  {
    const u16* sT = (const u16*)smem;
#pragma unroll 4
    for (int it = 0; it < 16; ++it) {
      const int c = etid + NTHR * it, row = c >> 5, cc = c & 31;
      const int nb64 = nt * 4 + (cc >> 3);
      const int head = nb64 / 3, part = nb64 % 3;
      *(u32x4*)(p.qmla() + ((size_t)(b * 4 + head) * 4096 + s0 + row) * 192 + part * 64 + (cc & 7) * 8) = *(const u32x4*)(sT + row * EPI_TS + cc * 8);
    }
  }
}

DI void tile_upkv(const Params& p, int L, int tile, char* smem) {
  const float* sRow = (const float*)(smem + GEMM_SROW_OFF);
  const int mt = tile >> 2, nt = tile & 3;
  f32x16 acc[4][2];
  gemm_mainloop<true>(p.h() + (size_t)mt * GM * HLD + 3584, HLD, p.wt_ukv() + (size_t)L * 1024 * 256 + (size_t)nt * GN * 256, 256, 256,
                      smem, acc);
  EPI_IDS
  const int nt128 = nt * 2 + (wn >> 1), wn1 = wn & 1;
  const int m0 = mt * GM, b = m0 >> 12, s0 = m0 & 4095;
  const int head = nt128 >> 1;
  EPI_LDS_WRITE(sRow[rl])
  {
    const u16* sT = (const u16*)smem;
#pragma unroll 4
    for (int it = 0; it < 8; ++it) {
      const int c = etid + NTHR * it, row = c >> 4, cc = c & 15;
      *(u32x4*)(p.kmla() + ((size_t)(b * 4 + nt) * 4096 + s0 + row) * 192 + cc * 8) = *(const u32x4*)(sT + row * EPI_TS + cc * 8);
    }
  }
  if (nt128 & 1) {
#pragma unroll
    for (int i = 0; i < 4; ++i)
#pragma unroll
      for (int j = 0; j < 2; ++j)
#pragma unroll
        for (int g4 = 0; g4 < 4; ++g4) {
          const int rl0 = wm * 128 + i * 32 + 8 * g4 + 4 * hh;
          const int d = wn1 * 64 + j * 32 + l31;
          const float v0 = acc[i][j][4 * g4 + 0] * sRow[rl0 + 0], v1 = acc[i][j][4 * g4 + 1] * sRow[rl0 + 1];
          const float v2 = acc[i][j][4 * g4 + 2] * sRow[rl0 + 2], v3 = acc[i][j][4 * g4 + 3] * sRow[rl0 + 3];
          u32x2 w = {pack2bf(v0, v1), pack2bf(v2, v3)};
          *(u32x2*)(p.vtC() + ((size_t)(b * 4 + head) * 128 + d) * 4096 + s0 + rl0) = w;
        }
  }
}

DI void phase_gemm_o(const Params& p, int L, char* smem) {
  const u16* Wt = p.wt_o() + (size_t)L * 2048 * 2048;
  for (int it = 0;; ++it) {
    int mt, nt;
    if (!gemm_tile_map(it, 64, 8, mt, nt)) { if (mt < 0) break; continue; }
    f32x16 acc[4][2];
    {
      float* sRow = (float*)(smem + GEMM_SROW_OFF);
      const int t = otid();
      __syncthreads();
      if (t < 256) {
        const float4* sp = (const float4*)(p.ssqh() + (size_t)(mt * GM + t) * 16);
        const float4 a0 = sp[0], a1 = sp[1], b0 = sp[2], c0 = sp[3];
        sRow[t * 4 + 0] = rsqrtf((a0.x + a0.y + a0.z + a0.w + a1.x + a1.y + a1.z + a1.w) * (1.f / 1024.f) + EPS);
        sRow[t * 4 + 1] = rsqrtf((b0.x + b0.y + b0.z + b0.w) * (1.f / 512.f) + EPS);
        sRow[t * 4 + 2] = rsqrtf((c0.x + c0.y + c0.z + c0.w) * (1.f / 512.f) + EPS);
      }
    }
    gemm_mainloop<false, false, true>(p.o() + (size_t)mt * GM * 2048, 2048, Wt + (size_t)nt * GN * 2048, 2048, 2048, smem, acc);
    EPI_IDS
    EPI_LDS_WRITE(1.f)
    {
      const u16* sT = (const u16*)smem;
#pragma unroll 4
      for (int it = 0; it < 16; ++it) {
        const int c = etid + NTHR * it, row = c >> 5, cc = c & 31;
        u16* xp = p.xb() + (size_t)(mt * GM + row) * 2048 + nt * GN + cc * 8;
        const u32x4 d = *(const u32x4*)(sT + row * EPI_TS + cc * 8);
        u32x4 x = *(const u32x4*)xp;
        x.x = pack2bf(bf_lo(x.x) + bf_lo(d.x), bf_hi(x.x) + bf_hi(d.x));
        x.y = pack2bf(bf_lo(x.y) + bf_lo(d.y), bf_hi(x.y) + bf_hi(d.y));
        x.z = pack2bf(bf_lo(x.z) + bf_lo(d.z), bf_hi(x.z) + bf_hi(d.z));
        x.w = pack2bf(bf_lo(x.w) + bf_lo(d.w), bf_hi(x.w) + bf_hi(d.w));
        *(u32x4*)xp = x;
      }
    }
  }
}

DI void phase_gemm_pq(const Params& p, int L, char* smem) {
  const u16* Wt = p.wt_pq() + (size_t)L * 1024 * 2048;
  const float* sRow = (const float*)(smem + GEMM_SROW_OFF);
  for (int tile = obid(); tile < 64 * 4; tile += gridDim.x) {
    const int mt = tile >> 2, nt = tile & 3;
    f32x16 acc[4][2];
    gemm_mainloop<true>(p.xb() + (size_t)mt * GM * 2048, 2048, Wt + (size_t)nt * GN * 2048, 2048, 2048, smem, acc);
    EPI_IDS
    EPI_LDS_WRITE(sRow[rl])
    {
      const u16* sT = (const u16*)smem;
#pragma unroll 4
      for (int it = 0; it < 16; ++it) {
        const int c = etid + NTHR * it, row = c >> 5, cc = c & 31;
        *(u32x4*)(p.pq() + (size_t)(mt * GM + row) * 1024 + nt * GN + cc * 8) = *(const u32x4*)(sT + row * EPI_TS + cc * 8);
      }
    }
  }
}

DI void phase_gemm_scores(const Params& p, int L, char* smem) {
  for (int mt = obid(); mt < 512; mt += gridDim.x) {
    f32x16 acc[4][2];
    gemm_mainloop<false>(p.pq() + (size_t)mt * GM * 128, 128, p.keys_b() + (size_t)L * 256 * 128, 128, 128, smem, acc);
    EPI_IDS
#pragma unroll
    for (int i = 0; i < 4; ++i)
#pragma unroll
      for (int j = 0; j < 2; ++j)
#pragma unroll
        for (int r = 0; r < 16; ++r) {
          const int rl = wm * 128 + i * 32 + crow(r, hh);
          p.scores()[(size_t)(mt * GM + rl) * 256 + wn * 64 + j * 32 + l31] = acc[i][j][r];
        }
  }
}

template <int DQK, int MODE>
DI void attn_block(char* smem, const u16* __restrict__ Q, int ldq, const u16* __restrict__ Kb, int ldk,
                   const u16* __restrict__ Vt, int t0, int t1, int qpos0, float slope2, float sink2,
                   const float* __restrict__ biasTbl, u16* __restrict__ Oout, float* __restrict__ ssq_out,
                   const float* __restrict__ ropeCS = nullptr) {
  constexpr int LDK = DQK + 8;
  constexpr int NCH = DQK / 8;
  constexpr int KCH = NCH / 8;
  constexpr int NKS = DQK / 16;
  constexpr int STG = 64 * LDK + 128 * 68;
  u16* sbase = (u16*)smem;
  float* sBias = (float*)(sbase + 2 * STG);
  const int tid = otid(), lane = tid & 63, wid = tid >> 6, hh = lane >> 5, l31 = lane & 31;

  __syncthreads();
  if (MODE == 1) {
    for (int i = tid; i < 465; i += NTHR) sBias[i] = biasTbl[i] * LOG2E;
  }
  bf16x8 qf[NKS];
  {
    const u16* qrow = Q + (size_t)(wid * 32 + l31) * ldq + hh * 8;
#pragma unroll
    for (int ks = 0; ks < NKS; ++ks) qf[ks] = *(const bf16x8*)(qrow + ks * 16);
  }
  if (MODE == 2) {
    const int pos = qpos0 + wid * 32 + l31;
#pragma unroll
    for (int k2 = 0; k2 < 2; ++k2) {
      const float* cp = ropeCS + (size_t)pos * 32 + k2 * 16 + 8 * hh;
      const float* sp = ropeCS + (size_t)SEQ * 32 + (size_t)pos * 32 + k2 * 16 + 8 * hh;
#pragma unroll
      for (int j = 0; j < 8; ++j) {
        const float c = cp[j], sn = sp[j];
        const float x1 = __uint_as_float(((u32)(u16)qf[NKS - 4 + k2][j]) << 16);
        const float x2 = __uint_as_float(((u32)(u16)qf[NKS - 2 + k2][j]) << 16);
        qf[NKS - 4 + k2][j] = (short)f2bf(x1 * c - x2 * sn);
        qf[NKS - 2 + k2][j] = (short)f2bf(x1 * sn + x2 * c);
      }
    }
  }
  constexpr float SM_THR = 6.f;
  float m_run = (MODE == 0) ? sink2 : 0.f;
  float l_run = (MODE == 0 && hh == 0) ? 1.f : 0.f;
  bool first = true;
  f32x16 oacc[4];
#pragma unroll
  for (int d = 0; d < 4; ++d)
#pragma unroll
    for (int r = 0; r < 16; ++r) oacc[d][r] = 0.f;

  const int widu = __builtin_amdgcn_readfirstlane(wid);
  const int qw0 = qpos0 + widu * 32;
  const int qpos = qw0 + l31;
  const int rq = (qpos0 >> 6) + (widu >> 1);
  const int rsq = min(max(rq - 4, 0), 56);
  const int cq = (wid & 1) * 32 + l31;
  const int cs = min(max(cq - 8, 0), 48);

  u32x4 rk[KCH], rv[2];
#define ATTN_LOAD_TILE(TT)                                                              \
  {                                                                                     \
    _Pragma("unroll") for (int i = 0; i < KCH; ++i) {                                   \
      const int c = tid + NTHR * i;                                                     \
      const int rr = c / NCH, cc = c % NCH;                                             \
      rk[i] = *(const u32x4*)(Kb + (size_t)((TT) * 64 + rr) * ldk + cc * 8);            \
    }                                                                                   \
    _Pragma("unroll") for (int i = 0; i < 2; ++i) {                                     \
      const int c = tid + NTHR * i;                                                     \
      const int d = c >> 3, part = c & 7;                                               \
      rv[i] = *(const u32x4*)(Vt + (size_t)d * 4096 + (TT) * 64 + part * 8);            \
    }                                                                                   \
  }
#define ATTN_STORE_TILE(STAGE)                                                          \
  {                                                                                     \
    u16* sKw = sbase + (STAGE) * STG;                                                   \
    u16* sVw = sKw + 64 * LDK;                                                          \
    _Pragma("unroll") for (int i = 0; i < KCH; ++i) {                                   \
      const int c = tid + NTHR * i;                                                     \
      const int rr = c / NCH, cc = c % NCH;                                             \
      *(u32x4*)(sKw + rr * LDK + cc * 8) = rk[i];                                       \
    }                                                                                   \
    _Pragma("unroll") for (int i = 0; i < 2; ++i) {                                     \
      const int c = tid + NTHR * i;                                                     \
      const int d = c >> 3, part = c & 7;                                               \
      *(u32x2*)(sVw + d * 68 + part * 8) = u32x2{rv[i].x, rv[i].y};                     \
      *(u32x2*)(sVw + d * 68 + part * 8 + 4) = u32x2{rv[i].z, rv[i].w};                 \
    }                                                                                   \
  }
  ATTN_LOAD_TILE(t0)
  ATTN_STORE_TILE(0)
  __syncthreads();
#pragma unroll 1
  for (int t = t0; t < t1; ++t) {
    const int cur = (t - t0) & 1;
    {
      const int tn = (t + 1 < t1) ? t + 1 : t;
      ATTN_LOAD_TILE(tn)
    }
    const u16* sK = sbase + cur * STG;
    const u16* sV = sK + 64 * LDK;
    bool relevant = true;
    if (MODE == 0) relevant = (t * 64 <= qw0 + 31 + 128) && (t * 64 + 63 >= qw0 - 128);
    if (MODE == 1) relevant = (t >= rsq) && (t < rsq + 8);
    if (relevant) {
      f32x16 sacc[2];
#pragma unroll
      for (int tt = 0; tt < 2; ++tt) {
#pragma unroll
        for (int r = 0; r < 16; ++r) sacc[tt][r] = -m_run;
        const u16* kp = sK + (tt * 32 + l31) * LDK + hh * 8;
#pragma unroll
        for (int ks = 0; ks < NKS; ++ks) {
          bf16x8 kf = *(const bf16x8*)(kp + ks * 16);
          sacc[tt] = MFMA32(kf, qf[ks], sacc[tt]);
        }
      }
      float mx = -INFINITY;
      const int drow = min(max(t - rq + 7, 0), 14) * 31;
#pragma unroll
      for (int tt = 0; tt < 2; ++tt)
#pragma unroll
        for (int r = 0; r < 16; ++r) {
          float sv = sacc[tt][r];
          const int kl = tt * 32 + crow(r, hh);
          if (MODE == 0) {
            const int kpos = t * 64 + kl;
            int dist = qpos - kpos;
            dist = dist < 0 ? -dist : dist;
            sv = (dist <= 128) ? (sv - slope2 * (float)dist) : -INFINITY;
          } else if (MODE == 1) {
            const bool ok = ((unsigned)(kl - cs) < 16u);
            const int dc = min(max(kl - cq + 15, 0), 30);
            sv = ok ? (sv + sBias[drow + dc]) : -INFINITY;
          }
          sacc[tt][r] = sv;
          mx = fmaxf(mx, sv);
        }
      mx = fmaxf(mx, __shfl_xor(mx, 32));
      if (__builtin_amdgcn_ballot_w64(first || (mx > SM_THR)) != 0ull) {
        float delta = fmaxf(mx, 0.f);
        if (first && MODE != 0) delta = (mx > -INFINITY) ? mx : 0.f;
        m_run += delta;
        const float alpha = __builtin_amdgcn_exp2f(-delta);
        l_run *= alpha;
#pragma unroll
        for (int d = 0; d < 4; ++d)
#pragma unroll
          for (int r = 0; r < 16; ++r) oacc[d][r] *= alpha;
#pragma unroll
        for (int tt = 0; tt < 2; ++tt)
#pragma unroll
          for (int r = 0; r < 16; ++r) sacc[tt][r] -= delta;
        first = false;
      }
      float ps = 0.f;
#pragma unroll
      for (int tt = 0; tt < 2; ++tt) {
#pragma unroll
        for (int r = 0; r < 16; ++r) {
          const float pv = __builtin_amdgcn_exp2f(sacc[tt][r]);
          sacc[tt][r] = pv;
          ps += pv;
        }
#pragma unroll
        for (int s2 = 0; s2 < 2; ++s2) {
          u32x4 w;
          w.x = pack2bf(sacc[tt][8 * s2 + 0], sacc[tt][8 * s2 + 1]);
          w.y = pack2bf(sacc[tt][8 * s2 + 2], sacc[tt][8 * s2 + 3]);
          w.z = pack2bf(sacc[tt][8 * s2 + 4], sacc[tt][8 * s2 + 5]);
          w.w = pack2bf(sacc[tt][8 * s2 + 6], sacc[tt][8 * s2 + 7]);
          const bf16x8 pf = __builtin_bit_cast(bf16x8, w);
#pragma unroll
          for (int dt = 0; dt < 4; ++dt) {
            const u16* vp = sV + (dt * 32 + l31) * 68 + 4 * hh;
            const u32x2 lo = *(const u32x2*)(vp + tt * 32 + s2 * 16);
            const u32x2 hi = *(const u32x2*)(vp + tt * 32 + s2 * 16 + 8);
            u32x4 wv = {lo.x, lo.y, hi.x, hi.y};
            oacc[dt] = MFMA32(__builtin_bit_cast(bf16x8, wv), pf, oacc[dt]);
          }
        }
      }
      l_run += ps;
    }
    ATTN_STORE_TILE(cur ^ 1)
    __syncthreads();
  }
  const float lt = l_run + __shfl_xor(l_run, 32);
  const float inv = 1.f / lt;
  float sq = 0.f;
  u16* orow = Oout + (size_t)(wid * 32 + l31) * 2048;
#pragma unroll
  for (int dt = 0; dt < 4; ++dt)
#pragma unroll
    for (int g4 = 0; g4 < 4; ++g4) {
      const float v0 = oacc[dt][4 * g4 + 0] * inv, v1 = oacc[dt][4 * g4 + 1] * inv;
      const float v2 = oacc[dt][4 * g4 + 2] * inv, v3 = oacc[dt][4 * g4 + 3] * inv;
      sq += v0 * v0 + v1 * v1 + v2 * v2 + v3 * v3;
      u32x2 w = {pack2bf(v0, v1), pack2bf(v2, v3)};
      *(u32x2*)(orow + dt * 32 + 8 * g4 + 4 * hh) = w;
    }
  sq += __shfl_xor(sq, 32);
  if (hh == 0) ssq_out[(size_t)(wid * 32 + l31) * 16] = sq;
}

DI void phase_mix(const Params& p, int L, char* smem) {
  for (int w = obid(); w < 256; w += gridDim.x) {
    const int b = w >> 6, rem = w & 63, rg = rem >> 2, hb = rem & 3;
    const int r0 = rg * 4;
    const int t0 = min(max(r0 - 4, 0), 56), t1 = min(max(r0 - 1, 0), 56) + 8;
    const size_t tok0 = (size_t)b * 4096 + r0 * 64;
    attn_block<128, 1>(smem, p.h() + tok0 * HLD + 1536 + hb * 128, HLD, p.h() + (size_t)b * 4096 * HLD + 2048 + hb * 128, HLD,
                       p.vtB() + (size_t)(b * 4 + hb) * 128 * 4096, t0, t1, r0 * 64, 0.f, 0.f,
                       p.b_rel + (size_t)L * 4 * 465 + hb * 465, p.o() + tok0 * 2048 + 1024 + hb * 128, p.ssqh() + tok0 * 16 + 8 + hb);
  }
  for (int ww = obid(); ww < 512; ww += gridDim.x) {
    const int b = ww >> 7, rem = ww & 127, sb = rem >> 3, hq = rem & 7;
    const int t0 = max(0, 4 * sb - 2), t1 = min(64, 4 * sb + 6);
    const size_t tok0 = (size_t)b * 4096 + sb * 256;
    const float slope2 = exp2f(-(float)(hq + 1)) * LOG2E;
    const float sink2 = p.a_sink[L * 8 + hq] * LOG2E;
    attn_block<128, 0>(smem, p.h() + tok0 * HLD + hq * 128, HLD, p.h() + (size_t)b * 4096 * HLD + 1024 + (hq >> 2) * 128, HLD,
                       p.vtA() + (size_t)(b * 2 + (hq >> 2)) * 128 * 4096, t0, t1, sb * 256, slope2, sink2, nullptr,
                       p.o() + tok0 * 2048 + hq * 128, p.ssqh() + tok0 * 16 + hq);
  }
  for (int w = (obid() + 64) % gridDim.x; w < 192; w += gridDim.x) tile_upq(p, L, w, smem);
  for (int w = obid(); w < 256; w += gridDim.x) tile_upkv(p, L, w, smem);
}

DI void phase_mla(const Params& p, char* smem) {
  const int nbx = gridDim.x >> 3;
  for (int li = obid() >> 3; li < 32; li += nbx) {
    const int pair = (obid() & 7) * 2 + (li >> 4), nq = li & 15;
    const int b = pair >> 2, hc = pair & 3;
    const size_t tok0 = (size_t)b * 4096 + nq * 256;
    attn_block<192, 2>(smem, p.qmla() + ((size_t)(b * 4 + hc) * 4096 + nq * 256) * 192, 192, p.kmla() + (size_t)(b * 4 + hc) * 4096 * 192, 192,
                       p.vtC() + (size_t)(b * 4 + hc) * 128 * 4096, 0, 64, nq * 256, 0.f, 0.f, nullptr,
                       p.o() + tok0 * 2048 + 1536 + hc * 128, p.ssqh() + tok0 * 16 + 12 + hc, p.ropeC());
  }
}

DI void phase_onorm(const Params& p) {
  const int lane = otid() & 63, wid = otid() >> 6;
  for (int row = obid() * NWAVE + wid; row < T; row += gridDim.x * NWAVE) {
    const float4* sp = (const float4*)(p.ssqh() + (size_t)row * 16);
    const float4 a0 = sp[0], a1 = sp[1], b0 = sp[2], c0 = sp[3];
    const float rA = rsqrtf((a0.x + a0.y + a0.z + a0.w + a1.x + a1.y + a1.z + a1.w) * (1.f / 1024.f) + EPS);
    const float rB = rsqrtf((b0.x + b0.y + b0.z + b0.w) * (1.f / 512.f) + EPS);
    const float rC = rsqrtf((c0.x + c0.y + c0.z + c0.w) * (1.f / 512.f) + EPS);
#pragma unroll
    for (int j = 0; j < 4; ++j) {
      const float sc = (j < 2) ? rA : (j == 2 ? rB : rC);
      const size_t off = (size_t)row * 2048 + j * 512 + lane * 8;
      u32x4 w = *(const u32x4*)(p.o() + off);
      w.x = pack2bf(bf_lo(w.x) * sc, bf_hi(w.x) * sc);
      w.y = pack2bf(bf_lo(w.y) * sc, bf_hi(w.y) * sc);
      w.z = pack2bf(bf_lo(w.z) * sc, bf_hi(w.z) * sc);
      w.w = pack2bf(bf_lo(w.w) * sc, bf_hi(w.w) * sc);
      *(u32x4*)(p.on() + off) = w;
    }
  }
}

DI u32 ordkey(float s) {
  const u32 u = __float_as_uint(s);
  return u ^ ((u >> 31) ? 0xFFFFFFFFu : 0x80000000u);
}
DI float unord(u32 k) {
  const u32 u = (k & 0x80000000u) ? (k ^ 0x80000000u) : ~k;
  return __uint_as_float(u);
}
DI void insert16(u32 (&Ls)[16], u32 key) {
#pragma unroll
  for (int q = 0; q < 16; ++q) {
    const u32 hi = max(Ls[q], key);
    key = min(Ls[q], key);
    Ls[q] = hi;
  }
}

DI void phase_select(const Params& p, int L, char* smem) {
  float* sS = (float*)smem;
  u32* sTop = (u32*)(smem + 256 * 132 * 4);
  const int tid = otid(), lane = tid & 63, wid = tid >> 6, hh = lane >> 5, l31 = lane & 31;
  const int rt = wid >> 1, c = wid & 1;
  const u16* kb = p.keys_b() + (size_t)L * 256 * 128;
  for (int it = obid(); it < 1024; it += gridDim.x) {
    f32x16 sc[4];
    {
      const u16* qrow = p.pq() + ((size_t)it * 128 + rt * 32 + l31) * 128 + c * 64 + hh * 8;
      bf16x8 qa[4];
#pragma unroll
      for (int ks = 0; ks < 4; ++ks) qa[ks] = *(const bf16x8*)(qrow + ks * 16);
#pragma unroll
      for (int ct = 0; ct < 4; ++ct) {
#pragma unroll
        for (int r = 0; r < 16; ++r) sc[ct][r] = 0.f;
        const u16* krow = kb + (size_t)(c * 128 + ct * 32 + l31) * 128 + c * 64 + hh * 8;
#pragma unroll
        for (int ks = 0; ks < 4; ++ks) {
          const bf16x8 kf = *(const bf16x8*)(krow + ks * 16);
          sc[ct] = MFMA32(qa[ks], kf, sc[ct]);
        }
      }
    }
    __syncthreads();
#pragma unroll
    for (int ct = 0; ct < 4; ++ct)
#pragma unroll
      for (int r = 0; r < 16; ++r) sS[((rt * 32 + crow(r, hh)) * 2 + c) * 132 + ct * 32 + l31] = sc[ct][r];
    __syncthreads();
    {
      const int combo = tid >> 1, half = tid & 1;
      u32 Ls[16];
#pragma unroll
      for (int q = 0; q < 16; ++q) Ls[q] = 0u;
      const float* sp = sS + combo * 132 + half * 64;
      for (int n4 = 0; n4 < 16; ++n4) {
        const int n4r = (n4 + half * 8) & 15;
        const float4 v = *(const float4*)(sp + n4r * 4);
        const int nb = half * 64 + n4r * 4;
        insert16(Ls, (ordkey(v.x) & ~0x7Fu) | (u32)(127 - (nb + 0)));
        insert16(Ls, (ordkey(v.y) & ~0x7Fu) | (u32)(127 - (nb + 1)));
        insert16(Ls, (ordkey(v.z) & ~0x7Fu) | (u32)(127 - (nb + 2)));
        insert16(Ls, (ordkey(v.w) & ~0x7Fu) | (u32)(127 - (nb + 3)));
      }
      u32 Ms[16];
#pragma unroll
      for (int q = 0; q < 16; ++q) {
        const u32 other = (u32)__shfl_xor((int)Ls[15 - q], 1);
        Ms[q] = max(Ls[q], other);
      }
#pragma unroll
      for (int span = 8; span >= 1; span >>= 1)
#pragma unroll
        for (int q = 0; q < 16; ++q)
          if ((q & span) == 0) {
            const u32 hi = max(Ms[q], Ms[q + span]), lo = min(Ms[q], Ms[q + span]);
            Ms[q] = hi;
            Ms[q + span] = lo;
          }
      if (half == 0) {
#pragma unroll
        for (int q = 0; q < 16; ++q) sTop[combo * 16 + q] = Ms[q];
      }
    }
    __syncthreads();
    if (tid < 128) {
      const u32* t0 = sTop + (tid * 2) * 16;
      const u32* t1 = sTop + (tid * 2 + 1) * 16;
      float s0[16], s1[16];
#pragma unroll
      for (int q = 0; q < 16; ++q) {
        s0[q] = unord(t0[q] & ~0x7Fu);
        s1[q] = unord(t1[q] & ~0x7Fu);
      }
      u32 M[16];
#pragma unroll
      for (int q = 0; q < 16; ++q) M[q] = 0u;
#pragma unroll
      for (int i = 0; i < 16; ++i)
#pragma unroll
        for (int j = 0; j < 16; ++j)
          if ((i + 1) * (j + 1) <= 16) {
            const float sm = s0[i] + s1[j];
            insert16(M, (ordkey(sm) & ~0xFFu) | (u32)(255 - (i * 16 + j)));
          }
      const float mxv = unord(M[0] & ~0xFFu);
      float e[16], sum = 0.f;
#pragma unroll
      for (int q = 0; q < 16; ++q) {
        e[q] = __expf(unord(M[q] & ~0xFFu) - mxv);
        sum += e[q];
      }
      const float inv = 1.f / sum;
      const size_t row = (size_t)it * 128 + tid;
#pragma unroll
      for (int q = 0; q < 16; ++q) {
        const int ij = 255 - (int)(M[q] & 0xFFu);
        const int n0 = 127 - (int)(t0[ij >> 4] & 0x7Fu);
        const int n1 = 127 - (int)(t1[ij & 15] & 0x7Fu);
        p.idx()[row * 16 + q] = n0 * 128 + n1;
        p.g()[row * 16 + q] = e[q] * inv;
      }
    }
  }
}

DI float dot32(u32x4 w, const float2_t* xn2) {
  float2_t s = {0.f, 0.f};
#pragma unroll
  for (int c = 0; c < 4; ++c) {
    s = __builtin_elementwise_fma(__builtin_amdgcn_cvt_scalef32_pk_f32_fp4(w[c], 1.0f, 0), xn2[4 * c + 0], s);
    s = __builtin_elementwise_fma(__builtin_amdgcn_cvt_scalef32_pk_f32_fp4(w[c], 1.0f, 1), xn2[4 * c + 1], s);
    s = __builtin_elementwise_fma(__builtin_amdgcn_cvt_scalef32_pk_f32_fp4(w[c], 1.0f, 2), xn2[4 * c + 2], s);
    s = __builtin_elementwise_fma(__builtin_amdgcn_cvt_scalef32_pk_f32_fp4(w[c], 1.0f, 3), xn2[4 * c + 3], s);
  }
  return s.x + s.y;
}
DI void axpy32(u32x4 w, float a, float2_t* y2) {
  const float2_t a2 = {a, a};
#pragma unroll
  for (int c = 0; c < 4; ++c) {
    y2[4 * c + 0] = __builtin_elementwise_fma(__builtin_amdgcn_cvt_scalef32_pk_f32_fp4(w[c], 1.0f, 0), a2, y2[4 * c + 0]);
    y2[4 * c + 1] = __builtin_elementwise_fma(__builtin_amdgcn_cvt_scalef32_pk_f32_fp4(w[c], 1.0f, 1), a2, y2[4 * c + 1]);
    y2[4 * c + 2] = __builtin_elementwise_fma(__builtin_amdgcn_cvt_scalef32_pk_f32_fp4(w[c], 1.0f, 2), a2, y2[4 * c + 2]);
    y2[4 * c + 3] = __builtin_elementwise_fma(__builtin_amdgcn_cvt_scalef32_pk_f32_fp4(w[c], 1.0f, 3), a2, y2[4 * c + 3]);
  }
}
DI float gelu_tanh(float a) {
  const float u = 0.7978845608028654f * (a + 0.044715f * a * a * a);
  return 0.5f * a * (1.f + tanhf(u));
}

DI void phase_gather(const Params& p, int L, bool last) {
  const int wid = otid() >> 6;
  const unsigned char* U = p.ub() + (size_t)L * NEXP * 1024;
  const unsigned char* V = p.vb() + (size_t)L * NEXP * 1024;
  const float* ln2 = p.ln2 + L * 2048;
  int ni0 = 0, ni1 = 0;
  float ng0 = 0.f, ng1 = 0.f;
  {
    const int t0 = obid() * NWAVE + wid, l0 = otid() & 63;
    if (t0 < T) {
      ni0 = p.idx()[(size_t)t0 * 128 + l0]; ni1 = p.idx()[(size_t)t0 * 128 + 64 + l0];
      ng0 = p.g()[(size_t)t0 * 128 + l0];   ng1 = p.g()[(size_t)t0 * 128 + 64 + l0];
    }
  }
  for (int t = obid() * NWAVE + wid; t < T; t += gridDim.x * NWAVE) {
    const int lane = otid() & 63;
    const u16* xr = p.xb() + (size_t)t * 2048;
    float2_t xn2[16];
    float ss = 0.f;
    u32x4 xkeep[4];
#pragma unroll
    for (int c8 = 0; c8 < 4; ++c8) {
      const u32x4 a = *(const u32x4*)(xr + lane * 32 + c8 * 8);
      xkeep[c8] = a;
      xn2[c8 * 4 + 0] = float2_t{bf_lo(a.x), bf_hi(a.x)};
      xn2[c8 * 4 + 1] = float2_t{bf_lo(a.y), bf_hi(a.y)};
      xn2[c8 * 4 + 2] = float2_t{bf_lo(a.z), bf_hi(a.z)};
      xn2[c8 * 4 + 3] = float2_t{bf_lo(a.w), bf_hi(a.w)};
    }
#pragma unroll
    for (int e = 0; e < 16; ++e) ss += xn2[e].x * xn2[e].x + xn2[e].y * xn2[e].y;
    ss = wave_sum(ss);
    const float rstd = rsqrtf(ss * (1.f / 2048.f) + EPS) * (1.f / U_SCALE);
#pragma unroll
    for (int c4 = 0; c4 < 8; ++c4) {
      const float4 a = *(const float4*)(ln2 + lane * 32 + c4 * 4);
      xn2[c4 * 2 + 0] *= float2_t{rstd * a.x, rstd * a.y};
      xn2[c4 * 2 + 1] *= float2_t{rstd * a.z, rstd * a.w};
    }
    const int i0 = ni0, i1 = ni1;
    const float g0 = ng0, g1 = ng1;
    float a0 = 0.f, a1 = 0.f;
#pragma unroll
    for (int half = 0; half < 2; ++half) {
      const int iv = half ? i1 : i0;
      float av = 0.f;
#pragma unroll 1
      for (int k0 = 0; k0 < 64; k0 += 16) {
        u32x4 w[16];
#pragma unroll
        for (int q = 0; q < 16; ++q) {
          const int row = __builtin_amdgcn_readlane(iv, k0 + q);
          w[q] = *(const u32x4*)(U + (size_t)row * 1024 + lane * 16);
        }
        float d[16];
#pragma unroll
        for (int q = 0; q < 16; ++q) {
          __builtin_amdgcn_sched_barrier(0);
          if (q > 0) asm volatile("" : "+v"(w[q]), "+v"(d[q - 1]));
          d[q] = dot32(w[q], xn2);
        }
        __builtin_amdgcn_sched_barrier(0);
        {
          const bool b5 = (lane & 32) != 0, b4 = (lane & 16) != 0, b3 = (lane & 8) != 0, b2 = (lane & 4) != 0;
          float e8[8], e4[4], e2[2], e1;
#pragma unroll
          for (int j = 0; j < 8; ++j) {
            const float snd = b5 ? d[j] : d[j + 8];
            const float kep = b5 ? d[j + 8] : d[j];
            e8[j] = kep + __shfl_xor(snd, 32);
          }
#pragma unroll
          for (int j = 0; j < 4; ++j) {
            const float snd = b4 ? e8[j] : e8[j + 4];
            const float kep = b4 ? e8[j + 4] : e8[j];
            e4[j] = kep + __shfl_xor(snd, 16);
          }
#pragma unroll
          for (int j = 0; j < 2; ++j) {
            const float snd = b3 ? e4[j] : e4[j + 2];
            const float kep = b3 ? e4[j + 2] : e4[j];
            e2[j] = kep + __shfl_xor(snd, 8);
          }
          {
            const float snd = b2 ? e2[0] : e2[1];
            const float kep = b2 ? e2[1] : e2[0];
            e1 = kep + __shfl_xor(snd, 4);
          }
          e1 += __shfl_xor(e1, 2);
          e1 += __shfl_xor(e1, 1);
          const float got = __shfl(e1, ((lane - k0) & 15) * 4);
          if (lane >= k0 && lane < k0 + 16) av = got;
        }
      }
      if (half) a1 = av; else a0 = av;
    }
    const float hs0 = gelu_tanh(a0) * g0 * (1.f / V_SCALE), hs1 = gelu_tanh(a1) * g1 * (1.f / V_SCALE);
    {
      const int tn = t + gridDim.x * NWAVE;
      if (tn < T) {
        ni0 = p.idx()[(size_t)tn * 128 + lane]; ni1 = p.idx()[(size_t)tn * 128 + 64 + lane];
        ng0 = p.g()[(size_t)tn * 128 + lane];   ng1 = p.g()[(size_t)tn * 128 + 64 + lane];
      }
    }
    float2_t y2[16];
#pragma unroll
    for (int e = 0; e < 16; ++e) y2[e] = float2_t{0.f, 0.f};
#pragma unroll
    for (int half = 0; half < 2; ++half) {
      const int iv = half ? i1 : i0;
      const int hv = __float_as_int(half ? hs1 : hs0);
#pragma unroll 1
      for (int k0 = 0; k0 < 64; k0 += 8) {
        u32x4 w[8];
        float wq[8];
#pragma unroll
        for (int q = 0; q < 8; ++q) {
          const int row = __builtin_amdgcn_readlane(iv, k0 + q);
          wq[q] = __int_as_float(__builtin_amdgcn_readlane(hv, k0 + q));
          w[q] = *(const u32x4*)(V + (size_t)row * 1024 + lane * 16);
        }
#pragma unroll
        for (int q = 0; q < 8; ++q) {
          __builtin_amdgcn_sched_barrier(0);
          asm volatile("" : "+v"(w[q]), "+v"(y2[0]), "+v"(y2[8]));
          axpy32(w[q], wq[q], y2);
        }
        __builtin_amdgcn_sched_barrier(0);
      }
    }
    int t2 = t;
    asm volatile("" : "+v"(t2));
    const int lane2 = otid() & 63;
#pragma unroll
    for (int c8 = 0; c8 < 4; ++c8) {
      const u32x4 a = xkeep[c8];
      y2[c8 * 4 + 0] += float2_t{bf_lo(a.x), bf_hi(a.x)};
      y2[c8 * 4 + 1] += float2_t{bf_lo(a.y), bf_hi(a.y)};
      y2[c8 * 4 + 2] += float2_t{bf_lo(a.z), bf_hi(a.z)};
      y2[c8 * 4 + 3] += float2_t{bf_lo(a.w), bf_hi(a.w)};
    }
    if (!last) {
#pragma unroll
      for (int c8 = 0; c8 < 4; ++c8) {
        const float2_t* yy = y2 + c8 * 4;
        u32x4 w = {pack2bf(yy[0].x, yy[0].y), pack2bf(yy[1].x, yy[1].y), pack2bf(yy[2].x, yy[2].y), pack2bf(yy[3].x, yy[3].y)};
        *(u32x4*)(p.xb() + (size_t)t2 * 2048 + lane2 * 32 + c8 * 8) = w;
      }
    } else {
      float ss2 = 0.f;
#pragma unroll
      for (int e = 0; e < 16; ++e) ss2 += y2[e].x * y2[e].x + y2[e].y * y2[e].y;
      ss2 = wave_sum(ss2);
      const float r2 = rsqrtf(ss2 * (1.f / 2048.f) + EPS);
      float* orow = p.out + (size_t)t2 * 2048;
#pragma unroll
      for (int c4 = 0; c4 < 8; ++c4) {
        const float4 a = *(const float4*)(p.fnorm + lane2 * 32 + c4 * 4);
        *(float4*)(orow + lane2 * 32 + c4 * 4) =
            float4{y2[c4 * 2].x * r2 * a.x, y2[c4 * 2].y * r2 * a.y, y2[c4 * 2 + 1].x * r2 * a.z, y2[c4 * 2 + 1].y * r2 * a.w};
      }
    }
  }
}


#define XB_TMO      128
#define XB_XCNT(j)  (256  + 64 * (j))
#define XB_XSUB(j)  (1280 + 64 * (j))
#define XB_XGEN(j)  (2304 + 64 * (j))
#define XB_TOP      3328
#define XB_TOPGEN   3392
#define XCD_BAR_WORDS 3456
#define XB_SPIN_CAP (1u << 18)
#define LAS __attribute__((address_space(3)))
DI unsigned xb_ld(unsigned* p) { return __hip_atomic_load(p, __ATOMIC_RELAXED, __HIP_MEMORY_SCOPE_AGENT); }
DI unsigned xb_add(unsigned* p, unsigned v) { return __hip_atomic_fetch_add(p, v, __ATOMIC_RELAXED, __HIP_MEMORY_SCOPE_AGENT); }
DI unsigned xb_xcc_id() { return (unsigned)__builtin_amdgcn_s_getreg((3 << 11) | 20) & 0xFu; }
#define XB_SPIN(cond, bar) do { unsigned _sp = 0; while (cond) { __builtin_amdgcn_s_sleep(1); \
    if ((++_sp & 255u) == 0u) { if (xb_ld(&(bar)[XB_TMO])) break; if (_sp > XB_SPIN_CAP) { atomicAdd(&(bar)[XB_TMO], 1u); break; } } } } while (0)
struct XcdBarrier { unsigned* bar; unsigned x; volatile LAS unsigned* st; };
DI XcdBarrier xcd_barrier_post(unsigned* bar, volatile LAS unsigned* st) {
  XcdBarrier b; b.bar = bar; b.x = xb_xcc_id(); b.st = st;
  if (threadIdx.x == 0) (void)xb_add(&bar[XB_XCNT(b.x)], 1u);
  return b;
}
DI void xcd_barrier_complete(unsigned* bar, unsigned x, unsigned& nloc, unsigned& nx) {
  const unsigned G = gridDim.x * gridDim.y * gridDim.z;
  unsigned sum, cnt, mine, sp = 0u;
  for (;;) {
    sum = 0u; cnt = 0u; mine = 0u;
#pragma unroll
    for (unsigned j = 0; j < 16; ++j) { const unsigned c = xb_ld(&bar[XB_XCNT(j)]); sum += c; cnt += (c > 0u) ? 1u : 0u; mine = (j == x) ? c : mine; }
    if (sum == G) break;
    __builtin_amdgcn_s_sleep(1);
    if ((++sp & 255u) == 0u) { if (xb_ld(&bar[XB_TMO])) break; if (sp > XB_SPIN_CAP) { atomicAdd(&bar[XB_TMO], 1u); break; } }
  }
  nloc = mine > 0u ? mine : 1u; nx = cnt > 0u ? cnt : 1u;
}
DI void xcd_barrier(const XcdBarrier& b) {
  asm volatile("s_waitcnt vmcnt(0)" ::: "memory");
  __syncthreads();
  if (threadIdx.x == 0) {
    unsigned* bar = b.bar;
    __builtin_amdgcn_s_waitcnt(0);
    unsigned nloc = b.st[0], nx = b.st[1];
    if (nloc == 0u) { xcd_barrier_complete(bar, b.x, nloc, nx); b.st[0] = nloc; b.st[1] = nx; }
    const unsigned old = xb_add(&bar[XB_XSUB(b.x)], 1u);
    const unsigned gen = old / nloc;
    if (old + 1u == (gen + 1u) * nloc) {
      __builtin_amdgcn_fence(__ATOMIC_RELEASE, "agent");
      asm volatile("s_waitcnt vmcnt(0)" ::: "memory");
      const unsigned og = xb_add(&bar[XB_TOP], 1u);
      const unsigned tg = og / nx;
      if (og + 1u == (tg + 1u) * nx) xb_add(&bar[XB_TOPGEN], 1u);
      else XB_SPIN(xb_ld(&bar[XB_TOPGEN]) == tg, bar);
      __builtin_amdgcn_fence(__ATOMIC_ACQUIRE, "agent");
      xb_add(&bar[XB_XGEN(b.x)], 1u);
      asm volatile("s_waitcnt vmcnt(0)" ::: "memory");
    } else {
      XB_SPIN(xb_ld(&bar[XB_XGEN(b.x)]) == gen, bar);
      __builtin_amdgcn_fence(__ATOMIC_ACQUIRE, "agent");
      asm volatile("s_waitcnt vmcnt(0)" ::: "memory");
    }
  }
  __syncthreads();
}

#define KDEF(name, body)                                                       \
  __global__ void __launch_bounds__(512) name(Params p, int L) {            \
    __shared__ __attribute__((aligned(16))) char smem[SMEM_BYTES];             \
    body;                                                                      \
  }
#if !MEGA
KDEF(k_prologue, phase_prologue(p, smem))
KDEF(k_gemm1, phase_gemm1(p, L, smem))
KDEF(k_mix, phase_mix(p, L, smem))
KDEF(k_mla, phase_mla(p, smem))
KDEF(k_onorm, phase_onorm(p))
KDEF(k_gemm_o, phase_gemm_o(p, L, smem))
KDEF(k_gemm_pq, phase_gemm_pq(p, L, smem))
KDEF(k_scores, phase_gemm_scores(p, L, smem))
KDEF(k_select, phase_select(p, L, smem))
KDEF(k_gather, phase_gather(p, L, L == 1))
#else
#ifndef PROBE_MASK
#define PROBE_MASK 0
#endif
#define RUN(bit, call)                         \
  call;                                        \
  if (PROBE_MASK & (bit)) {                    \
    grid.sync();                               \
    call;                                      \
  }
__global__ void __launch_bounds__(512) mega_coop(Params p) {
  __shared__ __attribute__((aligned(16))) char smem[SMEM_BYTES];
  __shared__ uint4 xb_words;
  cg::grid_group grid = cg::this_grid();
  if (threadIdx.x == 0) xb_words = make_uint4(0u, 0u, 0u, 0u);
  __syncthreads();
  const XcdBarrier xb = xcd_barrier_post((unsigned*)(p.ws + WS_NEED), (volatile LAS unsigned*)&xb_words);
#define GSYNC xcd_barrier(xb)
  RUN(256, phase_prologue(p, smem))
  if (p.ws == nullptr) grid.sync();
  GSYNC;
#pragma unroll 1
  for (int L = 0; L < 2; ++L) {
    phase_gemm1(p, L, smem);
    GSYNC;
    phase_mix(p, L, smem);
    GSYNC;
    phase_mla(p, smem);
    GSYNC;
    phase_gemm_o(p, L, smem);
    GSYNC;
    phase_gemm_pq(p, L, smem);
    GSYNC;
    phase_select(p, L, smem);
    GSYNC;
    phase_gather(p, L, L == 1);
    if (L == 0) GSYNC;
  }
}
#endif

extern "C" void kernel_launch(void* const* d_in, const int* in_sizes, int n_in, void* d_out, int out_size, void* d_ws,
                              size_t ws_size, hipStream_t stream) {
  Params p{};
  p.x = (const float*)d_in[0]; p.ln1 = (const float*)d_in[1]; p.w_in = (const float*)d_in[2]; p.a_sink = (const float*)d_in[3];
  p.b_rel = (const float*)d_in[4]; p.cqn = (const float*)d_in[5]; p.ckvn = (const float*)d_in[6]; p.wuq = (const float*)d_in[7];
  p.wukv = (const float*)d_in[8]; p.onorm = (const float*)d_in[9]; p.wo = (const float*)d_in[10]; p.ln2 = (const float*)d_in[11];
  p.pwq = (const float*)d_in[12]; p.pkeys = (const float*)d_in[13]; p.pu = (const float*)d_in[14]; p.pv = (const float*)d_in[15];
  p.fnorm = (const float*)d_in[16];
  p.out = (float*)d_out;
  p.ws = (char*)d_ws;
  if (WS_NEED + XCD_BAR_WORDS * sizeof(unsigned) > ws_size) { fprintf(stderr, "kernel_launch: workspace too small (%zu > %zu)\n", (size_t)WS_NEED, ws_size); return; }

#if MEGA
  static int grid_blocks = 0;
  if (!grid_blocks) {
    int dev = 0, cus = 0, per_cu = 0;
    hipGetDevice(&dev);
    hipDeviceGetAttribute(&cus, hipDeviceAttributeMultiprocessorCount, dev);
    hipOccupancyMaxActiveBlocksPerMultiprocessor(&per_cu, mega_coop, NTHR, 0);
    if (per_cu > 1) per_cu = 1;
    if (per_cu < 1) per_cu = 1;
    grid_blocks = (cus * per_cu) & ~7;
  }
  (void)hipMemsetAsync(p.ws + WS_NEED, 0, XCD_BAR_WORDS * sizeof(unsigned), stream);
  void* args[] = {&p};
  hipError_t e = hipLaunchCooperativeKernel((void*)mega_coop, dim3(grid_blocks), dim3(NTHR), args, 0, stream);
  if (e != hipSuccess) fprintf(stderr, "cooperative launch failed: %s (grid %d)\n", hipGetErrorString(e), grid_blocks);
#else
  const dim3 g(256), b(NTHR);
  k_prologue<<<g, b, 0, stream>>>(p, 0);
  for (int L = 0; L < 2; ++L) {
    k_gemm1<<<g, b, 0, stream>>>(p, L);
    k_mix<<<g, b, 0, stream>>>(p, L);
    k_mla<<<g, b, 0, stream>>>(p, L);
    k_gemm_o<<<g, b, 0, stream>>>(p, L);
    k_gemm_pq<<<g, b, 0, stream>>>(p, L);
    k_select<<<g, b, 0, stream>>>(p, L);
    k_gather<<<g, b, 0, stream>>>(p, L);
  }
#endif
}
```

```cpp
#include <hip/hip_runtime.h>
#include <hip/hip_cooperative_groups.h>
#include <cstdio>
namespace cg = cooperative_groups;

#ifndef MEGA
#define MEGA 1
#endif

#define DI __device__ __forceinline__
typedef unsigned short u16;
typedef unsigned int u32;
using bf16x8 = __attribute__((ext_vector_type(8))) short;
using f32x16 = __attribute__((ext_vector_type(16))) float;
typedef __bf16 bf16x2_t __attribute__((ext_vector_type(2)));
typedef float float2_t __attribute__((ext_vector_type(2)));
typedef unsigned int u32x4 __attribute__((ext_vector_type(4)));
typedef unsigned int u32x2 __attribute__((ext_vector_type(2)));

constexpr int T = 16384, SEQ = 4096, DM = 2048, HLD = 4096;
constexpr int NTHR = 512, NWAVE = 8;
constexpr int NEXP = 16384;
constexpr float EPS = 1e-6f;
constexpr float LOG2E = 1.4426950408889634f;
constexpr float QSCALE_AB = 0.08838834764831845f * LOG2E;
constexpr float QSCALE_C = 0.07216878364870323f * LOG2E;
constexpr float U_SCALE = 90.5f, V_SCALE = 8.f;
constexpr int LDT = 72;
constexpr int GEMM_STAGE = 512 * LDT;
constexpr int GEMM_SROW_OFF = 2 * GEMM_STAGE * 2;
constexpr int SMEM_BYTES = 256 * 132 * 4 + 256 * 16 * 4;

#define MFMA32(a, b, c) __builtin_amdgcn_mfma_f32_32x32x16_bf16((a), (b), (c), 0, 0, 0)

constexpr size_t al256(size_t x) { return (x + 255) & ~(size_t)255; }
constexpr size_t OFF_wt_in = 0;
constexpr size_t OFF_wt_o = OFF_wt_in + al256((size_t)2 * HLD * 2048 * 2);
constexpr size_t OFF_wt_pq = OFF_wt_o + al256((size_t)2 * 2048 * 2048 * 2);
constexpr size_t OFF_wt_uq = OFF_wt_pq + al256((size_t)2 * 1024 * 2048 * 2);
constexpr size_t OFF_wt_ukv = OFF_wt_uq + al256((size_t)2 * 768 * 512 * 2);
constexpr size_t OFF_keys_b = OFF_wt_ukv + al256((size_t)2 * 1024 * 256 * 2);
constexpr size_t OFF_ub = OFF_keys_b + al256((size_t)2 * 256 * 128 * 2);
constexpr size_t OFF_vb = OFF_ub + al256((size_t)2 * NEXP * 1024);
constexpr size_t OFF_ropeC = OFF_vb + al256((size_t)2 * NEXP * 1024);
constexpr size_t OFF_ropeS = OFF_ropeC + al256((size_t)SEQ * 32 * 4);
constexpr size_t OFF_xres = OFF_ropeS + al256((size_t)SEQ * 32 * 4);
constexpr size_t OFF_xb = OFF_xres + al256((size_t)T * 2048 * 4);
constexpr size_t OFF_h = OFF_xb + al256((size_t)T * 2048 * 2);
constexpr size_t OFF_vtA = OFF_h + al256((size_t)T * HLD * 2);
constexpr size_t OFF_vtB = OFF_vtA + al256((size_t)T * 256 * 2);
constexpr size_t OFF_kmla = OFF_vtB + al256((size_t)T * 512 * 2);
constexpr size_t OFF_vtC = OFF_kmla + al256((size_t)T * 4 * 192 * 2);
constexpr size_t OFF_qmla = OFF_vtC + al256((size_t)T * 512 * 2);
constexpr size_t OFF_o = OFF_qmla + al256((size_t)T * 4 * 192 * 2);
constexpr size_t OFF_on = OFF_o + al256((size_t)T * 2048 * 2);
constexpr size_t OFF_ssqh = OFF_on + al256((size_t)T * 2048 * 2);
constexpr size_t OFF_END1 = OFF_ssqh + al256((size_t)T * 16 * 4);
constexpr size_t OFF_pq = OFF_h;
constexpr size_t OFF_scores = OFF_pq + al256((size_t)T * 1024 * 2);
constexpr size_t OFF_idx = OFF_scores + al256((size_t)T * 8 * 256 * 4);
constexpr size_t OFF_g = OFF_idx + al256((size_t)T * 128 * 4);
constexpr size_t OFF_END2 = OFF_g + al256((size_t)T * 128 * 4);
constexpr size_t WS_NEED = OFF_END1 > OFF_END2 ? OFF_END1 : OFF_END2;

struct Params {
  const float *x, *ln1, *w_in, *a_sink, *b_rel, *cqn, *ckvn, *wuq, *wukv, *onorm, *wo, *ln2, *pwq, *pkeys, *pu, *pv, *fnorm;
  float* out;
  char* ws;
  DI u16* wt_in() const { return (u16*)(ws + OFF_wt_in); }
  DI u16* wt_o() const { return (u16*)(ws + OFF_wt_o); }
  DI u16* wt_pq() const { return (u16*)(ws + OFF_wt_pq); }
  DI u16* wt_uq() const { return (u16*)(ws + OFF_wt_uq); }
  DI u16* wt_ukv() const { return (u16*)(ws + OFF_wt_ukv); }
  DI u16* keys_b() const { return (u16*)(ws + OFF_keys_b); }
  DI unsigned char* ub() const { return (unsigned char*)(ws + OFF_ub); }
  DI unsigned char* vb() const { return (unsigned char*)(ws + OFF_vb); }
  DI float* ropeC() const { return (float*)(ws + OFF_ropeC); }
  DI float* ropeS() const { return (float*)(ws + OFF_ropeS); }
  DI float* xres() const { return (float*)(ws + OFF_xres); }
  DI u16* xb() const { return (u16*)(ws + OFF_xb); }
  DI u16* h() const { return (u16*)(ws + OFF_h); }
  DI u16* vtA() const { return (u16*)(ws + OFF_vtA); }
  DI u16* vtB() const { return (u16*)(ws + OFF_vtB); }
  DI u16* kmla() const { return (u16*)(ws + OFF_kmla); }
  DI u16* vtC() const { return (u16*)(ws + OFF_vtC); }
  DI u16* qmla() const { return (u16*)(ws + OFF_qmla); }
  DI u16* o() const { return (u16*)(ws + OFF_o); }
  DI u16* on() const { return (u16*)(ws + OFF_on); }
  DI float* ssqh() const { return (float*)(ws + OFF_ssqh); }
  DI u16* pq() const { return (u16*)(ws + OFF_pq); }
  DI float* scores() const { return (float*)(ws + OFF_scores); }
  DI int* idx() const { return (int*)(ws + OFF_idx); }
  DI float* g() const { return (float*)(ws + OFF_g); }
};

DI int otid() { int t = threadIdx.x; asm volatile("" : "+v"(t)); return t; }
DI int obid() { int b = blockIdx.x; asm volatile("" : "+s"(b)); return b; }
DI u16 f2bf(float x) {
  u32 u = __float_as_uint(x);
  u += 0x7fffu + ((u >> 16) & 1u);
  return (u16)(u >> 16);
}
DI u32 pack2bf(float a, float b) {
  float2_t f = {a, b};
  bf16x2_t r = __builtin_convertvector(f, bf16x2_t);
  return __builtin_bit_cast(u32, r);
}
DI float bf_lo(u32 w) { return __uint_as_float(w << 16); }
DI float bf_hi(u32 w) { return __uint_as_float(w & 0xffff0000u); }
DI int crow(int r, int h) { return (r & 3) + 8 * (r >> 2) + 4 * h; }
DI float wave_sum(float v) {
#pragma unroll
  for (int o = 32; o >= 1; o >>= 1) v += __shfl_xor(v, o);
  return v;
}
DI float ssq8(u32x4 w) {
  float s = 0.f, a;
  a = bf_lo(w.x); s += a * a; a = bf_hi(w.x); s += a * a;
  a = bf_lo(w.y); s += a * a; a = bf_hi(w.y); s += a * a;
  a = bf_lo(w.z); s += a * a; a = bf_hi(w.z); s += a * a;
  a = bf_lo(w.w); s += a * a; a = bf_hi(w.w); s += a * a;
  return s;
}
DI bool gemm_tile_map(int it, int MT, int NT, int& mt, int& nt) {
  const int b = obid(), x = b & 7, nb = gridDim.x >> 3;
  const int li = it * nb + (b >> 3);
  const int nrn = (NT + 7) >> 3, nrect = (MT >> 3) * nrn;
  const int q = x + 8 * (li >> 6);
  if (q >= nrect) { mt = -1; nt = 0; return false; }
  const int in = li & 63;
  mt = (q / nrn) * 8 + (in >> 3);
  nt = (q % nrn) * 8 + (in & 7);
  return nt < NT;
}

constexpr int GM = 256, GN = 256;
DI u32x4 scale8(u32x4 w, float sc) {
  w.x = pack2bf(bf_lo(w.x) * sc, bf_hi(w.x) * sc);
  w.y = pack2bf(bf_lo(w.y) * sc, bf_hi(w.y) * sc);
  w.z = pack2bf(bf_lo(w.z) * sc, bf_hi(w.z) * sc);
  w.w = pack2bf(bf_lo(w.w) * sc, bf_hi(w.w) * sc);
  return w;
}
template <bool ROWNORM, bool CONV = false, bool ASCALE = false>
DI void gemm_mainloop(const u16* __restrict__ Ag, int lda, const u16* __restrict__ Bg, int ldb, int K, char* smem,
                      f32x16 (&acc)[4][2], const float4* __restrict__ csrc = nullptr, u16* __restrict__ cdst = nullptr,
                      float cscale = 1.f) {
  u16* sbase = (u16*)smem;
  float* sRow = (float*)(smem + GEMM_SROW_OFF);
  const int tid = otid(), lane = tid & 63, wid = tid >> 6;
  const int wm = wid >> 2, wn = wid & 3, hh = lane >> 5, l31 = lane & 31;
  const int lr = tid >> 3, lc = (tid & 7) * 8;
#pragma unroll
  for (int i = 0; i < 4; ++i)
#pragma unroll
    for (int j = 0; j < 2; ++j)
#pragma unroll
      for (int r = 0; r < 16; ++r) acc[i][j][r] = 0.f;
  u32x4 ra[4], rb[4];
  float ssq[4] = {0.f, 0.f, 0.f, 0.f};
  const u16* ap = Ag + (size_t)lr * lda + lc;
  const u16* bp = Bg + (size_t)lr * ldb + lc;
#pragma unroll
  for (int i = 0; i < 4; ++i) {
    ra[i] = *(const u32x4*)(ap + (size_t)(64 * i) * lda);
    rb[i] = *(const u32x4*)(bp + (size_t)(64 * i) * ldb);
  }
  __syncthreads();
#pragma unroll
  for (int i = 0; i < 4; ++i) {
    if (ASCALE) ra[i] = scale8(ra[i], sRow[(lr + 64 * i) * 4 + 0]);
    *(u32x4*)(sbase + (lr + 64 * i) * LDT + lc) = ra[i];
    *(u32x4*)(sbase + (256 + lr + 64 * i) * LDT + lc) = rb[i];
    if (ROWNORM) ssq[i] += ssq8(ra[i]);
  }
  __syncthreads();
  const int nk = K >> 6;
  float4 cv = float4{0.f, 0.f, 0.f, 0.f};
  if (CONV) cv = csrc[tid];
#pragma unroll 1
  for (int kt = 0; kt < nk; ++kt) {
    const int cur = kt & 1;
    const bool more = (kt + 1 < nk);
    const int kn = more ? kt + 1 : kt;
#pragma unroll
    for (int i = 0; i < 4; ++i) {
      ra[i] = *(const u32x4*)(ap + (size_t)(64 * i) * lda + kn * 64);
      rb[i] = *(const u32x4*)(bp + (size_t)(64 * i) * ldb + kn * 64);
    }
    float4 cvn = cv;
    if (CONV) cvn = csrc[(size_t)kn * NTHR + tid];
    const u16* a_s = sbase + cur * GEMM_STAGE + (wm * 128 + l31) * LDT + hh * 8;
    const u16* b_s = sbase + cur * GEMM_STAGE + (256 + wn * 64 + l31) * LDT + hh * 8;
#pragma unroll
    for (int ks = 0; ks < 4; ++ks) {
      const bf16x8 b0 = *(const bf16x8*)(b_s + ks * 16);
      const bf16x8 b1 = *(const bf16x8*)(b_s + 32 * LDT + ks * 16);
      bf16x8 a0[4];
#pragma unroll
      for (int i = 0; i < 4; ++i) a0[i] = *(const bf16x8*)(a_s + i * 32 * LDT + ks * 16);
      __builtin_amdgcn_s_setprio(1);
#pragma unroll
      for (int i = 0; i < 4; ++i) {
        acc[i][0] = MFMA32(a0[i], b0, acc[i][0]);
        acc[i][1] = MFMA32(a0[i], b1, acc[i][1]);
      }
      __builtin_amdgcn_s_setprio(0);
    }
    {
      u16* w = sbase + (cur ^ 1) * GEMM_STAGE;
      const int g = (kn < 16) ? 0 : (kn < 24 ? 1 : 2);
#pragma unroll
      for (int i = 0; i < 4; ++i) {
        if (ASCALE) ra[i] = scale8(ra[i], sRow[(lr + 64 * i) * 4 + g]);
        *(u32x4*)(w + (lr + 64 * i) * LDT + lc) = ra[i];
        *(u32x4*)(w + (256 + lr + 64 * i) * LDT + lc) = rb[i];
        if (ROWNORM) ssq[i] += more ? ssq8(ra[i]) : 0.f;
      }
    }
    if (CONV) {
      u32 w4 = 0;
      w4 = __builtin_amdgcn_cvt_scalef32_pk_fp4_f32(w4, cv.x * cscale, cv.y * cscale, 1.0f, 0);
      w4 = __builtin_amdgcn_cvt_scalef32_pk_fp4_f32(w4, cv.z * cscale, cv.w * cscale, 1.0f, 1);
      cdst[(size_t)kt * NTHR + tid] = (u16)w4;
      cv = cvn;
    }
    if (CONV) {
      asm volatile("s_waitcnt lgkmcnt(0)" ::: "memory");
      __builtin_amdgcn_s_barrier();
      asm volatile("" ::: "memory");
    } else {
      __syncthreads();
    }
  }
  if (ROWNORM) {
#pragma unroll
    for (int i = 0; i < 4; ++i) {
      float s = ssq[i];
      s += __shfl_xor(s, 1);
      s += __shfl_xor(s, 2);
      s += __shfl_xor(s, 4);
      if ((tid & 7) == 0) sRow[lr + 64 * i] = rsqrtf(s / (float)K + EPS);
    }
    __syncthreads();
  }
}

DI void conv_transpose_all(const Params& p, char* smem) {
  const int lane = otid() & 63, wid = otid() >> 6;
  float* s = (float*)smem + wid * (64 * 65);
  constexpr int T0 = 32 * 61, T1 = T0 + 32 * 32, T2 = T1 + 32 * 16, T3 = T2 + 8 * 12, T4 = T3 + 4 * 16;
  for (int f = obid() * NWAVE + wid; f < 2 * T4; f += gridDim.x * NWAVE) {
    const int L = f / T4, r = f % T4;
    const float* W; const float* g; u16* Wt; int K, N, tile;
    if (r < T0)      { W = p.w_in + (size_t)L * 2048 * 3904; g = p.ln1 + L * 2048;   Wt = p.wt_in() + (size_t)L * HLD * 2048;   K = 2048; N = 3904; tile = r; }
    else if (r < T1) { W = p.wo + (size_t)L * 2048 * 2048;   g = p.onorm + L * 2048; Wt = p.wt_o() + (size_t)L * 2048 * 2048;   K = 2048; N = 2048; tile = r - T0; }
    else if (r < T2) { W = p.pwq + (size_t)L * 2048 * 1024;  g = p.ln2 + L * 2048;   Wt = p.wt_pq() + (size_t)L * 1024 * 2048;  K = 2048; N = 1024; tile = r - T1; }
    else if (r < T3) { W = p.wuq + (size_t)L * 512 * 768;    g = p.cqn + L * 512;    Wt = p.wt_uq() + (size_t)L * 768 * 512;    K = 512;  N = 768;  tile = r - T2; }
    else             { W = p.wukv + (size_t)L * 256 * 1024;  g = p.ckvn + L * 256;   Wt = p.wt_ukv() + (size_t)L * 1024 * 256;  K = 256;  N = 1024; tile = r - T3; }
    const int ntn = N / 64;
    const int k0 = (tile / ntn) * 64, n0 = (tile % ntn) * 64;
#pragma unroll 8
    for (int kk = 0; kk < 64; ++kk) s[kk * 65 + lane] = W[(size_t)(k0 + kk) * N + n0 + lane] * g[k0 + kk];
    __builtin_amdgcn_fence(__ATOMIC_RELEASE, "wavefront");
    __builtin_amdgcn_wave_barrier();
    __builtin_amdgcn_fence(__ATOMIC_ACQUIRE, "wavefront");
#pragma unroll 8
    for (int nn = 0; nn < 64; ++nn) Wt[(size_t)(n0 + nn) * K + k0 + lane] = f2bf(s[lane * 65 + nn]);
    __builtin_amdgcn_fence(__ATOMIC_RELEASE, "wavefront");
    __builtin_amdgcn_wave_barrier();
    __builtin_amdgcn_fence(__ATOMIC_ACQUIRE, "wavefront");
  }
}
DI void conv_flat(const float* __restrict__ src, u16* __restrict__ dst, size_t n4) {
  for (size_t i = (size_t)obid() * NTHR + otid(); i < n4; i += (size_t)gridDim.x * NTHR) {
    float4 v = ((const float4*)src)[i];
    u32x2 w = {pack2bf(v.x, v.y), pack2bf(v.z, v.w)};
    ((u32x2*)dst)[i] = w;
  }
}
DI void conv_fp4(const float* __restrict__ src, unsigned char* __restrict__ dst, size_t n8, float sc) {
  for (size_t i = (size_t)obid() * NTHR + otid(); i < n8; i += (size_t)gridDim.x * NTHR) {
    const float4 a = ((const float4*)src)[i * 2 + 0], b = ((const float4*)src)[i * 2 + 1];
    u32 w = 0;
    w = __builtin_amdgcn_cvt_scalef32_pk_fp4_f32(w, a.x * sc, a.y * sc, 1.0f, 0);
    w = __builtin_amdgcn_cvt_scalef32_pk_fp4_f32(w, a.z * sc, a.w * sc, 1.0f, 1);
    w = __builtin_amdgcn_cvt_scalef32_pk_fp4_f32(w, b.x * sc, b.y * sc, 1.0f, 2);
    w = __builtin_amdgcn_cvt_scalef32_pk_fp4_f32(w, b.z * sc, b.w * sc, 1.0f, 3);
    ((u32*)dst)[i] = w;
  }
}
DI void phase_prologue(const Params& p, char* smem) {
  __syncthreads();
  conv_transpose_all(p, smem);
  for (int L = 0; L < 2; ++L) {
    u16* pad = p.wt_in() + (size_t)L * HLD * 2048 + (size_t)3904 * 2048;
    for (int i = obid() * NTHR + otid(); i < 192 * 2048 / 8; i += gridDim.x * NTHR) ((u32x4*)pad)[i] = u32x4{0, 0, 0, 0};
  }
  for (int i = obid() * NTHR + otid(); i < 2 * 256 * 128; i += gridDim.x * NTHR) {
    const int L = i >> 15, n = (i >> 7) & 255, k = i & 127;
    const int c = n >> 7, kin = k - 64 * c;
    const float v = (kin >= 0 && kin < 64) ? p.pkeys[((size_t)(L * 2 + c) * 128 + (n & 127)) * 64 + kin] : 0.f;
    p.keys_b()[i] = f2bf(v);
  }
  conv_flat(p.x, p.xb(), (size_t)T * 2048 / 4);
  for (int i = obid() * NTHR + otid(); i < SEQ * 32; i += gridDim.x * NTHR) {
    const int pos = i >> 5, f = i & 31;
    const float inv = powf(10000.0f, -(float)f / 32.0f);
    const float ang = (float)pos * inv;
    p.ropeC()[i] = cosf(ang);
    p.ropeS()[i] = sinf(ang);
  }
}

#define EPI_IDS                                                                                     \
  const int etid = otid();                                                                          \
  const int lane = etid & 63, wid = etid >> 6, wm = wid >> 2, wn = wid & 3, hh = lane >> 5, l31 = lane & 31;

constexpr int EPI_TS = 264;
#define EPI_LDS_WRITE(SCALE_EXPR)                                                             \
  {                                                                                           \
    u16* sT_ = (u16*)smem;                                                                    \
    _Pragma("unroll") for (int i = 0; i < 4; ++i)                                             \
      _Pragma("unroll") for (int j = 0; j < 2; ++j)                                           \
        _Pragma("unroll") for (int r = 0; r < 16; ++r) {                                      \
          const int rl = wm * 128 + i * 32 + crow(r, hh);                                     \
          sT_[rl * EPI_TS + wn * 64 + j * 32 + l31] = f2bf(acc[i][j][r] * (SCALE_EXPR));      \
        }                                                                                     \
    __syncthreads();                                                                          \
  }

DI void phase_gemm1(const Params& p, int L, char* smem) {
  const u16* Wt = p.wt_in() + (size_t)L * HLD * 2048;
  const float* sRow = (const float*)(smem + GEMM_SROW_OFF);
  for (int it = 0;; ++it) {
    int mt, nt;
    if (!gemm_tile_map(it, 64, 16, mt, nt)) { if (mt < 0) break; continue; }
    f32x16 acc[4][2];
    const int tile_id = mt * 16 + nt;
    const bool isv = tile_id >= 512;
    const float4* csrc = (const float4*)((isv ? p.pv : p.pu) + (size_t)L * NEXP * 2048) + (size_t)(tile_id & 511) * 32 * NTHR;
    u16* cdst = (u16*)((isv ? p.vb() : p.ub()) + (size_t)L * NEXP * 1024) + (size_t)(tile_id & 511) * 32 * NTHR;
    gemm_mainloop<true, true>(p.xb() + (size_t)mt * GM * 2048, 2048, Wt + (size_t)nt * GN * 2048, 2048, 2048, smem, acc, csrc, cdst,
                              isv ? V_SCALE : U_SCALE);
    EPI_IDS
    const int nt128 = nt * 2 + (wn >> 1), wn1 = wn & 1;
    const int m0 = mt * GM, b = m0 >> 12, s0 = m0 & 4095;
    const bool plain = (nt != 5) && (nt != 10) && (nt != 11) && (nt != 15);
    if (plain) {
      const float sc = (nt < 4 || nt == 6 || nt == 7) ? QSCALE_AB : 1.f;
      EPI_LDS_WRITE(sRow[rl] * sc)
      const u16* sT = (const u16*)smem;
#pragma unroll 4
      for (int it = 0; it < 16; ++it) {
        const int c = etid + NTHR * it, row = c >> 5, cc = c & 31;
        *(u32x4*)(p.h() + (size_t)(m0 + row) * HLD + nt * GN + cc * 8) = *(const u32x4*)(sT + row * EPI_TS + cc * 8);
      }
    } else {
    if (nt128 >= 30) {
      if (nt128 == 30 && wn1 == 0) {
#pragma unroll
        for (int i = 0; i < 4; ++i)
#pragma unroll
          for (int r = 0; r < 16; ++r) {
            const int rl = wm * 128 + i * 32 + crow(r, hh);
            const float rs = sRow[rl];
            const float x1 = acc[i][0][r] * rs, x2 = acc[i][1][r] * rs;
            const int pos = s0 + rl;
            const float c = p.ropeC()[pos * 32 + l31], sn = p.ropeS()[pos * 32 + l31];
            const u16 o1 = f2bf(x1 * c - x2 * sn), o2 = f2bf(x1 * sn + x2 * c);
            u16* sT_ = (u16*)smem;
            sT_[rl * EPI_TS + l31] = o1;
            sT_[rl * EPI_TS + 32 + l31] = o2;
            if ((r & 3) == 3) __builtin_amdgcn_sched_barrier(0);
          }
      }
    } else if (nt128 == 10 || nt128 == 11 || (nt128 >= 20 && nt128 < 24)) {
      u16* vt;
      int nh, hd;
      if (nt128 < 12) { vt = p.vtA(); nh = 2; hd = nt128 - 10; } else { vt = p.vtB(); nh = 4; hd = nt128 - 20; }
#pragma unroll
      for (int i = 0; i < 4; ++i)
#pragma unroll
        for (int j = 0; j < 2; ++j)
#pragma unroll
          for (int g4 = 0; g4 < 4; ++g4) {
            const int rl0 = wm * 128 + i * 32 + 8 * g4 + 4 * hh;
            const int d = wn1 * 64 + j * 32 + l31;
            const float v0 = acc[i][j][4 * g4 + 0] * sRow[rl0 + 0], v1 = acc[i][j][4 * g4 + 1] * sRow[rl0 + 1];
            const float v2 = acc[i][j][4 * g4 + 2] * sRow[rl0 + 2], v3 = acc[i][j][4 * g4 + 3] * sRow[rl0 + 3];
            u32x2 w = {pack2bf(v0, v1), pack2bf(v2, v3)};
            *(u32x2*)(vt + ((size_t)(b * nh + hd) * 128 + d) * 4096 + s0 + rl0) = w;
          }
    } else {
      const float sc = (nt128 < 8 || (nt128 >= 12 && nt128 < 16)) ? QSCALE_AB : 1.f;
#pragma unroll
      for (int i = 0; i < 4; ++i)
#pragma unroll
        for (int j = 0; j < 2; ++j)
#pragma unroll
          for (int r = 0; r < 16; ++r) {
            const int rl = wm * 128 + i * 32 + crow(r, hh);
            p.h()[(size_t)(m0 + rl) * HLD + nt128 * 128 + wn1 * 64 + j * 32 + l31] = f2bf(acc[i][j][r] * sRow[rl] * sc);
          }
    }
    if (nt == 15) {
      __syncthreads();
      const u16* sT = (const u16*)smem;
#pragma unroll 4
      for (int it = 0; it < 16; ++it) {
        const int c = etid + NTHR * it, hd = c >> 11, row = (c >> 3) & 255, cc = c & 7;
        *(u32x4*)(p.kmla() + ((size_t)(b * 4 + hd) * 4096 + s0 + row) * 192 + 128 + cc * 8) = *(const u32x4*)(sT + row * EPI_TS + cc * 8);
      }
    }
    }
  }
}

DI void tile_upq(const Params& p, int L, int tile, char* smem) {
  const float* sRow = (const float*)(smem + GEMM_SROW_OFF);
  const int mt = tile / 3, nt = tile % 3;
  f32x16 acc[4][2];
  gemm_mainloop<true>(p.h() + (size_t)mt * GM * HLD + 3072, HLD, p.wt_uq() + (size_t)L * 768 * 512 + (size_t)nt * GN * 512, 512, 512,
                      smem, acc);
  EPI_IDS
  const int m0 = mt * GM, b = m0 >> 12, s0 = m0 & 4095;
  EPI_LDS_WRITE(sRow[rl] * QSCALE_C)
  {
    const u16* sT = (const u16*)smem;
#pragma unroll 4
    for (int it = 0; it < 16; ++it) {
      const int c = etid + NTHR * it, row = c >> 5, cc = c & 31;
      const int nb64 = nt * 4 + (cc >> 3);
      const int head = nb64 / 3, part = nb64 % 3;
      *(u32x4*)(p.qmla() + ((size_t)(b * 4 + head) * 4096 + s0 + row) * 192 + part * 64 + (cc & 7) * 8) = *(const u32x4*)(sT + row * EPI_TS + cc * 8);
    }
  }
}

DI void tile_upkv(const Params& p, int L, int tile, char* smem) {
  const float* sRow = (const float*)(smem + GEMM_SROW_OFF);
  const int mt = tile >> 2, nt = tile & 3;
  f32x16 acc[4][2];
  gemm_mainloop<true>(p.h() + (size_t)mt * GM * HLD + 3584, HLD, p.wt_ukv() + (size_t)L * 1024 * 256 + (size_t)nt * GN * 256, 256, 256,
                      smem, acc);
  EPI_IDS
  const int nt128 = nt * 2 + (wn >> 1), wn1 = wn & 1;
  const int m0 = mt * GM, b = m0 >> 12, s0 = m0 & 4095;
  const int head = nt128 >> 1;
  EPI_LDS_WRITE(sRow[rl])
  {
    const u16* sT = (const u16*)smem;
#pragma unroll 4
    for (int it = 0; it < 8; ++it) {
      const int c = etid + NTHR * it, row = c >> 4, cc = c & 15;
      *(u32x4*)(p.kmla() + ((size_t)(b * 4 + nt) * 4096 + s0 + row) * 192 + cc * 8) = *(const u32x4*)(sT + row * EPI_TS + cc * 8);
    }
  }
  if (nt128 & 1) {
#pragma unroll
    for (int i = 0; i < 4; ++i)
#pragma unroll
      for (int j = 0; j < 2; ++j)
#pragma unroll
        for (int g4 = 0; g4 < 4; ++g4) {
          const int rl0 = wm * 128 + i * 32 + 8 * g4 + 4 * hh;
          const int d = wn1 * 64 + j * 32 + l31;
          const float v0 = acc[i][j][4 * g4 + 0] * sRow[rl0 + 0], v1 = acc[i][j][4 * g4 + 1] * sRow[rl0 + 1];
          const float v2 = acc[i][j][4 * g4 + 2] * sRow[rl0 + 2], v3 = acc[i][j][4 * g4 + 3] * sRow[rl0 + 3];
          u32x2 w = {pack2bf(v0, v1), pack2bf(v2, v3)};
          *(u32x2*)(p.vtC() + ((size_t)(b * 4 + head) * 128 + d) * 4096 + s0 + rl0) = w;
        }
  }
}

DI void phase_gemm_o(const Params& p, int L, char* smem) {
  const u16* Wt = p.wt_o() + (size_t)L * 2048 * 2048;
  for (int it = 0;; ++it) {
    int mt, nt;
    if (!gemm_tile_map(it, 64, 8, mt, nt)) { if (mt < 0) break; continue; }
    f32x16 acc[4][2];
    {
      float* sRow = (float*)(smem + GEMM_SROW_OFF);
      const int t = otid();
      __syncthreads();
      if (t < 256) {
        const float4* sp = (const float4*)(p.ssqh() + (size_t)(mt * GM + t) * 16);
        const float4 a0 = sp[0], a1 = sp[1], b0 = sp[2], c0 = sp[3];
        sRow[t * 4 + 0] = rsqrtf((a0.x + a0.y + a0.z + a0.w + a1.x + a1.y + a1.z + a1.w) * (1.f / 1024.f) + EPS);
        sRow[t * 4 + 1] = rsqrtf((b0.x + b0.y + b0.z + b0.w) * (1.f / 512.f) + EPS);
        sRow[t * 4 + 2] = rsqrtf((c0.x + c0.y + c0.z + c0.w) * (1.f / 512.f) + EPS);
      }
    }
    gemm_mainloop<false, false, true>(p.o() + (size_t)mt * GM * 2048, 2048, Wt + (size_t)nt * GN * 2048, 2048, 2048, smem, acc);
    EPI_IDS
    EPI_LDS_WRITE(1.f)
    {
      const u16* sT = (const u16*)smem;
#pragma unroll 4
      for (int it = 0; it < 16; ++it) {
        const int c = etid + NTHR * it, row = c >> 5, cc = c & 31;
        u16* xp = p.xb() + (size_t)(mt * GM + row) * 2048 + nt * GN + cc * 8;
        const u32x4 d = *(const u32x4*)(sT + row * EPI_TS + cc * 8);
        u32x4 x = *(const u32x4*)xp;
        x.x = pack2bf(bf_lo(x.x) + bf_lo(d.x), bf_hi(x.x) + bf_hi(d.x));
        x.y = pack2bf(bf_lo(x.y) + bf_lo(d.y), bf_hi(x.y) + bf_hi(d.y));
        x.z = pack2bf(bf_lo(x.z) + bf_lo(d.z), bf_hi(x.z) + bf_hi(d.z));
        x.w = pack2bf(bf_lo(x.w) + bf_lo(d.w), bf_hi(x.w) + bf_hi(d.w));
        *(u32x4*)xp = x;
      }
    }
  }
}

DI void phase_gemm_pq(const Params& p, int L, char* smem) {
  const u16* Wt = p.wt_pq() + (size_t)L * 1024 * 2048;
  const float* sRow = (const float*)(smem + GEMM_SROW_OFF);
  for (int tile = obid(); tile < 64 * 4; tile += gridDim.x) {
    const int mt = tile >> 2, nt = tile & 3;
    f32x16 acc[4][2];
    gemm_mainloop<true>(p.xb() + (size_t)mt * GM * 2048, 2048, Wt + (size_t)nt * GN * 2048, 2048, 2048, smem, acc);
    EPI_IDS
    EPI_LDS_WRITE(sRow[rl])
    {
      const u16* sT = (const u16*)smem;
#pragma unroll 4
      for (int it = 0; it < 16; ++it) {
        const int c = etid + NTHR * it, row = c >> 5, cc = c & 31;
        *(u32x4*)(p.pq() + (size_t)(mt * GM + row) * 1024 + nt * GN + cc * 8) = *(const u32x4*)(sT + row * EPI_TS + cc * 8);
      }
    }
  }
}

DI void phase_gemm_scores(const Params& p, int L, char* smem) {
  for (int mt = obid(); mt < 512; mt += gridDim.x) {
    f32x16 acc[4][2];
    gemm_mainloop<false>(p.pq() + (size_t)mt * GM * 128, 128, p.keys_b() + (size_t)L * 256 * 128, 128, 128, smem, acc);
    EPI_IDS
#pragma unroll
    for (int i = 0; i < 4; ++i)
#pragma unroll
      for (int j = 0; j < 2; ++j)
#pragma unroll
        for (int r = 0; r < 16; ++r) {
          const int rl = wm * 128 + i * 32 + crow(r, hh);
          p.scores()[(size_t)(mt * GM + rl) * 256 + wn * 64 + j * 32 + l31] = acc[i][j][r];
        }
  }
}

template <int DQK, int MODE>
DI void attn_block(char* smem, const u16* __restrict__ Q, int ldq, const u16* __restrict__ Kb, int ldk,
                   const u16* __restrict__ Vt, int t0, int t1, int qpos0, float slope2, float sink2,
                   const float* __restrict__ biasTbl, u16* __restrict__ Oout, float* __restrict__ ssq_out,
                   const float* __restrict__ ropeCS = nullptr) {
  constexpr int LDK = DQK + 8;
  constexpr int NCH = DQK / 8;
  constexpr int KCH = NCH / 8;
  constexpr int NKS = DQK / 16;
  constexpr int STG = 64 * LDK + 128 * 68;
  u16* sbase = (u16*)smem;
  float* sBias = (float*)(sbase + 2 * STG);
  const int tid = otid(), lane = tid & 63, wid = tid >> 6, hh = lane >> 5, l31 = lane & 31;

  __syncthreads();
  if (MODE == 1) {
    for (int i = tid; i < 465; i += NTHR) sBias[i] = biasTbl[i] * LOG2E;
  }
  bf16x8 qf[NKS];
  {
    const u16* qrow = Q + (size_t)(wid * 32 + l31) * ldq + hh * 8;
#pragma unroll
    for (int ks = 0; ks < NKS; ++ks) qf[ks] = *(const bf16x8*)(qrow + ks * 16);
  }
  if (MODE == 2) {
    const int pos = qpos0 + wid * 32 + l31;
#pragma unroll
    for (int k2 = 0; k2 < 2; ++k2) {
      const float* cp = ropeCS + (size_t)pos * 32 + k2 * 16 + 8 * hh;
      const float* sp = ropeCS + (size_t)SEQ * 32 + (size_t)pos * 32 + k2 * 16 + 8 * hh;
#pragma unroll
      for (int j = 0; j < 8; ++j) {
        const float c = cp[j], sn = sp[j];
        const float x1 = __uint_as_float(((u32)(u16)qf[NKS - 4 + k2][j]) << 16);
        const float x2 = __uint_as_float(((u32)(u16)qf[NKS - 2 + k2][j]) << 16);
        qf[NKS - 4 + k2][j] = (short)f2bf(x1 * c - x2 * sn);
        qf[NKS - 2 + k2][j] = (short)f2bf(x1 * sn + x2 * c);
      }
    }
  }
  constexpr float SM_THR = 6.f;
  float m_run = (MODE == 0) ? sink2 : 0.f;
  float l_run = (MODE == 0 && hh == 0) ? 1.f : 0.f;
  bool first = true;
  f32x16 oacc[4];
#pragma unroll
  for (int d = 0; d < 4; ++d)
#pragma unroll
    for (int r = 0; r < 16; ++r) oacc[d][r] = 0.f;

  const int widu = __builtin_amdgcn_readfirstlane(wid);
  const int qw0 = qpos0 + widu * 32;
  const int qpos = qw0 + l31;
  const int rq = (qpos0 >> 6) + (widu >> 1);
  const int rsq = min(max(rq - 4, 0), 56);
  const int cq = (wid & 1) * 32 + l31;
  const int cs = min(max(cq - 8, 0), 48);

  u32x4 rk[KCH], rv[2];
#define ATTN_LOAD_TILE(TT)                                                              \
  {                                                                                     \
    _Pragma("unroll") for (int i = 0; i < KCH; ++i) {                                   \
      const int c = tid + NTHR * i;                                                     \
      const int rr = c / NCH, cc = c % NCH;                                             \
      rk[i] = *(const u32x4*)(Kb + (size_t)((TT) * 64 + rr) * ldk + cc * 8);            \
    }                                                                                   \
    _Pragma("unroll") for (int i = 0; i < 2; ++i) {                                     \
      const int c = tid + NTHR * i;                                                     \
      const int d = c >> 3, part = c & 7;                                               \
      rv[i] = *(const u32x4*)(Vt + (size_t)d * 4096 + (TT) * 64 + part * 8);            \
    }                                                                                   \
  }
#define ATTN_STORE_TILE(STAGE)                                                          \
  {                                                                                     \
    u16* sKw = sbase + (STAGE) * STG;                                                   \
    u16* sVw = sKw + 64 * LDK;                                                          \
    _Pragma("unroll") for (int i = 0; i < KCH; ++i) {                                   \
      const int c = tid + NTHR * i;                                                     \
      const int rr = c / NCH, cc = c % NCH;                                             \
      *(u32x4*)(sKw + rr * LDK + cc * 8) = rk[i];                                       \
    }                                                                                   \
    _Pragma("unroll") for (int i = 0; i < 2; ++i) {                                     \
      const int c = tid + NTHR * i;                                                     \
      const int d = c >> 3, part = c & 7;                                               \
      *(u32x2*)(sVw + d * 68 + part * 8) = u32x2{rv[i].x, rv[i].y};                     \
      *(u32x2*)(sVw + d * 68 + part * 8 + 4) = u32x2{rv[i].z, rv[i].w};                 \
    }                                                                                   \
  }
  ATTN_LOAD_TILE(t0)
  ATTN_STORE_TILE(0)
  __syncthreads();
#pragma unroll 1
  for (int t = t0; t < t1; ++t) {
    const int cur = (t - t0) & 1;
    {
      const int tn = (t + 1 < t1) ? t + 1 : t;
      ATTN_LOAD_TILE(tn)
    }
    const u16* sK = sbase + cur * STG;
    const u16* sV = sK + 64 * LDK;
    bool relevant = true;
    if (MODE == 0) relevant = (t * 64 <= qw0 + 31 + 128) && (t * 64 + 63 >= qw0 - 128);
    if (MODE == 1) relevant = (t >= rsq) && (t < rsq + 8);
    if (relevant) {
      f32x16 sacc[2];
#pragma unroll
      for (int tt = 0; tt < 2; ++tt) {
#pragma unroll
        for (int r = 0; r < 16; ++r) sacc[tt][r] = -m_run;
        const u16* kp = sK + (tt * 32 + l31) * LDK + hh * 8;
#pragma unroll
        for (int ks = 0; ks < NKS; ++ks) {
          bf16x8 kf = *(const bf16x8*)(kp + ks * 16);
          sacc[tt] = MFMA32(kf, qf[ks], sacc[tt]);
        }
      }
      float mx = -INFINITY;
      const int drow = min(max(t - rq + 7, 0), 14) * 31;
#pragma unroll
      for (int tt = 0; tt < 2; ++tt)
#pragma unroll
        for (int r = 0; r < 16; ++r) {
          float sv = sacc[tt][r];
          const int kl = tt * 32 + crow(r, hh);
          if (MODE == 0) {
            const int kpos = t * 64 + kl;
            int dist = qpos - kpos;
            dist = dist < 0 ? -dist : dist;
            sv = (dist <= 128) ? (sv - slope2 * (float)dist) : -INFINITY;
          } else if (MODE == 1) {
            const bool ok = ((unsigned)(kl - cs) < 16u);
            const int dc = min(max(kl - cq + 15, 0), 30);
            sv = ok ? (sv + sBias[drow + dc]) : -INFINITY;
          }
          sacc[tt][r] = sv;
          mx = fmaxf(mx, sv);
        }
      mx = fmaxf(mx, __shfl_xor(mx, 32));
      if (__builtin_amdgcn_ballot_w64(first || (mx > SM_THR)) != 0ull) {
        float delta = fmaxf(mx, 0.f);
        if (first && MODE != 0) delta = (mx > -INFINITY) ? mx : 0.f;
        m_run += delta;
        const float alpha = __builtin_amdgcn_exp2f(-delta);
        l_run *= alpha;
#pragma unroll
        for (int d = 0; d < 4; ++d)
#pragma unroll
          for (int r = 0; r < 16; ++r) oacc[d][r] *= alpha;
#pragma unroll
        for (int tt = 0; tt < 2; ++tt)
#pragma unroll
          for (int r = 0; r < 16; ++r) sacc[tt][r] -= delta;
        first = false;
      }
      float ps = 0.f;
#pragma unroll
      for (int tt = 0; tt < 2; ++tt) {
#pragma unroll
        for (int r = 0; r < 16; ++r) {
          const float pv = __builtin_amdgcn_exp2f(sacc[tt][r]);
          sacc[tt][r] = pv;
          ps += pv;
        }
#pragma unroll
        for (int s2 = 0; s2 < 2; ++s2) {
          u32x4 w;
          w.x = pack2bf(sacc[tt][8 * s2 + 0], sacc[tt][8 * s2 + 1]);
          w.y = pack2bf(sacc[tt][8 * s2 + 2], sacc[tt][8 * s2 + 3]);
          w.z = pack2bf(sacc[tt][8 * s2 + 4], sacc[tt][8 * s2 + 5]);
          w.w = pack2bf(sacc[tt][8 * s2 + 6], sacc[tt][8 * s2 + 7]);
          const bf16x8 pf = __builtin_bit_cast(bf16x8, w);
#pragma unroll
          for (int dt = 0; dt < 4; ++dt) {
            const u16* vp = sV + (dt * 32 + l31) * 68 + 4 * hh;
            const u32x2 lo = *(const u32x2*)(vp + tt * 32 + s2 * 16);
            const u32x2 hi = *(const u32x2*)(vp + tt * 32 + s2 * 16 + 8);
            u32x4 wv = {lo.x, lo.y, hi.x, hi.y};
            oacc[dt] = MFMA32(__builtin_bit_cast(bf16x8, wv), pf, oacc[dt]);
          }
        }
      }
      l_run += ps;
    }
    ATTN_STORE_TILE(cur ^ 1)
    __syncthreads();
  }
  const float lt = l_run + __shfl_xor(l_run, 32);
  const float inv = 1.f / lt;
  float sq = 0.f;
  u16* orow = Oout + (size_t)(wid * 32 + l31) * 2048;
#pragma unroll
  for (int dt = 0; dt < 4; ++dt)
#pragma unroll
    for (int g4 = 0; g4 < 4; ++g4) {
      const float v0 = oacc[dt][4 * g4 + 0] * inv, v1 = oacc[dt][4 * g4 + 1] * inv;
      const float v2 = oacc[dt][4 * g4 + 2] * inv, v3 = oacc[dt][4 * g4 + 3] * inv;
      sq += v0 * v0 + v1 * v1 + v2 * v2 + v3 * v3;
      u32x2 w = {pack2bf(v0, v1), pack2bf(v2, v3)};
      *(u32x2*)(orow + dt * 32 + 8 * g4 + 4 * hh) = w;
    }
  sq += __shfl_xor(sq, 32);
  if (hh == 0) ssq_out[(size_t)(wid * 32 + l31) * 16] = sq;
}

DI void phase_mix(const Params& p, int L, char* smem) {
  for (int w = obid(); w < 256; w += gridDim.x) {
    const int b = w >> 6, rem = w & 63, rg = rem >> 2, hb = rem & 3;
    const int r0 = rg * 4;
    const int t0 = min(max(r0 - 4, 0), 56), t1 = min(max(r0 - 1, 0), 56) + 8;
    const size_t tok0 = (size_t)b * 4096 + r0 * 64;
    attn_block<128, 1>(smem, p.h() + tok0 * HLD + 1536 + hb * 128, HLD, p.h() + (size_t)b * 4096 * HLD + 2048 + hb * 128, HLD,
                       p.vtB() + (size_t)(b * 4 + hb) * 128 * 4096, t0, t1, r0 * 64, 0.f, 0.f,
                       p.b_rel + (size_t)L * 4 * 465 + hb * 465, p.o() + tok0 * 2048 + 1024 + hb * 128, p.ssqh() + tok0 * 16 + 8 + hb);
  }
  for (int ww = obid(); ww < 512; ww += gridDim.x) {
    const int b = ww >> 7, rem = ww & 127, sb = rem >> 3, hq = rem & 7;
    const int t0 = max(0, 4 * sb - 2), t1 = min(64, 4 * sb + 6);
    const size_t tok0 = (size_t)b * 4096 + sb * 256;
    const float slope2 = exp2f(-(float)(hq + 1)) * LOG2E;
    const float sink2 = p.a_sink[L * 8 + hq] * LOG2E;
    attn_block<128, 0>(smem, p.h() + tok0 * HLD + hq * 128, HLD, p.h() + (size_t)b * 4096 * HLD + 1024 + (hq >> 2) * 128, HLD,
                       p.vtA() + (size_t)(b * 2 + (hq >> 2)) * 128 * 4096, t0, t1, sb * 256, slope2, sink2, nullptr,
                       p.o() + tok0 * 2048 + hq * 128, p.ssqh() + tok0 * 16 + hq);
  }
  for (int w = (obid() + 64) % gridDim.x; w < 192; w += gridDim.x) tile_upq(p, L, w, smem);
  for (int w = obid(); w < 256; w += gridDim.x) tile_upkv(p, L, w, smem);
}

DI void phase_mla(const Params& p, char* smem) {
  const int nbx = gridDim.x >> 3;
  for (int li = obid() >> 3; li < 32; li += nbx) {
    const int pair = (obid() & 7) * 2 + (li >> 4), nq = li & 15;
    const int b = pair >> 2, hc = pair & 3;
    const size_t tok0 = (size_t)b * 4096 + nq * 256;
    attn_block<192, 2>(smem, p.qmla() + ((size_t)(b * 4 + hc) * 4096 + nq * 256) * 192, 192, p.kmla() + (size_t)(b * 4 + hc) * 4096 * 192, 192,
                       p.vtC() + (size_t)(b * 4 + hc) * 128 * 4096, 0, 64, nq * 256, 0.f, 0.f, nullptr,
                       p.o() + tok0 * 2048 + 1536 + hc * 128, p.ssqh() + tok0 * 16 + 12 + hc, p.ropeC());
  }
}

DI void phase_onorm(const Params& p) {
  const int lane = otid() & 63, wid = otid() >> 6;
  for (int row = obid() * NWAVE + wid; row < T; row += gridDim.x * NWAVE) {
    const float4* sp = (const float4*)(p.ssqh() + (size_t)row * 16);
    const float4 a0 = sp[0], a1 = sp[1], b0 = sp[2], c0 = sp[3];
    const float rA = rsqrtf((a0.x + a0.y + a0.z + a0.w + a1.x + a1.y + a1.z + a1.w) * (1.f / 1024.f) + EPS);
    const float rB = rsqrtf((b0.x + b0.y + b0.z + b0.w) * (1.f / 512.f) + EPS);
    const float rC = rsqrtf((c0.x + c0.y + c0.z + c0.w) * (1.f / 512.f) + EPS);
#pragma unroll
    for (int j = 0; j < 4; ++j) {
      const float sc = (j < 2) ? rA : (j == 2 ? rB : rC);
      const size_t off = (size_t)row * 2048 + j * 512 + lane * 8;
      u32x4 w = *(const u32x4*)(p.o() + off);
      w.x = pack2bf(bf_lo(w.x) * sc, bf_hi(w.x) * sc);
      w.y = pack2bf(bf_lo(w.y) * sc, bf_hi(w.y) * sc);
      w.z = pack2bf(bf_lo(w.z) * sc, bf_hi(w.z) * sc);
      w.w = pack2bf(bf_lo(w.w) * sc, bf_hi(w.w) * sc);
      *(u32x4*)(p.on() + off) = w;
    }
  }
}

DI u32 ordkey(float s) {
  const u32 u = __float_as_uint(s);
  return u ^ ((u >> 31) ? 0xFFFFFFFFu : 0x80000000u);
}
DI float unord(u32 k) {
  const u32 u = (k & 0x80000000u) ? (k ^ 0x80000000u) : ~k;
  return __uint_as_float(u);
}
DI void insert16(u32 (&Ls)[16], u32 key) {
#pragma unroll
  for (int q = 0; q < 16; ++q) {
    const u32 hi = max(Ls[q], key);
    key = min(Ls[q], key);
    Ls[q] = hi;
  }
}

DI void phase_select(const Params& p, int L, char* smem) {
  float* sS = (float*)smem;
  u32* sTop = (u32*)(smem + 256 * 132 * 4);
  const int tid = otid(), lane = tid & 63, wid = tid >> 6, hh = lane >> 5, l31 = lane & 31;
  const int rt = wid >> 1, c = wid & 1;
  const u16* kb = p.keys_b() + (size_t)L * 256 * 128;
  for (int it = obid(); it < 1024; it += gridDim.x) {
    f32x16 sc[4];
    {
      const u16* qrow = p.pq() + ((size_t)it * 128 + rt * 32 + l31) * 128 + c * 64 + hh * 8;
      bf16x8 qa[4];
#pragma unroll
      for (int ks = 0; ks < 4; ++ks) qa[ks] = *(const bf16x8*)(qrow + ks * 16);
#pragma unroll
      for (int ct = 0; ct < 4; ++ct) {
#pragma unroll
        for (int r = 0; r < 16; ++r) sc[ct][r] = 0.f;
        const u16* krow = kb + (size_t)(c * 128 + ct * 32 + l31) * 128 + c * 64 + hh * 8;
#pragma unroll
        for (int ks = 0; ks < 4; ++ks) {
          const bf16x8 kf = *(const bf16x8*)(krow + ks * 16);
          sc[ct] = MFMA32(qa[ks], kf, sc[ct]);
        }
      }
    }
    __syncthreads();
#pragma unroll
    for (int ct = 0; ct < 4; ++ct)
#pragma unroll
      for (int r = 0; r < 16; ++r) sS[((rt * 32 + crow(r, hh)) * 2 + c) * 132 + ct * 32 + l31] = sc[ct][r];
    __syncthreads();
    {
      const int combo = tid >> 1, half = tid & 1;
      u32 Ls[16];
#pragma unroll
      for (int q = 0; q < 16; ++q) Ls[q] = 0u;
      const float* sp = sS + combo * 132 + half * 64;
      for (int n4 = 0; n4 < 16; ++n4) {
        const int n4r = (n4 + half * 8) & 15;
        const float4 v = *(const float4*)(sp + n4r * 4);
        const int nb = half * 64 + n4r * 4;
        insert16(Ls, (ordkey(v.x) & ~0x7Fu) | (u32)(127 - (nb + 0)));
        insert16(Ls, (ordkey(v.y) & ~0x7Fu) | (u32)(127 - (nb + 1)));
        insert16(Ls, (ordkey(v.z) & ~0x7Fu) | (u32)(127 - (nb + 2)));
        insert16(Ls, (ordkey(v.w) & ~0x7Fu) | (u32)(127 - (nb + 3)));
      }
      u32 Ms[16];
#pragma unroll
      for (int q = 0; q < 16; ++q) {
        const u32 other = (u32)__shfl_xor((int)Ls[15 - q], 1);
        Ms[q] = max(Ls[q], other);
      }
#pragma unroll
      for (int span = 8; span >= 1; span >>= 1)
#pragma unroll
        for (int q = 0; q < 16; ++q)
          if ((q & span) == 0) {
            const u32 hi = max(Ms[q], Ms[q + span]), lo = min(Ms[q], Ms[q + span]);
            Ms[q] = hi;
            Ms[q + span] = lo;
          }
      if (half == 0) {
#pragma unroll
        for (int q = 0; q < 16; ++q) sTop[combo * 16 + q] = Ms[q];
      }
    }
    __syncthreads();
    if (tid < 128) {
      const u32* t0 = sTop + (tid * 2) * 16;
      const u32* t1 = sTop + (tid * 2 + 1) * 16;
      float s0[16], s1[16];
#pragma unroll
      for (int q = 0; q < 16; ++q) {
        s0[q] = unord(t0[q] & ~0x7Fu);
        s1[q] = unord(t1[q] & ~0x7Fu);
      }
      u32 M[16];
#pragma unroll
      for (int q = 0; q < 16; ++q) M[q] = 0u;
#pragma unroll
      for (int i = 0; i < 16; ++i)
#pragma unroll
        for (int j = 0; j < 16; ++j)
          if ((i + 1) * (j + 1) <= 16) {
            const float sm = s0[i] + s1[j];
            insert16(M, (ordkey(sm) & ~0xFFu) | (u32)(255 - (i * 16 + j)));
          }
      const float mxv = unord(M[0] & ~0xFFu);
      float e[16], sum = 0.f;
#pragma unroll
      for (int q = 0; q < 16; ++q) {
        e[q] = __expf(unord(M[q] & ~0xFFu) - mxv);
        sum += e[q];
      }
      const float inv = 1.f / sum;
      const size_t row = (size_t)it * 128 + tid;
#pragma unroll
      for (int q = 0; q < 16; ++q) {
        const int ij = 255 - (int)(M[q] & 0xFFu);
        const int n0 = 127 - (int)(t0[ij >> 4] & 0x7Fu);
        const int n1 = 127 - (int)(t1[ij & 15] & 0x7Fu);
        p.idx()[row * 16 + q] = n0 * 128 + n1;
        p.g()[row * 16 + q] = e[q] * inv;
      }
    }
  }
}

DI float dot32(u32x4 w, const float2_t* xn2) {
  float2_t s = {0.f, 0.f};
#pragma unroll
  for (int c = 0; c < 4; ++c) {
    s = __builtin_elementwise_fma(__builtin_amdgcn_cvt_scalef32_pk_f32_fp4(w[c], 1.0f, 0), xn2[4 * c + 0], s);
    s = __builtin_elementwise_fma(__builtin_amdgcn_cvt_scalef32_pk_f32_fp4(w[c], 1.0f, 1), xn2[4 * c + 1], s);
    s = __builtin_elementwise_fma(__builtin_amdgcn_cvt_scalef32_pk_f32_fp4(w[c], 1.0f, 2), xn2[4 * c + 2], s);
    s = __builtin_elementwise_fma(__builtin_amdgcn_cvt_scalef32_pk_f32_fp4(w[c], 1.0f, 3), xn2[4 * c + 3], s);
  }
  return s.x + s.y;
}
DI void axpy32(u32x4 w, float a, float2_t* y2) {
  const float2_t a2 = {a, a};
#pragma unroll
  for (int c = 0; c < 4; ++c) {
    y2[4 * c + 0] = __builtin_elementwise_fma(__builtin_amdgcn_cvt_scalef32_pk_f32_fp4(w[c], 1.0f, 0), a2, y2[4 * c + 0]);
    y2[4 * c + 1] = __builtin_elementwise_fma(__builtin_amdgcn_cvt_scalef32_pk_f32_fp4(w[c], 1.0f, 1), a2, y2[4 * c + 1]);
    y2[4 * c + 2] = __builtin_elementwise_fma(__builtin_amdgcn_cvt_scalef32_pk_f32_fp4(w[c], 1.0f, 2), a2, y2[4 * c + 2]);
    y2[4 * c + 3] = __builtin_elementwise_fma(__builtin_amdgcn_cvt_scalef32_pk_f32_fp4(w[c], 1.0f, 3), a2, y2[4 * c + 3]);
  }
}
DI float gelu_tanh(float a) {
  const float u = 0.7978845608028654f * (a + 0.044715f * a * a * a);
  return 0.5f * a * (1.f + tanhf(u));
}

DI void phase_gather(const Params& p, int L, bool last) {
  const int wid = otid() >> 6;
  const unsigned char* U = p.ub() + (size_t)L * NEXP * 1024;
  const unsigned char* V = p.vb() + (size_t)L * NEXP * 1024;
  const float* ln2 = p.ln2 + L * 2048;
  int ni0 = 0, ni1 = 0;
  float ng0 = 0.f, ng1 = 0.f;
  {
    const int t0 = obid() * NWAVE + wid, l0 = otid() & 63;
    if (t0 < T) {
      ni0 = p.idx()[(size_t)t0 * 128 + l0]; ni1 = p.idx()[(size_t)t0 * 128 + 64 + l0];
      ng0 = p.g()[(size_t)t0 * 128 + l0];   ng1 = p.g()[(size_t)t0 * 128 + 64 + l0];
    }
  }
  for (int t = obid() * NWAVE + wid; t < T; t += gridDim.x * NWAVE) {
    const int lane = otid() & 63;
    const u16* xr = p.xb() + (size_t)t * 2048;
    float2_t xn2[16];
    float ss = 0.f;
    u32x4 xkeep[4];
#pragma unroll
    for (int c8 = 0; c8 < 4; ++c8) {
      const u32x4 a = *(const u32x4*)(xr + lane * 32 + c8 * 8);
      xkeep[c8] = a;
      xn2[c8 * 4 + 0] = float2_t{bf_lo(a.x), bf_hi(a.x)};
      xn2[c8 * 4 + 1] = float2_t{bf_lo(a.y), bf_hi(a.y)};
      xn2[c8 * 4 + 2] = float2_t{bf_lo(a.z), bf_hi(a.z)};
      xn2[c8 * 4 + 3] = float2_t{bf_lo(a.w), bf_hi(a.w)};
    }
#pragma unroll
    for (int e = 0; e < 16; ++e) ss += xn2[e].x * xn2[e].x + xn2[e].y * xn2[e].y;
    ss = wave_sum(ss);
    const float rstd = rsqrtf(ss * (1.f / 2048.f) + EPS) * (1.f / U_SCALE);
#pragma unroll
    for (int c4 = 0; c4 < 8; ++c4) {
      const float4 a = *(const float4*)(ln2 + lane * 32 + c4 * 4);
      xn2[c4 * 2 + 0] *= float2_t{rstd * a.x, rstd * a.y};
      xn2[c4 * 2 + 1] *= float2_t{rstd * a.z, rstd * a.w};
    }
    const int i0 = ni0, i1 = ni1;
    const float g0 = ng0, g1 = ng1;
    float a0 = 0.f, a1 = 0.f;
#pragma unroll
    for (int half = 0; half < 2; ++half) {
      const int iv = half ? i1 : i0;
      float av = 0.f;
#pragma unroll 1
      for (int k0 = 0; k0 < 64; k0 += 16) {
        u32x4 w[16];
#pragma unroll
        for (int q = 0; q < 16; ++q) {
          const int row = __builtin_amdgcn_readlane(iv, k0 + q);
          w[q] = *(const u32x4*)(U + (size_t)row * 1024 + lane * 16);
        }
        float d[16];
#pragma unroll
        for (int q = 0; q < 16; ++q) {
          __builtin_amdgcn_sched_barrier(0);
          if (q > 0) asm volatile("" : "+v"(w[q]), "+v"(d[q - 1]));
          d[q] = dot32(w[q], xn2);
        }
        __builtin_amdgcn_sched_barrier(0);
        {
          const bool b5 = (lane & 32) != 0, b4 = (lane & 16) != 0, b3 = (lane & 8) != 0, b2 = (lane & 4) != 0;
          float e8[8], e4[4], e2[2], e1;
#pragma unroll
          for (int j = 0; j < 8; ++j) {
            const float snd = b5 ? d[j] : d[j + 8];
            const float kep = b5 ? d[j + 8] : d[j];
            e8[j] = kep + __shfl_xor(snd, 32);
          }
#pragma unroll
          for (int j = 0; j < 4; ++j) {
            const float snd = b4 ? e8[j] : e8[j + 4];
            const float kep = b4 ? e8[j + 4] : e8[j];
            e4[j] = kep + __shfl_xor(snd, 16);
          }
#pragma unroll
          for (int j = 0; j < 2; ++j) {
            const float snd = b3 ? e4[j] : e4[j + 2];
            const float kep = b3 ? e4[j + 2] : e4[j];
            e2[j] = kep + __shfl_xor(snd, 8);
          }
          {
            const float snd = b2 ? e2[0] : e2[1];
            const float kep = b2 ? e2[1] : e2[0];
            e1 = kep + __shfl_xor(snd, 4);
          }
          e1 += __shfl_xor(e1, 2);
          e1 += __shfl_xor(e1, 1);
          const float got = __shfl(e1, ((lane - k0) & 15) * 4);
          if (lane >= k0 && lane < k0 + 16) av = got;
        }
      }
      if (half) a1 = av; else a0 = av;
    }
    const float hs0 = gelu_tanh(a0) * g0 * (1.f / V_SCALE), hs1 = gelu_tanh(a1) * g1 * (1.f / V_SCALE);
    {
      const int tn = t + gridDim.x * NWAVE;
      if (tn < T) {
        ni0 = p.idx()[(size_t)tn * 128 + lane]; ni1 = p.idx()[(size_t)tn * 128 + 64 + lane];
        ng0 = p.g()[(size_t)tn * 128 + lane];   ng1 = p.g()[(size_t)tn * 128 + 64 + lane];
      }
    }
    float2_t y2[16];
#pragma unroll
    for (int e = 0; e < 16; ++e) y2[e] = float2_t{0.f, 0.f};
#pragma unroll
    for (int half = 0; half < 2; ++half) {
      const int iv = half ? i1 : i0;
      const int hv = __float_as_int(half ? hs1 : hs0);
#pragma unroll 1
      for (int k0 = 0; k0 < 64; k0 += 8) {
        u32x4 w[8];
        float wq[8];
#pragma unroll
        for (int q = 0; q < 8; ++q) {
          const int row = __builtin_amdgcn_readlane(iv, k0 + q);
          wq[q] = __int_as_float(__builtin_amdgcn_readlane(hv, k0 + q));
          w[q] = *(const u32x4*)(V + (size_t)row * 1024 + lane * 16);
        }
#pragma unroll
        for (int q = 0; q < 8; ++q) {
          __builtin_amdgcn_sched_barrier(0);
          asm volatile("" : "+v"(w[q]), "+v"(y2[0]), "+v"(y2[8]));
          axpy32(w[q], wq[q], y2);
        }
        __builtin_amdgcn_sched_barrier(0);
      }
    }
    int t2 = t;
    asm volatile("" : "+v"(t2));
    const int lane2 = otid() & 63;
#pragma unroll
    for (int c8 = 0; c8 < 4; ++c8) {
      const u32x4 a = xkeep[c8];
      y2[c8 * 4 + 0] += float2_t{bf_lo(a.x), bf_hi(a.x)};
      y2[c8 * 4 + 1] += float2_t{bf_lo(a.y), bf_hi(a.y)};
      y2[c8 * 4 + 2] += float2_t{bf_lo(a.z), bf_hi(a.z)};
      y2[c8 * 4 + 3] += float2_t{bf_lo(a.w), bf_hi(a.w)};
    }
    if (!last) {
#pragma unroll
      for (int c8 = 0; c8 < 4; ++c8) {
        const float2_t* yy = y2 + c8 * 4;
        u32x4 w = {pack2bf(yy[0].x, yy[0].y), pack2bf(yy[1].x, yy[1].y), pack2bf(yy[2].x, yy[2].y), pack2bf(yy[3].x, yy[3].y)};
        *(u32x4*)(p.xb() + (size_t)t2 * 2048 + lane2 * 32 + c8 * 8) = w;
      }
    } else {
      float ss2 = 0.f;
#pragma unroll
      for (int e = 0; e < 16; ++e) ss2 += y2[e].x * y2[e].x + y2[e].y * y2[e].y;
      ss2 = wave_sum(ss2);
      const float r2 = rsqrtf(ss2 * (1.f / 2048.f) + EPS);
      float* orow = p.out + (size_t)t2 * 2048;
#pragma unroll
      for (int c4 = 0; c4 < 8; ++c4) {
        const float4 a = *(const float4*)(p.fnorm + lane2 * 32 + c4 * 4);
        *(float4*)(orow + lane2 * 32 + c4 * 4) =
            float4{y2[c4 * 2].x * r2 * a.x, y2[c4 * 2].y * r2 * a.y, y2[c4 * 2 + 1].x * r2 * a.z, y2[c4 * 2 + 1].y * r2 * a.w};
      }
    }
  }
}


#define XB_TMO      128
#define XB_XCNT(j)  (256  + 64 * (j))
#define XB_XSUB(j)  (1280 + 64 * (j))
#define XB_XGEN(j)  (2304 + 64 * (j))
#define XB_TOP      3328
#define XB_TOPGEN   3392
#define XCD_BAR_WORDS 3456
#define XB_SPIN_CAP (1u << 18)
#define LAS __attribute__((address_space(3)))
DI unsigned xb_ld(unsigned* p) { return __hip_atomic_load(p, __ATOMIC_RELAXED, __HIP_MEMORY_SCOPE_AGENT); }
DI unsigned xb_add(unsigned* p, unsigned v) { return __hip_atomic_fetch_add(p, v, __ATOMIC_RELAXED, __HIP_MEMORY_SCOPE_AGENT); }
DI unsigned xb_xcc_id() { return (unsigned)__builtin_amdgcn_s_getreg((3 << 11) | 20) & 0xFu; }
#define XB_SPIN(cond, bar) do { unsigned _sp = 0; while (cond) { __builtin_amdgcn_s_sleep(1); \
    if ((++_sp & 255u) == 0u) { if (xb_ld(&(bar)[XB_TMO])) break; if (_sp > XB_SPIN_CAP) { atomicAdd(&(bar)[XB_TMO], 1u); break; } } } } while (0)
struct XcdBarrier { unsigned* bar; unsigned x; volatile LAS unsigned* st; };
DI XcdBarrier xcd_barrier_post(unsigned* bar, volatile LAS unsigned* st) {
  XcdBarrier b; b.bar = bar; b.x = xb_xcc_id(); b.st = st;
  if (threadIdx.x == 0) (void)xb_add(&bar[XB_XCNT(b.x)], 1u);
  return b;
}
DI void xcd_barrier_complete(unsigned* bar, unsigned x, unsigned& nloc, unsigned& nx) {
  const unsigned G = gridDim.x * gridDim.y * gridDim.z;
  unsigned sum, cnt, mine, sp = 0u;
  for (;;) {
    sum = 0u; cnt = 0u; mine = 0u;
#pragma unroll
    for (unsigned j = 0; j < 16; ++j) { const unsigned c = xb_ld(&bar[XB_XCNT(j)]); sum += c; cnt += (c > 0u) ? 1u : 0u; mine = (j == x) ? c : mine; }
    if (sum == G) break;
    __builtin_amdgcn_s_sleep(1);
    if ((++sp & 255u) == 0u) { if (xb_ld(&bar[XB_TMO])) break; if (sp > XB_SPIN_CAP) { atomicAdd(&bar[XB_TMO], 1u); break; } }
  }
  nloc = mine > 0u ? mine : 1u; nx = cnt > 0u ? cnt : 1u;
}
DI void xcd_barrier(const XcdBarrier& b) {
  asm volatile("s_waitcnt vmcnt(0)" ::: "memory");
  __syncthreads();
  if (threadIdx.x == 0) {
    unsigned* bar = b.bar;
    __builtin_amdgcn_s_waitcnt(0);
    unsigned nloc = b.st[0], nx = b.st[1];
    if (nloc == 0u) { xcd_barrier_complete(bar, b.x, nloc, nx); b.st[0] = nloc; b.st[1] = nx; }
    const unsigned old = xb_add(&bar[XB_XSUB(b.x)], 1u);
    const unsigned gen = old / nloc;
    if (old + 1u == (gen + 1u) * nloc) {
      __builtin_amdgcn_fence(__ATOMIC_RELEASE, "agent");
      asm volatile("s_waitcnt vmcnt(0)" ::: "memory");
      const unsigned og = xb_add(&bar[XB_TOP], 1u);
      const unsigned tg = og / nx;
      if (og + 1u == (tg + 1u) * nx) xb_add(&bar[XB_TOPGEN], 1u);
      else XB_SPIN(xb_ld(&bar[XB_TOPGEN]) == tg, bar);
      __builtin_amdgcn_fence(__ATOMIC_ACQUIRE, "agent");
      xb_add(&bar[XB_XGEN(b.x)], 1u);
      asm volatile("s_waitcnt vmcnt(0)" ::: "memory");
    } else {
      XB_SPIN(xb_ld(&bar[XB_XGEN(b.x)]) == gen, bar);
      __builtin_amdgcn_fence(__ATOMIC_ACQUIRE, "agent");
      asm volatile("s_waitcnt vmcnt(0)" ::: "memory");
    }
  }
  __syncthreads();
}

#define KDEF(name, body)                                                       \
  __global__ void __launch_bounds__(512) name(Params p, int L) {            \
    __shared__ __attribute__((aligned(16))) char smem[SMEM_BYTES];             \
    body;                                                                      \
  }
#if !MEGA
KDEF(k_prologue, phase_prologue(p, smem))
KDEF(k_gemm1, phase_gemm1(p, L, smem))
KDEF(k_mix, phase_mix(p, L, smem))
KDEF(k_mla, phase_mla(p, smem))
KDEF(k_onorm, phase_onorm(p))
KDEF(k_gemm_o, phase_gemm_o(p, L, smem))
KDEF(k_gemm_pq, phase_gemm_pq(p, L, smem))
KDEF(k_scores, phase_gemm_scores(p, L, smem))
KDEF(k_select, phase_select(p, L, smem))
KDEF(k_gather, phase_gather(p, L, L == 1))
#else
#ifndef PROBE_MASK
#define PROBE_MASK 0
#endif
#define RUN(bit, call)                         \
  call;                                        \
  if (PROBE_MASK & (bit)) {                    \
    grid.sync();                               \
    call;                                      \
  }
__global__ void __launch_bounds__(512) mega_coop(Params p) {
  __shared__ __attribute__((aligned(16))) char smem[SMEM_BYTES];
  __shared__ uint4 xb_words;
  cg::grid_group grid = cg::this_grid();
  if (threadIdx.x == 0) xb_words = make_uint4(0u, 0u, 0u, 0u);
  __syncthreads();
  const XcdBarrier xb = xcd_barrier_post((unsigned*)(p.ws + WS_NEED), (volatile LAS unsigned*)&xb_words);
#define GSYNC xcd_barrier(xb)
  RUN(256, phase_prologue(p, smem))
  if (p.ws == nullptr) grid.sync();
  GSYNC;
#pragma unroll 1
  for (int L = 0; L < 2; ++L) {
    phase_gemm1(p, L, smem);
    GSYNC;
    phase_mix(p, L, smem);
    GSYNC;
    phase_mla(p, smem);
    GSYNC;
    phase_gemm_o(p, L, smem);
    GSYNC;
    phase_gemm_pq(p, L, smem);
    GSYNC;
    phase_select(p, L, smem);
    GSYNC;
    phase_gather(p, L, L == 1);
    if (L == 0) GSYNC;
  }
}
#endif

extern "C" void kernel_launch(void* const* d_in, const int* in_sizes, int n_in, void* d_out, int out_size, void* d_ws,
                              size_t ws_size, hipStream_t stream) {
  Params p{};
  p.x = (const float*)d_in[0]; p.ln1 = (const float*)d_in[1]; p.w_in = (const float*)d_in[2]; p.a_sink = (const float*)d_in[3];
  p.b_rel = (const float*)d_in[4]; p.cqn = (const float*)d_in[5]; p.ckvn = (const float*)d_in[6]; p.wuq = (const float*)d_in[7];
  p.wukv = (const float*)d_in[8]; p.onorm = (const float*)d_in[9]; p.wo = (const float*)d_in[10]; p.ln2 = (const float*)d_in[11];
  p.pwq = (const float*)d_in[12]; p.pkeys = (const float*)d_in[13]; p.pu = (const float*)d_in[14]; p.pv = (const float*)d_in[15];
  p.fnorm = (const float*)d_in[16];
  p.out = (float*)d_out;
  p.ws = (char*)d_ws;
  if (WS_NEED + XCD_BAR_WORDS * sizeof(unsigned) > ws_size) { fprintf(stderr, "kernel_launch: workspace too small (%zu > %zu)\n", (size_t)WS_NEED, ws_size); return; }

#if MEGA
  static int grid_blocks = 0;
  if (!grid_blocks) {
    int dev = 0, cus = 0, per_cu = 0;
    hipGetDevice(&dev);
    hipDeviceGetAttribute(&cus, hipDeviceAttributeMultiprocessorCount, dev);
    hipOccupancyMaxActiveBlocksPerMultiprocessor(&per_cu, mega_coop, NTHR, 0);
    if (per_cu > 1) per_cu = 1;
    if (per_cu < 1) per_cu = 1;
    grid_blocks = (cus * per_cu) & ~7;
  }
  (void)hipMemsetAsync(p.ws + WS_NEED, 0, XCD_BAR_WORDS * sizeof(unsigned), stream);
  void* args[] = {&p};
  hipError_t e = hipLaunchCooperativeKernel((void*)mega_coop, dim3(grid_blocks), dim3(NTHR), args, 0, stream);
  if (e != hipSuccess) fprintf(stderr, "cooperative launch failed: %s (grid %d)\n", hipGetErrorString(e), grid_blocks);
#else
  const dim3 g(256), b(NTHR);
  k_prologue<<<g, b, 0, stream>>>(p, 0);
  for (int L = 0; L < 2; ++L) {
    k_gemm1<<<g, b, 0, stream>>>(p, L);
    k_mix<<<g, b, 0, stream>>>(p, L);
    k_mla<<<g, b, 0, stream>>>(p, L);
    k_gemm_o<<<g, b, 0, stream>>>(p, L);
    k_gemm_pq<<<g, b, 0, stream>>>(p, L);
    k_select<<<g, b, 0, stream>>>(p, L);
    k_gather<<<g, b, 0, stream>>>(p, L);
  }
#endif
}
```

```cpp
#include <hip/hip_runtime.h>
#include <hip/hip_cooperative_groups.h>
#include <cstdio>
namespace cg = cooperative_groups;

#ifndef MEGA
#define MEGA 1
#endif

#define DI __device__ __forceinline__
typedef unsigned short u16;
typedef unsigned int u32;
using bf16x8 = __attribute__((ext_vector_type(8))) short;
using f32x16 = __attribute__((ext_vector_type(16))) float;
typedef __bf16 bf16x2_t __attribute__((ext_vector_type(2)));
typedef float float2_t __attribute__((ext_vector_type(2)));
typedef unsigned int u32x4 __attribute__((ext_vector_type(4)));
typedef unsigned int u32x2 __attribute__((ext_vector_type(2)));

constexpr int T = 16384, SEQ = 4096, DM = 2048, HLD = 4096;
constexpr int NTHR = 512, NWAVE = 8;
constexpr int NEXP = 16384;
constexpr float EPS = 1e-6f;
constexpr float LOG2E = 1.4426950408889634f;
constexpr float QSCALE_AB = 0.08838834764831845f * LOG2E;
constexpr float QSCALE_C = 0.07216878364870323f * LOG2E;
constexpr float U_SCALE = 90.5f, V_SCALE = 8.f;
constexpr int LDT = 72;
constexpr int GEMM_STAGE = 512 * LDT;
constexpr int GEMM_SROW_OFF = 2 * GEMM_STAGE * 2;
constexpr int SMEM_BYTES = 256 * 132 * 4 + 256 * 16 * 4;

#define MFMA32(a, b, c) __builtin_amdgcn_mfma_f32_32x32x16_bf16((a), (b), (c), 0, 0, 0)

constexpr size_t al256(size_t x) { return (x + 255) & ~(size_t)255; }
constexpr size_t OFF_wt_in = 0;
constexpr size_t OFF_wt_o = OFF_wt_in + al256((size_t)2 * HLD * 2048 * 2);
constexpr size_t OFF_wt_pq = OFF_wt_o + al256((size_t)2 * 2048 * 2048 * 2);
constexpr size_t OFF_wt_uq = OFF_wt_pq + al256((size_t)2 * 1024 * 2048 * 2);
constexpr size_t OFF_wt_ukv = OFF_wt_uq + al256((size_t)2 * 768 * 512 * 2);
constexpr size_t OFF_keys_b = OFF_wt_ukv + al256((size_t)2 * 1024 * 256 * 2);
constexpr size_t OFF_ub = OFF_keys_b + al256((size_t)2 * 256 * 128 * 2);
constexpr size_t OFF_vb = OFF_ub + al256((size_t)2 * NEXP * 1024);
constexpr size_t OFF_ropeC = OFF_vb + al256((size_t)2 * NEXP * 1024);
constexpr size_t OFF_ropeS = OFF_ropeC + al256((size_t)SEQ * 32 * 4);
constexpr size_t OFF_xres = OFF_ropeS + al256((size_t)SEQ * 32 * 4);
constexpr size_t OFF_xb = OFF_xres + al256((size_t)T * 2048 * 4);
constexpr size_t OFF_h = OFF_xb + al256((size_t)T * 2048 * 2);
constexpr size_t OFF_vtA = OFF_h + al256((size_t)T * HLD * 2);
constexpr size_t OFF_vtB = OFF_vtA + al256((size_t)T * 256 * 2);
constexpr size_t OFF_kmla = OFF_vtB + al256((size_t)T * 512 * 2);
constexpr size_t OFF_vtC = OFF_kmla + al256((size_t)T * 4 * 192 * 2);
constexpr size_t OFF_qmla = OFF_vtC + al256((size_t)T * 512 * 2);
constexpr size_t OFF_o = OFF_qmla + al256((size_t)T * 4 * 192 * 2);
constexpr size_t OFF_on = OFF_o + al256((size_t)T * 2048 * 2);
constexpr size_t OFF_ssqh = OFF_on + al256((size_t)T * 2048 * 2);
constexpr size_t OFF_END1 = OFF_ssqh + al256((size_t)T * 16 * 4);
constexpr size_t OFF_pq = OFF_h;
constexpr size_t OFF_scores = OFF_pq + al256((size_t)T * 1024 * 2);
constexpr size_t OFF_idx = OFF_scores + al256((size_t)T * 8 * 256 * 4);
constexpr size_t OFF_g = OFF_idx + al256((size_t)T * 128 * 4);
constexpr size_t OFF_END2 = OFF_g + al256((size_t)T * 128 * 4);
constexpr size_t WS_NEED = OFF_END1 > OFF_END2 ? OFF_END1 : OFF_END2;

struct Params {
  const float *x, *ln1, *w_in, *a_sink, *b_rel, *cqn, *ckvn, *wuq, *wukv, *onorm, *wo, *ln2, *pwq, *pkeys, *pu, *pv, *fnorm;
  float* out;
  char* ws;
  DI u16* wt_in() const { return (u16*)(ws + OFF_wt_in); }
  DI u16* wt_o() const { return (u16*)(ws + OFF_wt_o); }
  DI u16* wt_pq() const { return (u16*)(ws + OFF_wt_pq); }
  DI u16* wt_uq() const { return (u16*)(ws + OFF_wt_uq); }
  DI u16* wt_ukv() const { return (u16*)(ws + OFF_wt_ukv); }
  DI u16* keys_b() const { return (u16*)(ws + OFF_keys_b); }
  DI unsigned char* ub() const { return (unsigned char*)(ws + OFF_ub); }
  DI unsigned char* vb() const { return (unsigned char*)(ws + OFF_vb); }
  DI float* ropeC() const { return (float*)(ws + OFF_ropeC); }
  DI float* ropeS() const { return (float*)(ws + OFF_ropeS); }
  DI float* xres() const { return (float*)(ws + OFF_xres); }
  DI u16* xb() const { return (u16*)(ws + OFF_xb); }
  DI u16* h() const { return (u16*)(ws + OFF_h); }
  DI u16* vtA() const { return (u16*)(ws + OFF_vtA); }
  DI u16* vtB() const { return (u16*)(ws + OFF_vtB); }
  DI u16* kmla() const { return (u16*)(ws + OFF_kmla); }
  DI u16* vtC() const { return (u16*)(ws + OFF_vtC); }
  DI u16* qmla() const { return (u16*)(ws + OFF_qmla); }
  DI u16* o() const { return (u16*)(ws + OFF_o); }
  DI u16* on() const { return (u16*)(ws + OFF_on); }
  DI float* ssqh() const { return (float*)(ws + OFF_ssqh); }
  DI u16* pq() const { return (u16*)(ws + OFF_pq); }
  DI float* scores() const { return (float*)(ws + OFF_scores); }
  DI int* idx() const { return (int*)(ws + OFF_idx); }
  DI float* g() const { return (float*)(ws + OFF_g); }
};

DI int otid() { int t = threadIdx.x; asm volatile("" : "+v"(t)); return t; }
DI int obid() { int b = blockIdx.x; asm volatile("" : "+s"(b)); return b; }
DI u16 f2bf(float x) {
  u32 u = __float_as_uint(x);
  u += 0x7fffu + ((u >> 16) & 1u);
  return (u16)(u >> 16);
}
DI u32 pack2bf(float a, float b) {
  float2_t f = {a, b};
  bf16x2_t r = __builtin_convertvector(f, bf16x2_t);
  return __builtin_bit_cast(u32, r);
}
DI float bf_lo(u32 w) { return __uint_as_float(w << 16); }
DI float bf_hi(u32 w) { return __uint_as_float(w & 0xffff0000u); }
DI int crow(int r, int h) { return (r & 3) + 8 * (r >> 2) + 4 * h; }
DI float wave_sum(float v) {
#pragma unroll
  for (int o = 32; o >= 1; o >>= 1) v += __shfl_xor(v, o);
  return v;
}
DI float ssq8(u32x4 w) {
  float s = 0.f, a;
  a = bf_lo(w.x); s += a * a; a = bf_hi(w.x); s += a * a;
  a = bf_lo(w.y); s += a * a; a = bf_hi(w.y); s += a * a;
  a = bf_lo(w.z); s += a * a; a = bf_hi(w.z); s += a * a;
  a = bf_lo(w.w); s += a * a; a = bf_hi(w.w); s += a * a;
  return s;
}
DI bool gemm_tile_map(int it, int MT, int NT, int& mt, int& nt) {
  const int b = obid(), x = b & 7, nb = gridDim.x >> 3;
  const int li = it * nb + (b >> 3);
  const int nrn = (NT + 7) >> 3, nrect = (MT >> 3) * nrn;
  const int q = x + 8 * (li >> 6);
  if (q >= nrect) { mt = -1; nt = 0; return false; }
  const int in = li & 63;
  mt = (q / nrn) * 8 + (in >> 3);
  nt = (q % nrn) * 8 + (in & 7);
  return nt < NT;
}

constexpr int GM = 256, GN = 256;
DI u32x4 scale8(u32x4 w, float sc) {
  w.x = pack2bf(bf_lo(w.x) * sc, bf_hi(w.x) * sc);
  w.y = pack2bf(bf_lo(w.y) * sc, bf_hi(w.y) * sc);
  w.z = pack2bf(bf_lo(w.z) * sc, bf_hi(w.z) * sc);
  w.w = pack2bf(bf_lo(w.w) * sc, bf_hi(w.w) * sc);
  return w;
}
template <bool ROWNORM, bool CONV = false, bool ASCALE = false>
DI void gemm_mainloop(const u16* __restrict__ Ag, int lda, const u16* __restrict__ Bg, int ldb, int K, char* smem,
                      f32x16 (&acc)[4][2], const float4* __restrict__ csrc = nullptr, u16* __restrict__ cdst = nullptr,
                      float cscale = 1.f) {
  u16* sbase = (u16*)smem;
  float* sRow = (float*)(smem + GEMM_SROW_OFF);
  const int tid = otid(), lane = tid & 63, wid = tid >> 6;
  const int wm = wid >> 2, wn = wid & 3, hh = lane >> 5, l31 = lane & 31;
  const int lr = tid >> 3, lc = (tid & 7) * 8;
#pragma unroll
  for (int i = 0; i < 4; ++i)
#pragma unroll
    for (int j = 0; j < 2; ++j)
#pragma unroll
      for (int r = 0; r < 16; ++r) acc[i][j][r] = 0.f;
  u32x4 ra[4], rb[4];
  float ssq[4] = {0.f, 0.f, 0.f, 0.f};
  const u16* ap = Ag + (size_t)lr * lda + lc;
  const u16* bp = Bg + (size_t)lr * ldb + lc;
#pragma unroll
  for (int i = 0; i < 4; ++i) {
    ra[i] = *(const u32x4*)(ap + (size_t)(64 * i) * lda);
    rb[i] = *(const u32x4*)(bp + (size_t)(64 * i) * ldb);
  }
  __syncthreads();
#pragma unroll
  for (int i = 0; i < 4; ++i) {
    if (ASCALE) ra[i] = scale8(ra[i], sRow[(lr + 64 * i) * 4 + 0]);
    *(u32x4*)(sbase + (lr + 64 * i) * LDT + lc) = ra[i];
    *(u32x4*)(sbase + (256 + lr + 64 * i) * LDT + lc) = rb[i];
    if (ROWNORM) ssq[i] += ssq8(ra[i]);
  }
  __syncthreads();
  const int nk = K >> 6;
  float4 cv = float4{0.f, 0.f, 0.f, 0.f};
  if (CONV) cv = csrc[tid];
#pragma unroll 1
  for (int kt = 0; kt < nk; ++kt) {
    const int cur = kt & 1;
    const bool more = (kt + 1 < nk);
    const int kn = more ? kt + 1 : kt;
#pragma unroll
    for (int i = 0; i < 4; ++i) {
      ra[i] = *(const u32x4*)(ap + (size_t)(64 * i) * lda + kn * 64);
      rb[i] = *(const u32x4*)(bp + (size_t)(64 * i) * ldb + kn * 64);
    }
    float4 cvn = cv;
    if (CONV) cvn = csrc[(size_t)kn * NTHR + tid];
    const u16* a_s = sbase + cur * GEMM_STAGE + (wm * 128 + l31) * LDT + hh * 8;
    const u16* b_s = sbase + cur * GEMM_STAGE + (256 + wn * 64 + l31) * LDT + hh * 8;
#pragma unroll
    for (int ks = 0; ks < 4; ++ks) {
      const bf16x8 b0 = *(const bf16x8*)(b_s + ks * 16);
      const bf16x8 b1 = *(const bf16x8*)(b_s + 32 * LDT + ks * 16);
      bf16x8 a0[4];
#pragma unroll
      for (int i = 0; i < 4; ++i) a0[i] = *(const bf16x8*)(a_s + i * 32 * LDT + ks * 16);
      __builtin_amdgcn_s_setprio(1);
#pragma unroll
      for (int i = 0; i < 4; ++i) {
        acc[i][0] = MFMA32(a0[i], b0, acc[i][0]);
        acc[i][1] = MFMA32(a0[i], b1, acc[i][1]);
      }
      __builtin_amdgcn_s_setprio(0);
    }
    {
      u16* w = sbase + (cur ^ 1) * GEMM_STAGE;
      const int g = (kn < 16) ? 0 : (kn < 24 ? 1 : 2);
#pragma unroll
      for (int i = 0; i < 4; ++i) {
        if (ASCALE) ra[i] = scale8(ra[i], sRow[(lr + 64 * i) * 4 + g]);
        *(u32x4*)(w + (lr + 64 * i) * LDT + lc) = ra[i];
        *(u32x4*)(w + (256 + lr + 64 * i) * LDT + lc) = rb[i];
        if (ROWNORM) ssq[i] += more ? ssq8(ra[i]) : 0.f;
      }
    }
    if (CONV) {
      u32 w4 = 0;
      w4 = __builtin_amdgcn_cvt_scalef32_pk_fp4_f32(w4, cv.x * cscale, cv.y * cscale, 1.0f, 0);
      w4 = __builtin_amdgcn_cvt_scalef32_pk_fp4_f32(w4, cv.z * cscale, cv.w * cscale, 1.0f, 1);
      cdst[(size_t)kt * NTHR + tid] = (u16)w4;
      cv = cvn;
    }
    if (CONV) {
      asm volatile("s_waitcnt lgkmcnt(0)" ::: "memory");
      __builtin_amdgcn_s_barrier();
      asm volatile("" ::: "memory");
    } else {
      __syncthreads();
    }
  }
  if (ROWNORM) {
#pragma unroll
    for (int i = 0; i < 4; ++i) {
      float s = ssq[i];
      s += __shfl_xor(s, 1);
      s += __shfl_xor(s, 2);
      s += __shfl_xor(s, 4);
      if ((tid & 7) == 0) sRow[lr + 64 * i] = rsqrtf(s / (float)K + EPS);
    }
    __syncthreads();
  }
}

DI void conv_transpose_all(const Params& p, char* smem) {
  const int lane = otid() & 63, wid = otid() >> 6;
  float* s = (float*)smem + wid * (64 * 65);
  constexpr int T0 = 32 * 61, T1 = T0 + 32 * 32, T2 = T1 + 32 * 16, T3 = T2 + 8 * 12, T4 = T3 + 4 * 16;
  for (int f = obid() * NWAVE + wid; f < 2 * T4; f += gridDim.x * NWAVE) {
    const int L = f / T4, r = f % T4;
    const float* W; const float* g; u16* Wt; int K, N, tile;
    if (r < T0)      { W = p.w_in + (size_t)L * 2048 * 3904; g = p.ln1 + L * 2048;   Wt = p.wt_in() + (size_t)L * HLD * 2048;   K = 2048; N = 3904; tile = r; }
    else if (r < T1) { W = p.wo + (size_t)L * 2048 * 2048;   g = p.onorm + L * 2048; Wt = p.wt_o() + (size_t)L * 2048 * 2048;   K = 2048; N = 2048; tile = r - T0; }
    else if (r < T2) { W = p.pwq + (size_t)L * 2048 * 1024;  g = p.ln2 + L * 2048;   Wt = p.wt_pq() + (size_t)L * 1024 * 2048;  K = 2048; N = 1024; tile = r - T1; }
    else if (r < T3) { W = p.wuq + (size_t)L * 512 * 768;    g = p.cqn + L * 512;    Wt = p.wt_uq() + (size_t)L * 768 * 512;    K = 512;  N = 768;  tile = r - T2; }
    else             { W = p.wukv + (size_t)L * 256 * 1024;  g = p.ckvn + L * 256;   Wt = p.wt_ukv() + (size_t)L * 1024 * 256;  K = 256;  N = 1024; tile = r - T3; }
    const int ntn = N / 64;
    const int k0 = (tile / ntn) * 64, n0 = (tile % ntn) * 64;
#pragma unroll 8
    for (int kk = 0; kk < 64; ++kk) s[kk * 65 + lane] = W[(size_t)(k0 + kk) * N + n0 + lane] * g[k0 + kk];
    __builtin_amdgcn_fence(__ATOMIC_RELEASE, "wavefront");
    __builtin_amdgcn_wave_barrier();
    __builtin_amdgcn_fence(__ATOMIC_ACQUIRE, "wavefront");
#pragma unroll 8
    for (int nn = 0; nn < 64; ++nn) Wt[(size_t)(n0 + nn) * K + k0 + lane] = f2bf(s[lane * 65 + nn]);
    __builtin_amdgcn_fence(__ATOMIC_RELEASE, "wavefront");
    __builtin_amdgcn_wave_barrier();
    __builtin_amdgcn_fence(__ATOMIC_ACQUIRE, "wavefront");
  }
}
DI void conv_flat(const float* __restrict__ src, u16* __restrict__ dst, size_t n4) {
  for (size_t i = (size_t)obid() * NTHR + otid(); i < n4; i += (size_t)gridDim.x * NTHR) {
    float4 v = ((const float4*)src)[i];
    u32x2 w = {pack2bf(v.x, v.y), pack2bf(v.z, v.w)};
    ((u32x2*)dst)[i] = w;
  }
}
DI void conv_fp4(const float* __restrict__ src, unsigned char* __restrict__ dst, size_t n8, float sc) {
  for (size_t i = (size_t)obid() * NTHR + otid(); i < n8; i += (size_t)gridDim.x * NTHR) {
    const float4 a = ((const float4*)src)[i * 2 + 0], b = ((const float4*)src)[i * 2 + 1];
    u32 w = 0;
    w = __builtin_amdgcn_cvt_scalef32_pk_fp4_f32(w, a.x * sc, a.y * sc, 1.0f, 0);
    w = __builtin_amdgcn_cvt_scalef32_pk_fp4_f32(w, a.z * sc, a.w * sc, 1.0f, 1);
    w = __builtin_amdgcn_cvt_scalef32_pk_fp4_f32(w, b.x * sc, b.y * sc, 1.0f, 2);
    w = __builtin_amdgcn_cvt_scalef32_pk_fp4_f32(w, b.z * sc, b.w * sc, 1.0f, 3);
    ((u32*)dst)[i] = w;
  }
}
DI void phase_prologue(const Params& p, char* smem) {
  __syncthreads();
  conv_transpose_all(p, smem);
  for (int L = 0; L < 2; ++L) {
    u16* pad = p.wt_in() + (size_t)L * HLD * 2048 + (size_t)3904 * 2048;
    for (int i = obid() * NTHR + otid(); i < 192 * 2048 / 8; i += gridDim.x * NTHR) ((u32x4*)pad)[i] = u32x4{0, 0, 0, 0};
  }
  for (int i = obid() * NTHR + otid(); i < 2 * 256 * 128; i += gridDim.x * NTHR) {
    const int L = i >> 15, n = (i >> 7) & 255, k = i & 127;
    const int c = n >> 7, kin = k - 64 * c;
    const float v = (kin >= 0 && kin < 64) ? p.pkeys[((size_t)(L * 2 + c) * 128 + (n & 127)) * 64 + kin] : 0.f;
    p.keys_b()[i] = f2bf(v);
  }
  conv_flat(p.x, p.xb(), (size_t)T * 2048 / 4);
  for (int i = obid() * NTHR + otid(); i < SEQ * 32; i += gridDim.x * NTHR) {
    const int pos = i >> 5, f = i & 31;
    const float inv = powf(10000.0f, -(float)f / 32.0f);
    const float ang = (float)pos * inv;
    p.ropeC()[i] = cosf(ang);
    p.ropeS()[i] = sinf(ang);
  }
}

#define EPI_IDS                                                                                     \
  const int etid = otid();                                                                          \
  const int lane = etid & 63, wid = etid >> 6, wm = wid >> 2, wn = wid & 3, hh = lane >> 5, l31 = lane & 31;

constexpr int EPI_TS = 264;
#define EPI_LDS_WRITE(SCALE_EXPR)                                                             \
  {                                                                                           \
    u16* sT_ = (u16*)smem;                                                                    \
    _Pragma("unroll") for (int i = 0; i < 4; ++i)                                             \
      _Pragma("unroll") for (int j = 0; j < 2; ++j)                                           \
        _Pragma("unroll") for (int r = 0; r < 16; ++r) {                                      \
          const int rl = wm * 128 + i * 32 + crow(r, hh);                                     \
          sT_[rl * EPI_TS + wn * 64 + j * 32 + l31] = f2bf(acc[i][j][r] * (SCALE_EXPR));      \
        }                                                                                     \
    __syncthreads();                                                                          \
  }

DI void phase_gemm1(const Params& p, int L, char* smem) {
  const u16* Wt = p.wt_in() + (size_t)L * HLD * 2048;
  const float* sRow = (const float*)(smem + GEMM_SROW_OFF);
  for (int it = 0;; ++it) {
    int mt, nt;
    if (!gemm_tile_map(it, 64, 16, mt, nt)) { if (mt < 0) break; continue; }
    f32x16 acc[4][2];
    const int tile_id = mt * 16 + nt;
    const bool isv = tile_id >= 512;
    const float4* csrc = (const float4*)((isv ? p.pv : p.pu) + (size_t)L * NEXP * 2048) + (size_t)(tile_id & 511) * 32 * NTHR;
    u16* cdst = (u16*)((isv ? p.vb() : p.ub()) + (size_t)L * NEXP * 1024) + (size_t)(tile_id & 511) * 32 * NTHR;
    gemm_mainloop<true, true>(p.xb() + (size_t)mt * GM * 2048, 2048, Wt + (size_t)nt * GN * 2048, 2048, 2048, smem, acc, csrc, cdst,
                              isv ? V_SCALE : U_SCALE);
    EPI_IDS
    const int nt128 = nt * 2 + (wn >> 1), wn1 = wn & 1;
    const int m0 = mt * GM, b = m0 >> 12, s0 = m0 & 4095;
    const bool plain = (nt != 5) && (nt != 10) && (nt != 11) && (nt != 15);
    if (plain) {
      const float sc = (nt < 4 || nt == 6 || nt == 7) ? QSCALE_AB : 1.f;
      EPI_LDS_WRITE(sRow[rl] * sc)
      const u16* sT = (const u16*)smem;
#pragma unroll 4
      for (int it = 0; it < 16; ++it) {
        const int c = etid + NTHR * it, row = c >> 5, cc = c & 31;
        *(u32x4*)(p.h() + (size_t)(m0 + row) * HLD + nt * GN + cc * 8) = *(const u32x4*)(sT + row * EPI_TS + cc * 8);
      }
    } else {
    if (nt128 >= 30) {
      if (nt128 == 30 && wn1 == 0) {
#pragma unroll
        for (int i = 0; i < 4; ++i)
#pragma unroll
          for (int r = 0; r < 16; ++r) {
            const int rl = wm * 128 + i * 32 + crow(r, hh);
            const float rs = sRow[rl];
            const float x1 = acc[i][0][r] * rs, x2 = acc[i][1][r] * rs;
            const int pos = s0 + rl;
            const float c = p.ropeC()[pos * 32 + l31], sn = p.ropeS()[pos * 32 + l31];
            const u16 o1 = f2bf(x1 * c - x2 * sn), o2 = f2bf(x1 * sn + x2 * c);
            u16* sT_ = (u16*)smem;
            sT_[rl * EPI_TS + l31] = o1;
            sT_[rl * EPI_TS + 32 + l31] = o2;
            if ((r & 3) == 3) __builtin_amdgcn_sched_barrier(0);
          }
      }
    } else if (nt128 == 10 || nt128 == 11 || (nt128 >= 20 && nt128 < 24)) {
      u16* vt;
      int nh, hd;
      if (nt128 < 12) { vt = p.vtA(); nh = 2; hd = nt128 - 10; } else { vt = p.vtB(); nh = 4; hd = nt128 - 20; }
#pragma unroll
      for (int i = 0; i < 4; ++i)
#pragma unroll
        for (int j = 0; j < 2; ++j)
#pragma unroll
          for (int g4 = 0; g4 < 4; ++g4) {
            const int rl0 = wm * 128 + i * 32 + 8 * g4 + 4 * hh;
            const int d = wn1 * 64 + j * 32 + l31;
            const float v0 = acc[i][j][4 * g4 + 0] * sRow[rl0 + 0], v1 = acc[i][j][4 * g4 + 1] * sRow[rl0 + 1];
            const float v2 = acc[i][j][4 * g4 + 2] * sRow[rl0 + 2], v3 = acc[i][j][4 * g4 + 3] * sRow[rl0 + 3];
            u32x2 w = {pack2bf(v0, v1), pack2bf(v2, v3)};
            *(u32x2*)(vt + ((size_t)(b * nh + hd) * 128 + d) * 4096 + s0 + rl0) = w;
          }
    } else {
      const float sc = (nt128 < 8 || (nt128 >= 12 && nt128 < 16)) ? QSCALE_AB : 1.f;
#pragma unroll
      for (int i = 0; i < 4; ++i)
#pragma unroll
        for (int j = 0; j < 2; ++j)
#pragma unroll
          for (int r = 0; r < 16; ++r) {
            const int rl = wm * 128 + i * 32 + crow(r, hh);
            p.h()[(size_t)(m0 + rl) * HLD + nt128 * 128 + wn1 * 64 + j * 32 + l31] = f2bf(acc[i][j][r] * sRow[rl] * sc);
          }
    }
    if (nt == 15) {
      __syncthreads();
      const u16* sT = (const u16*)smem;
#pragma unroll 4
      for (int it = 0; it < 16; ++it) {
        const int c = etid + NTHR * it, hd = c >> 11, row = (c >> 3) & 255, cc = c & 7;
        *(u32x4*)(p.kmla() + ((size_t)(b * 4 + hd) * 4096 + s0 + row) * 192 + 128 + cc * 8) = *(const u32x4*)(sT + row * EPI_TS + cc * 8);
      }
    }
    }
  }
}

DI void tile_upq(const Params& p, int L, int tile, char* smem) {
  const float* sRow = (const float*)(smem + GEMM_SROW_OFF);
  const int mt = tile / 3, nt = tile % 3;
  f32x16 acc[4][2];
  gemm_mainloop<true>(p.h() + (size_t)mt * GM * HLD + 3072, HLD, p.wt_uq() + (size_t)L * 768 * 512 + (size_t)nt * GN * 512, 512, 512,
                      smem, acc);
  EPI_IDS
  const int m0 = mt * GM, b = m0 >> 12, s0 = m0 & 4095;
  EPI_LDS_WRITE(sRow[rl] * QSCALE_C)
  {
    const u16* sT = (const u16*)smem;
#pragma unroll 4
    for (int it = 0; it < 16; ++it) {
      const int c = etid + NTHR * it, row = c >> 5, cc = c & 31;
      const int nb64 = nt * 4 + (cc >> 3);
      const int head = nb64 / 3, part = nb64 % 3;
      *(u32x4*)(p.qmla() + ((size_t)(b * 4 + head) * 4096 + s0 + row) * 192 + part * 64 + (cc & 7) * 8) = *(const u32x4*)(sT + row * EPI_TS + cc * 8);
    }
  }
}

DI void tile_upkv(const Params& p, int L, int tile, char* smem) {
  const float* sRow = (const float*)(smem + GEMM_SROW_OFF);
  const int mt = tile >> 2, nt = tile & 3;
  f32x16 acc[4][2];
  gemm_mainloop<true>(p.h() + (size_t)mt * GM * HLD + 3584, HLD, p.wt_ukv() + (size_t)L * 1024 * 256 + (size_t)nt * GN * 256, 256, 256,
                      smem, acc);
  EPI_IDS
  const int nt128 = nt * 2 + (wn >> 1), wn1 = wn & 1;
  const int m0 = mt * GM, b = m0 >> 12, s0 = m0 & 4095;
  const int head = nt128 >> 1;
  EPI_LDS_WRITE(sRow[rl])
  {
    const u16* sT = (const u16*)smem;
#pragma unroll 4
    for (int it = 0; it < 8; ++it) {
      const int c = etid + NTHR * it, row = c >> 4, cc = c & 15;
      *(u32x4*)(p.kmla() + ((size_t)(b * 4 + nt) * 4096 + s0 + row) * 192 + cc * 8) = *(const u32x4*)(sT + row * EPI_TS + cc * 8);
    }
  }
  if (nt128 & 1) {
#pragma unroll
    for (int i = 0; i < 4; ++i)
#pragma unroll
      for (int j = 0; j < 2; ++j)
#pragma unroll
        for (int g4 = 0; g4 < 4; ++g4) {
          const int rl0 = wm * 128 + i * 32 + 8 * g4 + 4 * hh;
          const int d = wn1 * 64 + j * 32 + l31;
          const float v0 = acc[i][j][4 * g4 + 0] * sRow[rl0 + 0], v1 = acc[i][j][4 * g4 + 1] * sRow[rl0 + 1];
          const float v2 = acc[i][j][4 * g4 + 2] * sRow[rl0 + 2], v3 = acc[i][j][4 * g4 + 3] * sRow[rl0 + 3];
          u32x2 w = {pack2bf(v0, v1), pack2bf(v2, v3)};
          *(u32x2*)(p.vtC() + ((size_t)(b * 4 + head) * 128 + d) * 4096 + s0 + rl0) = w;
        }
  }
}

DI void phase_gemm_o(const Params& p, int L, char* smem) {
  const u16* Wt = p.wt_o() + (size_t)L * 2048 * 2048;
  for (int it = 0;; ++it) {
    int mt, nt;
    if (!gemm_tile_map(it, 64, 8, mt, nt)) { if (mt < 0) break; continue; }
    f32x16 acc[4][2];
    {
      float* sRow = (float*)(smem + GEMM_SROW_OFF);
      const int t = otid();
      __syncthreads();
      if (t < 256) {
        const float4* sp = (const float4*)(p.ssqh() + (size_t)(mt * GM + t) * 16);
        const float4 a0 = sp[0], a1 = sp[1], b0 = sp[2], c0 = sp[3];
        sRow[t * 4 + 0] = rsqrtf((a0.x + a0.y + a0.z + a0.w + a1.x + a1.y + a1.z + a1.w) * (1.f / 1024.f) + EPS);
        sRow[t * 4 + 1] = rsqrtf((b0.x + b0.y + b0.z + b0.w) * (1.f / 512.f) + EPS);
        sRow[t * 4 + 2] = rsqrtf((c0.x + c0.y + c0.z + c0.w) * (1.f / 512.f) + EPS);
      }
    }
    gemm_mainloop<false, false, true>(p.o() + (size_t)mt * GM * 2048, 2048, Wt + (size_t)nt * GN * 2048, 2048, 2048, smem, acc);
    EPI_IDS
    EPI_LDS_WRITE(1.f)
    {
      const u16* sT = (const u16*)smem;
#pragma unroll 8
      for (int it = 0; it < 16; ++it) {
        const int c = etid + NTHR * it, row = c >> 5, cc = c & 31;
        u16* xp = p.xb() + (size_t)(mt * GM + row) * 2048 + nt * GN + cc * 8;
        const u32x4 d = *(const u32x4*)(sT + row * EPI_TS + cc * 8);
        u32x4 x = *(const u32x4*)xp;
        x.x = pack2bf(bf_lo(x.x) + bf_lo(d.x), bf_hi(x.x) + bf_hi(d.x));
        x.y = pack2bf(bf_lo(x.y) + bf_lo(d.y), bf_hi(x.y) + bf_hi(d.y));
        x.z = pack2bf(bf_lo(x.z) + bf_lo(d.z), bf_hi(x.z) + bf_hi(d.z));
        x.w = pack2bf(bf_lo(x.w) + bf_lo(d.w), bf_hi(x.w) + bf_hi(d.w));
        *(u32x4*)xp = x;
      }
    }
  }
}

DI void phase_gemm_pq(const Params& p, int L, char* smem) {
  const u16* Wt = p.wt_pq() + (size_t)L * 1024 * 2048;
  const float* sRow = (const float*)(smem + GEMM_SROW_OFF);
  for (int tile = obid(); tile < 64 * 4; tile += gridDim.x) {
    const int mt = tile >> 2, nt = tile & 3;
    f32x16 acc[4][2];
    gemm_mainloop<true>(p.xb() + (size_t)mt * GM * 2048, 2048, Wt + (size_t)nt * GN * 2048, 2048, 2048, smem, acc);
    EPI_IDS
    EPI_LDS_WRITE(sRow[rl])
    {
      const u16* sT = (const u16*)smem;
#pragma unroll 4
      for (int it = 0; it < 16; ++it) {
        const int c = etid + NTHR * it, row = c >> 5, cc = c & 31;
        *(u32x4*)(p.pq() + (size_t)(mt * GM + row) * 1024 + nt * GN + cc * 8) = *(const u32x4*)(sT + row * EPI_TS + cc * 8);
      }
    }
  }
}

DI void phase_gemm_scores(const Params& p, int L, char* smem) {
  for (int mt = obid(); mt < 512; mt += gridDim.x) {
    f32x16 acc[4][2];
    gemm_mainloop<false>(p.pq() + (size_t)mt * GM * 128, 128, p.keys_b() + (size_t)L * 256 * 128, 128, 128, smem, acc);
    EPI_IDS
#pragma unroll
    for (int i = 0; i < 4; ++i)
#pragma unroll
      for (int j = 0; j < 2; ++j)
#pragma unroll
        for (int r = 0; r < 16; ++r) {
          const int rl = wm * 128 + i * 32 + crow(r, hh);
          p.scores()[(size_t)(mt * GM + rl) * 256 + wn * 64 + j * 32 + l31] = acc[i][j][r];
        }
  }
}

template <int DQK, int MODE>
DI void attn_block(char* smem, const u16* __restrict__ Q, int ldq, const u16* __restrict__ Kb, int ldk,
                   const u16* __restrict__ Vt, int t0, int t1, int qpos0, float slope2, float sink2,
                   const float* __restrict__ biasTbl, u16* __restrict__ Oout, float* __restrict__ ssq_out,
                   const float* __restrict__ ropeCS = nullptr) {
  constexpr int LDK = DQK + 8;
  constexpr int NCH = DQK / 8;
  constexpr int KCH = NCH / 8;
  constexpr int NKS = DQK / 16;
  constexpr int STG = 64 * LDK + 128 * 68;
  u16* sbase = (u16*)smem;
  float* sBias = (float*)(sbase + 2 * STG);
  const int tid = otid(), lane = tid & 63, wid = tid >> 6, hh = lane >> 5, l31 = lane & 31;

  __syncthreads();
  if (MODE == 1) {
    for (int i = tid; i < 465; i += NTHR) sBias[i] = biasTbl[i] * LOG2E;
  }
  bf16x8 qf[NKS];
  {
    const u16* qrow = Q + (size_t)(wid * 32 + l31) * ldq + hh * 8;
#pragma unroll
    for (int ks = 0; ks < NKS; ++ks) qf[ks] = *(const bf16x8*)(qrow + ks * 16);
  }
  if (MODE == 2) {
    const int pos = qpos0 + wid * 32 + l31;
#pragma unroll
    for (int k2 = 0; k2 < 2; ++k2) {
      const float* cp = ropeCS + (size_t)pos * 32 + k2 * 16 + 8 * hh;
      const float* sp = ropeCS + (size_t)SEQ * 32 + (size_t)pos * 32 + k2 * 16 + 8 * hh;
#pragma unroll
      for (int j = 0; j < 8; ++j) {
        const float c = cp[j], sn = sp[j];
        const float x1 = __uint_as_float(((u32)(u16)qf[NKS - 4 + k2][j]) << 16);
        const float x2 = __uint_as_float(((u32)(u16)qf[NKS - 2 + k2][j]) << 16);
        qf[NKS - 4 + k2][j] = (short)f2bf(x1 * c - x2 * sn);
        qf[NKS - 2 + k2][j] = (short)f2bf(x1 * sn + x2 * c);
      }
    }
  }
  constexpr float SM_THR = 6.f;
  float m_run = (MODE == 0) ? sink2 : 0.f;
  float l_run = (MODE == 0 && hh == 0) ? 1.f : 0.f;
  bool first = true;
  f32x16 oacc[4];
#pragma unroll
  for (int d = 0; d < 4; ++d)
#pragma unroll
    for (int r = 0; r < 16; ++r) oacc[d][r] = 0.f;

  const int widu = __builtin_amdgcn_readfirstlane(wid);
  const int qw0 = qpos0 + widu * 32;
  const int qpos = qw0 + l31;
  const int rq = (qpos0 >> 6) + (widu >> 1);
  const int rsq = min(max(rq - 4, 0), 56);
  const int cq = (wid & 1) * 32 + l31;
  const int cs = min(max(cq - 8, 0), 48);

  u32x4 rk[KCH], rv[2];
#define ATTN_LOAD_TILE(TT)                                                              \
  {                                                                                     \
    _Pragma("unroll") for (int i = 0; i < KCH; ++i) {                                   \
      const int c = tid + NTHR * i;                                                     \
      const int rr = c / NCH, cc = c % NCH;                                             \
      rk[i] = *(const u32x4*)(Kb + (size_t)((TT) * 64 + rr) * ldk + cc * 8);            \
    }                                                                                   \
    _Pragma("unroll") for (int i = 0; i < 2; ++i) {                                     \
      const int c = tid + NTHR * i;                                                     \
      const int d = c >> 3, part = c & 7;                                               \
      rv[i] = *(const u32x4*)(Vt + (size_t)d * 4096 + (TT) * 64 + part * 8);            \
    }                                                                                   \
  }
#define ATTN_STORE_TILE(STAGE)                                                          \
  {                                                                                     \
    u16* sKw = sbase + (STAGE) * STG;                                                   \
    u16* sVw = sKw + 64 * LDK;                                                          \
    _Pragma("unroll") for (int i = 0; i < KCH; ++i) {                                   \
      const int c = tid + NTHR * i;                                                     \
      const int rr = c / NCH, cc = c % NCH;                                             \
      *(u32x4*)(sKw + rr * LDK + cc * 8) = rk[i];                                       \
    }                                                                                   \
    _Pragma("unroll") for (int i = 0; i < 2; ++i) {                                     \
      const int c = tid + NTHR * i;                                                     \
      const int d = c >> 3, part = c & 7;                                               \
      *(u32x2*)(sVw + d * 68 + part * 8) = u32x2{rv[i].x, rv[i].y};                     \
      *(u32x2*)(sVw + d * 68 + part * 8 + 4) = u32x2{rv[i].z, rv[i].w};                 \
    }                                                                                   \
  }
  ATTN_LOAD_TILE(t0)
  ATTN_STORE_TILE(0)
  __syncthreads();
#pragma unroll 1
  for (int t = t0; t < t1; ++t) {
    const int cur = (t - t0) & 1;
    {
      const int tn = (t + 1 < t1) ? t + 1 : t;
      ATTN_LOAD_TILE(tn)
    }
    const u16* sK = sbase + cur * STG;
    const u16* sV = sK + 64 * LDK;
    bool relevant = true;
    if (MODE == 0) relevant = (t * 64 <= qw0 + 31 + 128) && (t * 64 + 63 >= qw0 - 128);
    if (MODE == 1) relevant = (t >= rsq) && (t < rsq + 8);
    if (relevant) {
      f32x16 sacc[2];
#pragma unroll
      for (int tt = 0; tt < 2; ++tt) {
#pragma unroll
        for (int r = 0; r < 16; ++r) sacc[tt][r] = -m_run;
        const u16* kp = sK + (tt * 32 + l31) * LDK + hh * 8;
#pragma unroll
        for (int ks = 0; ks < NKS; ++ks) {
          bf16x8 kf = *(const bf16x8*)(kp + ks * 16);
          sacc[tt] = MFMA32(kf, qf[ks], sacc[tt]);
        }
      }
      float mx = -INFINITY;
      const int drow = min(max(t - rq + 7, 0), 14) * 31;
#pragma unroll
      for (int tt = 0; tt < 2; ++tt)
#pragma unroll
        for (int r = 0; r < 16; ++r) {
          float sv = sacc[tt][r];
          const int kl = tt * 32 + crow(r, hh);
          if (MODE == 0) {
            const int kpos = t * 64 + kl;
            int dist = qpos - kpos;
            dist = dist < 0 ? -dist : dist;
            sv = (dist <= 128) ? (sv - slope2 * (float)dist) : -INFINITY;
          } else if (MODE == 1) {
            const bool ok = ((unsigned)(kl - cs) < 16u);
            const int dc = min(max(kl - cq + 15, 0), 30);
            sv = ok ? (sv + sBias[drow + dc]) : -INFINITY;
          }
          sacc[tt][r] = sv;
          mx = fmaxf(mx, sv);
        }
      mx = fmaxf(mx, __shfl_xor(mx, 32));
      if (__builtin_amdgcn_ballot_w64(first || (mx > SM_THR)) != 0ull) {
        float delta = fmaxf(mx, 0.f);
        if (first && MODE != 0) delta = (mx > -INFINITY) ? mx : 0.f;
        m_run += delta;
        const float alpha = __builtin_amdgcn_exp2f(-delta);
        l_run *= alpha;
#pragma unroll
        for (int d = 0; d < 4; ++d)
#pragma unroll
          for (int r = 0; r < 16; ++r) oacc[d][r] *= alpha;
#pragma unroll
        for (int tt = 0; tt < 2; ++tt)
#pragma unroll
          for (int r = 0; r < 16; ++r) sacc[tt][r] -= delta;
        first = false;
      }
      float ps = 0.f;
#pragma unroll
      for (int tt = 0; tt < 2; ++tt) {
#pragma unroll
        for (int r = 0; r < 16; ++r) {
          const float pv = __builtin_amdgcn_exp2f(sacc[tt][r]);
          sacc[tt][r] = pv;
          ps += pv;
        }
#pragma unroll
        for (int s2 = 0; s2 < 2; ++s2) {
          u32x4 w;
          w.x = pack2bf(sacc[tt][8 * s2 + 0], sacc[tt][8 * s2 + 1]);
          w.y = pack2bf(sacc[tt][8 * s2 + 2], sacc[tt][8 * s2 + 3]);
          w.z = pack2bf(sacc[tt][8 * s2 + 4], sacc[tt][8 * s2 + 5]);
          w.w = pack2bf(sacc[tt][8 * s2 + 6], sacc[tt][8 * s2 + 7]);
          const bf16x8 pf = __builtin_bit_cast(bf16x8, w);
#pragma unroll
          for (int dt = 0; dt < 4; ++dt) {
            const u16* vp = sV + (dt * 32 + l31) * 68 + 4 * hh;
            const u32x2 lo = *(const u32x2*)(vp + tt * 32 + s2 * 16);
            const u32x2 hi = *(const u32x2*)(vp + tt * 32 + s2 * 16 + 8);
            u32x4 wv = {lo.x, lo.y, hi.x, hi.y};
            oacc[dt] = MFMA32(__builtin_bit_cast(bf16x8, wv), pf, oacc[dt]);
          }
        }
      }
      l_run += ps;
    }
    ATTN_STORE_TILE(cur ^ 1)
    __syncthreads();
  }
  const float lt = l_run + __shfl_xor(l_run, 32);
  const float inv = 1.f / lt;
  float sq = 0.f;
  u16* orow = Oout + (size_t)(wid * 32 + l31) * 2048;
#pragma unroll
  for (int dt = 0; dt < 4; ++dt)
#pragma unroll
    for (int g4 = 0; g4 < 4; ++g4) {
      const float v0 = oacc[dt][4 * g4 + 0] * inv, v1 = oacc[dt][4 * g4 + 1] * inv;
      const float v2 = oacc[dt][4 * g4 + 2] * inv, v3 = oacc[dt][4 * g4 + 3] * inv;
      sq += v0 * v0 + v1 * v1 + v2 * v2 + v3 * v3;
      u32x2 w = {pack2bf(v0, v1), pack2bf(v2, v3)};
      *(u32x2*)(orow + dt * 32 + 8 * g4 + 4 * hh) = w;
    }
  sq += __shfl_xor(sq, 32);
  if (hh == 0) ssq_out[(size_t)(wid * 32 + l31) * 16] = sq;
}

DI void phase_mix(const Params& p, int L, char* smem) {
  for (int w = obid(); w < 256; w += gridDim.x) {
    const int b = w >> 6, rem = w & 63, rg = rem >> 2, hb = rem & 3;
    const int r0 = rg * 4;
    const int t0 = min(max(r0 - 4, 0), 56), t1 = min(max(r0 - 1, 0), 56) + 8;
    const size_t tok0 = (size_t)b * 4096 + r0 * 64;
    attn_block<128, 1>(smem, p.h() + tok0 * HLD + 1536 + hb * 128, HLD, p.h() + (size_t)b * 4096 * HLD + 2048 + hb * 128, HLD,
                       p.vtB() + (size_t)(b * 4 + hb) * 128 * 4096, t0, t1, r0 * 64, 0.f, 0.f,
                       p.b_rel + (size_t)L * 4 * 465 + hb * 465, p.o() + tok0 * 2048 + 1024 + hb * 128, p.ssqh() + tok0 * 16 + 8 + hb);
  }
  for (int ww = obid(); ww < 512; ww += gridDim.x) {
    const int b = ww >> 7, rem = ww & 127, sb = rem >> 3, hq = rem & 7;
    const int t0 = max(0, 4 * sb - 2), t1 = min(64, 4 * sb + 6);
    const size_t tok0 = (size_t)b * 4096 + sb * 256;
    const float slope2 = exp2f(-(float)(hq + 1)) * LOG2E;
    const float sink2 = p.a_sink[L * 8 + hq] * LOG2E;
    attn_block<128, 0>(smem, p.h() + tok0 * HLD + hq * 128, HLD, p.h() + (size_t)b * 4096 * HLD + 1024 + (hq >> 2) * 128, HLD,
                       p.vtA() + (size_t)(b * 2 + (hq >> 2)) * 128 * 4096, t0, t1, sb * 256, slope2, sink2, nullptr,
                       p.o() + tok0 * 2048 + hq * 128, p.ssqh() + tok0 * 16 + hq);
  }
  for (int w = (obid() + 64) % gridDim.x; w < 192; w += gridDim.x) tile_upq(p, L, w, smem);
  for (int w = obid(); w < 256; w += gridDim.x) tile_upkv(p, L, w, smem);
}

DI void phase_mla(const Params& p, char* smem) {
  const int nbx = gridDim.x >> 3;
  for (int li = obid() >> 3; li < 32; li += nbx) {
    const int pair = (obid() & 7) * 2 + (li >> 4), nq = li & 15;
    const int b = pair >> 2, hc = pair & 3;
    const size_t tok0 = (size_t)b * 4096 + nq * 256;
    attn_block<192, 2>(smem, p.qmla() + ((size_t)(b * 4 + hc) * 4096 + nq * 256) * 192, 192, p.kmla() + (size_t)(b * 4 + hc) * 4096 * 192, 192,
                       p.vtC() + (size_t)(b * 4 + hc) * 128 * 4096, 0, 64, nq * 256, 0.f, 0.f, nullptr,
                       p.o() + tok0 * 2048 + 1536 + hc * 128, p.ssqh() + tok0 * 16 + 12 + hc, p.ropeC());
  }
}

DI void phase_onorm(const Params& p) {
  const int lane = otid() & 63, wid = otid() >> 6;
  for (int row = obid() * NWAVE + wid; row < T; row += gridDim.x * NWAVE) {
    const float4* sp = (const float4*)(p.ssqh() + (size_t)row * 16);
    const float4 a0 = sp[0], a1 = sp[1], b0 = sp[2], c0 = sp[3];
    const float rA = rsqrtf((a0.x + a0.y + a0.z + a0.w + a1.x + a1.y + a1.z + a1.w) * (1.f / 1024.f) + EPS);
    const float rB = rsqrtf((b0.x + b0.y + b0.z + b0.w) * (1.f / 512.f) + EPS);
    const float rC = rsqrtf((c0.x + c0.y + c0.z + c0.w) * (1.f / 512.f) + EPS);
#pragma unroll
    for (int j = 0; j < 4; ++j) {
      const float sc = (j < 2) ? rA : (j == 2 ? rB : rC);
      const size_t off = (size_t)row * 2048 + j * 512 + lane * 8;
      u32x4 w = *(const u32x4*)(p.o() + off);
      w.x = pack2bf(bf_lo(w.x) * sc, bf_hi(w.x) * sc);
      w.y = pack2bf(bf_lo(w.y) * sc, bf_hi(w.y) * sc);
      w.z = pack2bf(bf_lo(w.z) * sc, bf_hi(w.z) * sc);
      w.w = pack2bf(bf_lo(w.w) * sc, bf_hi(w.w) * sc);
      *(u32x4*)(p.on() + off) = w;
    }
  }
}

DI u32 ordkey(float s) {
  const u32 u = __float_as_uint(s);
  return u ^ ((u >> 31) ? 0xFFFFFFFFu : 0x80000000u);
}
DI float unord(u32 k) {
  const u32 u = (k & 0x80000000u) ? (k ^ 0x80000000u) : ~k;
  return __uint_as_float(u);
}
DI void insert16(u32 (&Ls)[16], u32 key) {
#pragma unroll
  for (int q = 0; q < 16; ++q) {
    const u32 hi = max(Ls[q], key);
    key = min(Ls[q], key);
    Ls[q] = hi;
  }
}

DI void phase_select(const Params& p, int L, char* smem) {
  float* sS = (float*)smem;
  u32* sTop = (u32*)(smem + 256 * 132 * 4);
  const int tid = otid(), lane = tid & 63, wid = tid >> 6, hh = lane >> 5, l31 = lane & 31;
  const int rt = wid >> 1, c = wid & 1;
  const u16* kb = p.keys_b() + (size_t)L * 256 * 128;
  for (int it = obid(); it < 1024; it += gridDim.x) {
    f32x16 sc[4];
    {
      const u16* qrow = p.pq() + ((size_t)it * 128 + rt * 32 + l31) * 128 + c * 64 + hh * 8;
      bf16x8 qa[4];
#pragma unroll
      for (int ks = 0; ks < 4; ++ks) qa[ks] = *(const bf16x8*)(qrow + ks * 16);
#pragma unroll
      for (int ct = 0; ct < 4; ++ct) {
#pragma unroll
        for (int r = 0; r < 16; ++r) sc[ct][r] = 0.f;
        const u16* krow = kb + (size_t)(c * 128 + ct * 32 + l31) * 128 + c * 64 + hh * 8;
#pragma unroll
        for (int ks = 0; ks < 4; ++ks) {
          const bf16x8 kf = *(const bf16x8*)(krow + ks * 16);
          sc[ct] = MFMA32(qa[ks], kf, sc[ct]);
        }
      }
    }
    __syncthreads();
#pragma unroll
    for (int ct = 0; ct < 4; ++ct)
#pragma unroll
      for (int r = 0; r < 16; ++r) sS[((rt * 32 + crow(r, hh)) * 2 + c) * 132 + ct * 32 + l31] = sc[ct][r];
    __syncthreads();
    {
      const int combo = tid >> 1, half = tid & 1;
      u32 Ls[16];
#pragma unroll
      for (int q = 0; q < 16; ++q) Ls[q] = 0u;
      const float* sp = sS + combo * 132 + half * 64;
      for (int n4 = 0; n4 < 16; ++n4) {
        const int n4r = (n4 + half * 8) & 15;
        const float4 v = *(const float4*)(sp + n4r * 4);
        const int nb = half * 64 + n4r * 4;
        insert16(Ls, (ordkey(v.x) & ~0x7Fu) | (u32)(127 - (nb + 0)));
        insert16(Ls, (ordkey(v.y) & ~0x7Fu) | (u32)(127 - (nb + 1)));
        insert16(Ls, (ordkey(v.z) & ~0x7Fu) | (u32)(127 - (nb + 2)));
        insert16(Ls, (ordkey(v.w) & ~0x7Fu) | (u32)(127 - (nb + 3)));
      }
      u32 Ms[16];
#pragma unroll
      for (int q = 0; q < 16; ++q) {
        const u32 other = (u32)__shfl_xor((int)Ls[15 - q], 1);
        Ms[q] = max(Ls[q], other);
      }
#pragma unroll
      for (int span = 8; span >= 1; span >>= 1)
#pragma unroll
        for (int q = 0; q < 16; ++q)
          if ((q & span) == 0) {
            const u32 hi = max(Ms[q], Ms[q + span]), lo = min(Ms[q], Ms[q + span]);
            Ms[q] = hi;
            Ms[q + span] = lo;
          }
      if (half == 0) {
#pragma unroll
        for (int q = 0; q < 16; ++q) sTop[combo * 16 + q] = Ms[q];
      }
    }
    __syncthreads();
    if (tid < 128) {
      const u32* t0 = sTop + (tid * 2) * 16;
      const u32* t1 = sTop + (tid * 2 + 1) * 16;
      float s0[16], s1[16];
#pragma unroll
      for (int q = 0; q < 16; ++q) {
        s0[q] = unord(t0[q] & ~0x7Fu);
        s1[q] = unord(t1[q] & ~0x7Fu);
      }
      u32 M[16];
#pragma unroll
      for (int q = 0; q < 16; ++q) M[q] = 0u;
#pragma unroll
      for (int i = 0; i < 16; ++i)
#pragma unroll
        for (int j = 0; j < 16; ++j)
          if ((i + 1) * (j + 1) <= 16) {
            const float sm = s0[i] + s1[j];
            insert16(M, (ordkey(sm) & ~0xFFu) | (u32)(255 - (i * 16 + j)));
          }
      const float mxv = unord(M[0] & ~0xFFu);
      float e[16], sum = 0.f;
#pragma unroll
      for (int q = 0; q < 16; ++q) {
        e[q] = __expf(unord(M[q] & ~0xFFu) - mxv);
        sum += e[q];
      }
      const float inv = 1.f / sum;
      const size_t row = (size_t)it * 128 + tid;
#pragma unroll
      for (int q = 0; q < 16; ++q) {
        const int ij = 255 - (int)(M[q] & 0xFFu);
        const int n0 = 127 - (int)(t0[ij >> 4] & 0x7Fu);
        const int n1 = 127 - (int)(t1[ij & 15] & 0x7Fu);
        p.idx()[row * 16 + q] = n0 * 128 + n1;
        p.g()[row * 16 + q] = e[q] * inv;
      }
    }
  }
}

DI float dot32(u32x4 w, const float2_t* xn2) {
  float2_t s = {0.f, 0.f};
#pragma unroll
  for (int c = 0; c < 4; ++c) {
    s = __builtin_elementwise_fma(__builtin_amdgcn_cvt_scalef32_pk_f32_fp4(w[c], 1.0f, 0), xn2[4 * c + 0], s);
    s = __builtin_elementwise_fma(__builtin_amdgcn_cvt_scalef32_pk_f32_fp4(w[c], 1.0f, 1), xn2[4 * c + 1], s);
    s = __builtin_elementwise_fma(__builtin_amdgcn_cvt_scalef32_pk_f32_fp4(w[c], 1.0f, 2), xn2[4 * c + 2], s);
    s = __builtin_elementwise_fma(__builtin_amdgcn_cvt_scalef32_pk_f32_fp4(w[c], 1.0f, 3), xn2[4 * c + 3], s);
  }
  return s.x + s.y;
}
DI void axpy32(u32x4 w, float a, float2_t* y2) {
  const float2_t a2 = {a, a};
#pragma unroll
  for (int c = 0; c < 4; ++c) {
    y2[4 * c + 0] = __builtin_elementwise_fma(__builtin_amdgcn_cvt_scalef32_pk_f32_fp4(w[c], 1.0f, 0), a2, y2[4 * c + 0]);
    y2[4 * c + 1] = __builtin_elementwise_fma(__builtin_amdgcn_cvt_scalef32_pk_f32_fp4(w[c], 1.0f, 1), a2, y2[4 * c + 1]);
    y2[4 * c + 2] = __builtin_elementwise_fma(__builtin_amdgcn_cvt_scalef32_pk_f32_fp4(w[c], 1.0f, 2), a2, y2[4 * c + 2]);
    y2[4 * c + 3] = __builtin_elementwise_fma(__builtin_amdgcn_cvt_scalef32_pk_f32_fp4(w[c], 1.0f, 3), a2, y2[4 * c + 3]);
  }
}
DI float gelu_tanh(float a) {
  const float u = 0.7978845608028654f * (a + 0.044715f * a * a * a);
  return 0.5f * a * (1.f + tanhf(u));
}

DI void phase_gather(const Params& p, int L, bool last) {
  const int wid = otid() >> 6;
  const unsigned char* U = p.ub() + (size_t)L * NEXP * 1024;
  const unsigned char* V = p.vb() + (size_t)L * NEXP * 1024;
  const float* ln2 = p.ln2 + L * 2048;
  int ni0 = 0, ni1 = 0;
  float ng0 = 0.f, ng1 = 0.f;
  {
    const int t0 = obid() * NWAVE + wid, l0 = otid() & 63;
    if (t0 < T) {
      ni0 = p.idx()[(size_t)t0 * 128 + l0]; ni1 = p.idx()[(size_t)t0 * 128 + 64 + l0];
      ng0 = p.g()[(size_t)t0 * 128 + l0];   ng1 = p.g()[(size_t)t0 * 128 + 64 + l0];
    }
  }
  for (int t = obid() * NWAVE + wid; t < T; t += gridDim.x * NWAVE) {
    const int lane = otid() & 63;
    const u16* xr = p.xb() + (size_t)t * 2048;
    float2_t xn2[16];
    float ss = 0.f;
    u32x4 xkeep[4];
#pragma unroll
    for (int c8 = 0; c8 < 4; ++c8) {
      const u32x4 a = *(const u32x4*)(xr + lane * 32 + c8 * 8);
      xkeep[c8] = a;
      xn2[c8 * 4 + 0] = float2_t{bf_lo(a.x), bf_hi(a.x)};
      xn2[c8 * 4 + 1] = float2_t{bf_lo(a.y), bf_hi(a.y)};
      xn2[c8 * 4 + 2] = float2_t{bf_lo(a.z), bf_hi(a.z)};
      xn2[c8 * 4 + 3] = float2_t{bf_lo(a.w), bf_hi(a.w)};
    }
#pragma unroll
    for (int e = 0; e < 16; ++e) ss += xn2[e].x * xn2[e].x + xn2[e].y * xn2[e].y;
    ss = wave_sum(ss);
    const float rstd = rsqrtf(ss * (1.f / 2048.f) + EPS) * (1.f / U_SCALE);
#pragma unroll
    for (int c4 = 0; c4 < 8; ++c4) {
      const float4 a = *(const float4*)(ln2 + lane * 32 + c4 * 4);
      xn2[c4 * 2 + 0] *= float2_t{rstd * a.x, rstd * a.y};
      xn2[c4 * 2 + 1] *= float2_t{rstd * a.z, rstd * a.w};
    }
    const int i0 = ni0, i1 = ni1;
    const float g0 = ng0, g1 = ng1;
    float a0 = 0.f, a1 = 0.f;
#pragma unroll
    for (int half = 0; half < 2; ++half) {
      const int iv = half ? i1 : i0;
      float av = 0.f;
#pragma unroll 1
      for (int k0 = 0; k0 < 64; k0 += 16) {
        u32x4 w[16];
#pragma unroll
        for (int q = 0; q < 16; ++q) {
          const int row = __builtin_amdgcn_readlane(iv, k0 + q);
          w[q] = *(const u32x4*)(U + (size_t)row * 1024 + lane * 16);
        }
        float d[16];
#pragma unroll
        for (int q = 0; q < 16; ++q) {
          __builtin_amdgcn_sched_barrier(0);
          if (q > 0) asm volatile("" : "+v"(w[q]), "+v"(d[q - 1]));
          d[q] = dot32(w[q], xn2);
        }
        __builtin_amdgcn_sched_barrier(0);
        {
          const bool b5 = (lane & 32) != 0, b4 = (lane & 16) != 0, b3 = (lane & 8) != 0, b2 = (lane & 4) != 0;
          float e8[8], e4[4], e2[2], e1;
#pragma unroll
          for (int j = 0; j < 8; ++j) {
            const float snd = b5 ? d[j] : d[j + 8];
            const float kep = b5 ? d[j + 8] : d[j];
            e8[j] = kep + __shfl_xor(snd, 32);
          }
#pragma unroll
          for (int j = 0; j < 4; ++j) {
            const float snd = b4 ? e8[j] : e8[j + 4];
            const float kep = b4 ? e8[j + 4] : e8[j];
            e4[j] = kep + __shfl_xor(snd, 16);
          }
#pragma unroll
          for (int j = 0; j < 2; ++j) {
            const float snd = b3 ? e4[j] : e4[j + 2];
            const float kep = b3 ? e4[j + 2] : e4[j];
            e2[j] = kep + __shfl_xor(snd, 8);
          }
          {
            const float snd = b2 ? e2[0] : e2[1];
            const float kep = b2 ? e2[1] : e2[0];
            e1 = kep + __shfl_xor(snd, 4);
          }
          e1 += __shfl_xor(e1, 2);
          e1 += __shfl_xor(e1, 1);
          const float got = __shfl(e1, ((lane - k0) & 15) * 4);
          if (lane >= k0 && lane < k0 + 16) av = got;
        }
      }
      if (half) a1 = av; else a0 = av;
    }
    const float hs0 = gelu_tanh(a0) * g0 * (1.f / V_SCALE), hs1 = gelu_tanh(a1) * g1 * (1.f / V_SCALE);
    {
      const int tn = t + gridDim.x * NWAVE;
      if (tn < T) {
        ni0 = p.idx()[(size_t)tn * 128 + lane]; ni1 = p.idx()[(size_t)tn * 128 + 64 + lane];
        ng0 = p.g()[(size_t)tn * 128 + lane];   ng1 = p.g()[(size_t)tn * 128 + 64 + lane];
      }
    }
    float2_t y2[16];
#pragma unroll
    for (int e = 0; e < 16; ++e) y2[e] = float2_t{0.f, 0.f};
#pragma unroll
    for (int half = 0; half < 2; ++half) {
      const int iv = half ? i1 : i0;
      const int hv = __float_as_int(half ? hs1 : hs0);
#pragma unroll 1
      for (int k0 = 0; k0 < 64; k0 += 8) {
        u32x4 w[8];
        float wq[8];
#pragma unroll
        for (int q = 0; q < 8; ++q) {
          const int row = __builtin_amdgcn_readlane(iv, k0 + q);
          wq[q] = __int_as_float(__builtin_amdgcn_readlane(hv, k0 + q));
          w[q] = *(const u32x4*)(V + (size_t)row * 1024 + lane * 16);
        }
#pragma unroll
        for (int q = 0; q < 8; ++q) {
          __builtin_amdgcn_sched_barrier(0);
          asm volatile("" : "+v"(w[q]), "+v"(y2[0]), "+v"(y2[8]));
          axpy32(w[q], wq[q], y2);
        }
        __builtin_amdgcn_sched_barrier(0);
      }
    }
    int t2 = t;
    asm volatile("" : "+v"(t2));
    const int lane2 = otid() & 63;
#pragma unroll
    for (int c8 = 0; c8 < 4; ++c8) {
      const u32x4 a = xkeep[c8];
      y2[c8 * 4 + 0] += float2_t{bf_lo(a.x), bf_hi(a.x)};
      y2[c8 * 4 + 1] += float2_t{bf_lo(a.y), bf_hi(a.y)};
      y2[c8 * 4 + 2] += float2_t{bf_lo(a.z), bf_hi(a.z)};
      y2[c8 * 4 + 3] += float2_t{bf_lo(a.w), bf_hi(a.w)};
    }
    if (!last) {
#pragma unroll
      for (int c8 = 0; c8 < 4; ++c8) {
        const float2_t* yy = y2 + c8 * 4;
        u32x4 w = {pack2bf(yy[0].x, yy[0].y), pack2bf(yy[1].x, yy[1].y), pack2bf(yy[2].x, yy[2].y), pack2bf(yy[3].x, yy[3].y)};
        *(u32x4*)(p.xb() + (size_t)t2 * 2048 + lane2 * 32 + c8 * 8) = w;
      }
    } else {
      float ss2 = 0.f;
#pragma unroll
      for (int e = 0; e < 16; ++e) ss2 += y2[e].x * y2[e].x + y2[e].y * y2[e].y;
      ss2 = wave_sum(ss2);
      const float r2 = rsqrtf(ss2 * (1.f / 2048.f) + EPS);
      float* orow = p.out + (size_t)t2 * 2048;
#pragma unroll
      for (int c4 = 0; c4 < 8; ++c4) {
        const float4 a = *(const float4*)(p.fnorm + lane2 * 32 + c4 * 4);
        *(float4*)(orow + lane2 * 32 + c4 * 4) =
            float4{y2[c4 * 2].x * r2 * a.x, y2[c4 * 2].y * r2 * a.y, y2[c4 * 2 + 1].x * r2 * a.z, y2[c4 * 2 + 1].y * r2 * a.w};
      }
    }
  }
}


#define XB_TMO      128
#define XB_XCNT(j)  (256  + 64 * (j))
#define XB_XSUB(j)  (1280 + 64 * (j))
#define XB_XGEN(j)  (2304 + 64 * (j))
#define XB_TOP      3328
#define XB_TOPGEN   3392
#define XCD_BAR_WORDS 3456
#define XB_SPIN_CAP (1u << 18)
#define LAS __attribute__((address_space(3)))
DI unsigned xb_ld(unsigned* p) { return __hip_atomic_load(p, __ATOMIC_RELAXED, __HIP_MEMORY_SCOPE_AGENT); }
DI unsigned xb_add(unsigned* p, unsigned v) { return __hip_atomic_fetch_add(p, v, __ATOMIC_RELAXED, __HIP_MEMORY_SCOPE_AGENT); }
DI unsigned xb_xcc_id() { return (unsigned)__builtin_amdgcn_s_getreg((3 << 11) | 20) & 0xFu; }
#define XB_SPIN(cond, bar) do { unsigned _sp = 0; while (cond) { __builtin_amdgcn_s_sleep(1); \
    if ((++_sp & 255u) == 0u) { if (xb_ld(&(bar)[XB_TMO])) break; if (_sp > XB_SPIN_CAP) { atomicAdd(&(bar)[XB_TMO], 1u); break; } } } } while (0)
struct XcdBarrier { unsigned* bar; unsigned x; volatile LAS unsigned* st; };
DI XcdBarrier xcd_barrier_post(unsigned* bar, volatile LAS unsigned* st) {
  XcdBarrier b; b.bar = bar; b.x = xb_xcc_id(); b.st = st;
  if (threadIdx.x == 0) (void)xb_add(&bar[XB_XCNT(b.x)], 1u);
  return b;
}
DI void xcd_barrier_complete(unsigned* bar, unsigned x, unsigned& nloc, unsigned& nx) {
  const unsigned G = gridDim.x * gridDim.y * gridDim.z;
  unsigned sum, cnt, mine, sp = 0u;
  for (;;) {
    sum = 0u; cnt = 0u; mine = 0u;
#pragma unroll
    for (unsigned j = 0; j < 16; ++j) { const unsigned c = xb_ld(&bar[XB_XCNT(j)]); sum += c; cnt += (c > 0u) ? 1u : 0u; mine = (j == x) ? c : mine; }
    if (sum == G) break;
    __builtin_amdgcn_s_sleep(1);
    if ((++sp & 255u) == 0u) { if (xb_ld(&bar[XB_TMO])) break; if (sp > XB_SPIN_CAP) { atomicAdd(&bar[XB_TMO], 1u); break; } }
  }
  nloc = mine > 0u ? mine : 1u; nx = cnt > 0u ? cnt : 1u;
}
DI void xcd_barrier(const XcdBarrier& b) {
  asm volatile("s_waitcnt vmcnt(0)" ::: "memory");
  __syncthreads();
  if (threadIdx.x == 0) {
    unsigned* bar = b.bar;
    __builtin_amdgcn_s_waitcnt(0);
    unsigned nloc = b.st[0], nx = b.st[1];
    if (nloc == 0u) { xcd_barrier_complete(bar, b.x, nloc, nx); b.st[0] = nloc; b.st[1] = nx; }
    const unsigned old = xb_add(&bar[XB_XSUB(b.x)], 1u);
    const unsigned gen = old / nloc;
    if (old + 1u == (gen + 1u) * nloc) {
      __builtin_amdgcn_fence(__ATOMIC_RELEASE, "agent");
      asm volatile("s_waitcnt vmcnt(0)" ::: "memory");
      const unsigned og = xb_add(&bar[XB_TOP], 1u);
      const unsigned tg = og / nx;
      if (og + 1u == (tg + 1u) * nx) xb_add(&bar[XB_TOPGEN], 1u);
      else XB_SPIN(xb_ld(&bar[XB_TOPGEN]) == tg, bar);
      __builtin_amdgcn_fence(__ATOMIC_ACQUIRE, "agent");
      xb_add(&bar[XB_XGEN(b.x)], 1u);
      asm volatile("s_waitcnt vmcnt(0)" ::: "memory");
    } else {
      XB_SPIN(xb_ld(&bar[XB_XGEN(b.x)]) == gen, bar);
      __builtin_amdgcn_fence(__ATOMIC_ACQUIRE, "agent");
      asm volatile("s_waitcnt vmcnt(0)" ::: "memory");
    }
  }
  __syncthreads();
}

#define KDEF(name, body)                                                       \
  __global__ void __launch_bounds__(512) name(Params p, int L) {            \
    __shared__ __attribute__((aligned(16))) char smem[SMEM_BYTES];             \
    body;                                                                      \
  }
#if !MEGA
KDEF(k_prologue, phase_prologue(p, smem))
KDEF(k_gemm1, phase_gemm1(p, L, smem))
KDEF(k_mix, phase_mix(p, L, smem))
KDEF(k_mla, phase_mla(p, smem))
KDEF(k_onorm, phase_onorm(p))
KDEF(k_gemm_o, phase_gemm_o(p, L, smem))
KDEF(k_gemm_pq, phase_gemm_pq(p, L, smem))
KDEF(k_scores, phase_gemm_scores(p, L, smem))
KDEF(k_select, phase_select(p, L, smem))
KDEF(k_gather, phase_gather(p, L, L == 1))
#else
#ifndef PROBE_MASK
#define PROBE_MASK 0
#endif
#define RUN(bit, call)                         \
  call;                                        \
  if (PROBE_MASK & (bit)) {                    \
    grid.sync();                               \
    call;                                      \
  }
__global__ void __launch_bounds__(512) mega_coop(Params p) {
  __shared__ __attribute__((aligned(16))) char smem[SMEM_BYTES];
  __shared__ uint4 xb_words;
  cg::grid_group grid = cg::this_grid();
  if (threadIdx.x == 0) xb_words = make_uint4(0u, 0u, 0u, 0u);
  __syncthreads();
  const XcdBarrier xb = xcd_barrier_post((unsigned*)(p.ws + WS_NEED), (volatile LAS unsigned*)&xb_words);
#define GSYNC xcd_barrier(xb)
  RUN(256, phase_prologue(p, smem))
  if (p.ws == nullptr) grid.sync();
  GSYNC;
#pragma unroll 1
  for (int L = 0; L < 2; ++L) {
    phase_gemm1(p, L, smem);
    GSYNC;
    phase_mix(p, L, smem);
    GSYNC;
    phase_mla(p, smem);
    GSYNC;
    phase_gemm_o(p, L, smem);
    GSYNC;
    phase_gemm_pq(p, L, smem);
    GSYNC;
    phase_select(p, L, smem);
    GSYNC;
    phase_gather(p, L, L == 1);
    if (L == 0) GSYNC;
  }
}
#endif

extern "C" void kernel_launch(void* const* d_in, const int* in_sizes, int n_in, void* d_out, int out_size, void* d_ws,
                              size_t ws_size, hipStream_t stream) {
  Params p{};
  p.x = (const float*)d_in[0]; p.ln1 = (const float*)d_in[1]; p.w_in = (const float*)d_in[2]; p.a_sink = (const float*)d_in[3];
  p.b_rel = (const float*)d_in[4]; p.cqn = (const float*)d_in[5]; p.ckvn = (const float*)d_in[6]; p.wuq = (const float*)d_in[7];
  p.wukv = (const float*)d_in[8]; p.onorm = (const float*)d_in[9]; p.wo = (const float*)d_in[10]; p.ln2 = (const float*)d_in[11];
  p.pwq = (const float*)d_in[12]; p.pkeys = (const float*)d_in[13]; p.pu = (const float*)d_in[14]; p.pv = (const float*)d_in[15];
  p.fnorm = (const float*)d_in[16];
  p.out = (float*)d_out;
  p.ws = (char*)d_ws;
  if (WS_NEED + XCD_BAR_WORDS * sizeof(unsigned) > ws_size) { fprintf(stderr, "kernel_launch: workspace too small (%zu > %zu)\n", (size_t)WS_NEED, ws_size); return; }

#if MEGA
  static int grid_blocks = 0;
  if (!grid_blocks) {
    int dev = 0, cus = 0, per_cu = 0;
    hipGetDevice(&dev);
    hipDeviceGetAttribute(&cus, hipDeviceAttributeMultiprocessorCount, dev);
    hipOccupancyMaxActiveBlocksPerMultiprocessor(&per_cu, mega_coop, NTHR, 0);
    if (per_cu > 1) per_cu = 1;
    if (per_cu < 1) per_cu = 1;
    grid_blocks = (cus * per_cu) & ~7;
  }
  (void)hipMemsetAsync(p.ws + WS_NEED, 0, XCD_BAR_WORDS * sizeof(unsigned), stream);
  void* args[] = {&p};
  hipError_t e = hipLaunchCooperativeKernel((void*)mega_coop, dim3(grid_blocks), dim3(NTHR), args, 0, stream);
  if (e != hipSuccess) fprintf(stderr, "cooperative launch failed: %s (grid %d)\n", hipGetErrorString(e), grid_blocks);
#else
  const dim3 g(256), b(NTHR);
  k_prologue<<<g, b, 0, stream>>>(p, 0);
  for (int L = 0; L < 2; ++L) {
    k_gemm1<<<g, b, 0, stream>>>(p, L);
    k_mix<<<g, b, 0, stream>>>(p, L);
    k_mla<<<g, b, 0, stream>>>(p, L);
    k_gemm_o<<<g, b, 0, stream>>>(p, L);
    k_gemm_pq<<<g, b, 0, stream>>>(p, L);
    k_select<<<g, b, 0, stream>>>(p, L);
    k_gather<<<g, b, 0, stream>>>(p, L);
  }
#endif
}
```
